# Optimizing an MI355X kernel written in HIP

```python
import math
import jax, jax.numpy as jnp
from jax import lax
import numpy as np

D_MODEL = 4096
BATCH = 2
SEQ = 4096
DEPTH = 1
DEC_BATCH = 4
DEC_SEQ = 4096
PAST_LEN = 128

N_META = 16
GRID_W = 64
Q_BLOCK = 128
HEAD_DIM = 128
MLA_HEADS = 16
MLA_Q_LORA = 1024
MLA_KV_LORA = 512
MLA_NOPE_DIM = 128
MLA_ROPE_DIM = 64
MLA_V_DIM = 128
GQA_HEADS = 16
GQA_KV_HEADS = 4
GQA_GROUP = GQA_HEADS // GQA_KV_HEADS
D_FF = 11008
CONV_WIDTH = 3
ROPE_THETA = 10000.0
NORM_EPS = 1e-6
IN_SPLITS = (MLA_Q_LORA, MLA_KV_LORA, MLA_ROPE_DIM, GQA_HEADS * HEAD_DIM, GQA_KV_HEADS * HEAD_DIM, GQA_KV_HEADS * HEAD_DIM, D_MODEL, D_MODEL)
D_IN = sum(IN_SPLITS)

kernel_name = "hybrid_mla_axial_gqa_encoder"


def _rms(x, g):
    x32 = x.astype(jnp.float32)
    y = x32 * lax.rsqrt(jnp.mean(x32 * x32, axis=-1, keepdims=True) + NORM_EPS)
    return (y * g.astype(jnp.float32)).astype(x.dtype)


def _rope_tables(pos, dim):
    inv = ROPE_THETA ** (-jnp.arange(0, dim, 2, dtype=jnp.float32) / dim)
    ang = pos.astype(jnp.float32)[:, None] * inv[None, :]
    return jnp.cos(ang), jnp.sin(ang)


def _apply_rope(x, cos, sin):
    half = x.shape[-1] // 2
    c = cos[None, :, None, :].astype(x.dtype)
    s = sin[None, :, None, :].astype(x.dtype)
    x1, x2 = x[..., :half], x[..., half:]
    return jnp.concatenate([x1 * c - x2 * s, x1 * s + x2 * c], axis=-1)


def _axial_rope(x, row_cos, row_sin, col_cos, col_sin):
    half = x.shape[-1] // 2
    return jnp.concatenate([_apply_rope(x[..., :half], row_cos, row_sin),
                            _apply_rope(x[..., half:], col_cos, col_sin)], axis=-1)


def _attend_block(q, k, v, scale):
    s = jnp.einsum("bqkgd,bskd->bkgqs", q, k).astype(jnp.float32) * scale
    p = jax.nn.softmax(s, axis=-1).astype(v.dtype)
    return jnp.einsum("bkgqs,bskd->bqkgd", p, v)


def _bidir_attention(q, k, v, scale):
    b, l, hk, g, d = q.shape
    n_real = l - N_META
    n_blk = n_real // Q_BLOCK
    o_meta = _attend_block(q[:, :N_META], k, v, scale)
    q_blocks = jnp.moveaxis(q[:, N_META:].reshape(b, n_blk, Q_BLOCK, hk, g, d), 1, 0)
    o_blocks = lax.map(lambda qb: _attend_block(qb, k, v, scale), q_blocks)
    o_real = jnp.moveaxis(o_blocks, 0, 1).reshape(b, n_real, hk, g, v.shape[-1])
    return jnp.concatenate([o_meta, o_real], axis=1)


def _dwconv3(a, w, bias):
    ap = jnp.pad(a, ((0, 0), (1, 1), (0, 0)))
    return ap[:, :-2] * w[0] + ap[:, 1:-1] * w[1] + ap[:, 2:] * w[2] + bias


def _layer(h, rope1, axial, g_pre_mix, w_in, g_cq, w_uq, g_ckv, w_ukv, g_qn, g_kn,
           w_pa, w_pb, w_o, g_post_mix, g_pre_ffn, w_up, w_conv, b_conv, w_down, g_post_ffn):
    b, l, _ = h.shape
    cos1, sin1 = rope1
    u = _rms(h, g_pre_mix)
    z = u @ w_in
    offsets = np.cumsum(IN_SPLITS)[:-1].tolist()
    z_cq, z_ckv, z_kr, z_gq, z_gk, z_gv, z_ga, z_gb = jnp.split(z, offsets, axis=-1)

    cq = _rms(z_cq, g_cq)
    qa = (cq @ w_uq).reshape(b, l, MLA_HEADS, MLA_NOPE_DIM + MLA_ROPE_DIM)
    qa = jnp.concatenate([qa[..., :MLA_NOPE_DIM], _apply_rope(qa[..., MLA_NOPE_DIM:], cos1, sin1)], axis=-1)
    ckv = _rms(z_ckv, g_ckv)
    kv = (ckv @ w_ukv).reshape(b, l, MLA_HEADS, MLA_NOPE_DIM + MLA_V_DIM)
    k_nope, v_a = kv[..., :MLA_NOPE_DIM], kv[..., MLA_NOPE_DIM:]
    k_rope = _apply_rope(z_kr[:, :, None, :], cos1, sin1)
    ka = jnp.concatenate([k_nope, jnp.broadcast_to(k_rope, (b, l, MLA_HEADS, MLA_ROPE_DIM))], axis=-1)
    o_a = _bidir_attention(qa[:, :, :, None, :], ka, v_a, 1.0 / math.sqrt(MLA_NOPE_DIM + MLA_ROPE_DIM))
    o_a = o_a.reshape(b, l, MLA_HEADS * MLA_V_DIM)

    qb = _axial_rope(_rms(z_gq.reshape(b, l, GQA_HEADS, HEAD_DIM), g_qn), *axial)
    kb = _axial_rope(_rms(z_gk.reshape(b, l, GQA_KV_HEADS, HEAD_DIM), g_kn), *axial)
    vb = z_gv.reshape(b, l, GQA_KV_HEADS, HEAD_DIM)
    qb = qb.reshape(b, l, GQA_KV_HEADS, GQA_GROUP, HEAD_DIM)
    o_b = _bidir_attention(qb, kb, vb, 1.0 / math.sqrt(HEAD_DIM)).reshape(b, l, GQA_HEADS * HEAD_DIM)

    merged = jax.nn.sigmoid(z_ga) * (o_a @ w_pa) + jax.nn.sigmoid(z_gb) * (o_b @ w_pb)
    h = h + _rms(merged @ w_o, g_post_mix)

    up = _rms(h, g_pre_ffn) @ w_up
    a, gv = up[..., :D_FF], up[..., D_FF:]
    f = jax.nn.gelu(_dwconv3(a, w_conv, b_conv)) * gv
    return h + _rms(f @ w_down, g_post_ffn)


def _trunk(x, meta_tokens, params):
    b, n_tok, _ = x.shape
    rows = n_tok // GRID_W
    h = jnp.concatenate([jnp.broadcast_to(meta_tokens.astype(x.dtype)[None], (b, N_META, D_MODEL)), x], axis=1)
    l = N_META + n_tok
    rope1 = _rope_tables(jnp.arange(l), MLA_ROPE_DIM)
    row_ids = jnp.concatenate([jnp.zeros((N_META,), jnp.int32), jnp.repeat(jnp.arange(rows, dtype=jnp.int32), GRID_W)])
    col_ids = jnp.concatenate([jnp.zeros((N_META,), jnp.int32), jnp.tile(jnp.arange(GRID_W, dtype=jnp.int32), rows)])
    row_cos, row_sin = _rope_tables(row_ids, HEAD_DIM // 2)
    col_cos, col_sin = _rope_tables(col_ids, HEAD_DIM // 2)
    axial = (row_cos, row_sin, col_cos, col_sin)
    for i in range(DEPTH):
        h = _layer(h, rope1, axial, *[p[i] for p in params])
    return h[:, N_META:]


def setup_inputs(seed: int = 0) -> dict:
    key = jax.random.key(seed)
    ks = jax.random.split(key, 24)
    f32 = jnp.float32

    def nrm(k, shape, scale):
        return jax.random.normal(k, shape, f32) * scale

    def gain(k, n):
        return 1.0 + 0.02 * jax.random.normal(k, (DEPTH, n), f32)

    return {
        "x_prompt": nrm(ks[0], (BATCH, SEQ, D_MODEL), 1.0),
        "x_sample": nrm(ks[1], (DEC_BATCH, DEC_SEQ, D_MODEL), 1.0),
        "meta_tokens": nrm(ks[2], (N_META, D_MODEL), 1.0),
        "g_pre_mix": gain(ks[3], D_MODEL),
        "w_in": nrm(ks[4], (DEPTH, D_MODEL, D_IN), D_MODEL ** -0.5),
        "g_cq": gain(ks[5], MLA_Q_LORA),
        "w_uq": nrm(ks[6], (DEPTH, MLA_Q_LORA, MLA_HEADS * (MLA_NOPE_DIM + MLA_ROPE_DIM)), MLA_Q_LORA ** -0.5),
        "g_ckv": gain(ks[7], MLA_KV_LORA),
        "w_ukv": nrm(ks[8], (DEPTH, MLA_KV_LORA, MLA_HEADS * (MLA_NOPE_DIM + MLA_V_DIM)), MLA_KV_LORA ** -0.5),
        "g_qn": gain(ks[9], HEAD_DIM),
        "g_kn": gain(ks[10], HEAD_DIM),
        "w_pa": nrm(ks[11], (DEPTH, MLA_HEADS * MLA_V_DIM, D_MODEL), (MLA_HEADS * MLA_V_DIM) ** -0.5),
        "w_pb": nrm(ks[12], (DEPTH, GQA_HEADS * HEAD_DIM, D_MODEL), (GQA_HEADS * HEAD_DIM) ** -0.5),
        "w_o": nrm(ks[13], (DEPTH, D_MODEL, D_MODEL), D_MODEL ** -0.5),
        "g_post_mix": gain(ks[14], D_MODEL),
        "g_pre_ffn": gain(ks[15], D_MODEL),
        "w_up": nrm(ks[16], (DEPTH, D_MODEL, 2 * D_FF), D_MODEL ** -0.5),
        "w_conv": nrm(ks[17], (DEPTH, CONV_WIDTH, D_FF), CONV_WIDTH ** -0.5),
        "b_conv": nrm(ks[18], (DEPTH, D_FF), 0.01),
        "w_down": nrm(ks[19], (DEPTH, D_FF, D_MODEL), D_FF ** -0.5),
        "g_post_ffn": gain(ks[20], D_MODEL),
    }


def reference(x_prompt, x_sample, meta_tokens, g_pre_mix, w_in, g_cq, w_uq, g_ckv, w_ukv, g_qn, g_kn,
              w_pa, w_pb, w_o, g_post_mix, g_pre_ffn, w_up, w_conv, b_conv, w_down, g_post_ffn):
    params = (g_pre_mix, w_in, g_cq, w_uq, g_ckv, w_ukv, g_qn, g_kn, w_pa, w_pb, w_o,
              g_post_mix, g_pre_ffn, w_up, w_conv, b_conv, w_down, g_post_ffn)
    y_prompt = _trunk(x_prompt, meta_tokens, params)
    y_sample = _trunk(x_sample, meta_tokens, params)
    return (y_prompt, y_sample)
```

```cpp
#include <hip/hip_runtime.h>
#include <cstdio>
#include <cstdint>

#ifndef MK_ONE_LAUNCH
#define MK_ONE_LAUNCH 1
#endif

#define LAS __attribute__((address_space(3)))
#define GAS __attribute__((address_space(1)))
typedef unsigned short bf16_t;
typedef short bf16x8 __attribute__((ext_vector_type(8)));
typedef short s16x4 __attribute__((ext_vector_type(4)));
typedef float f32x2 __attribute__((ext_vector_type(2)));
typedef float f32x4 __attribute__((ext_vector_type(4)));
typedef float f32x16 __attribute__((ext_vector_type(16)));
typedef unsigned u32x2 __attribute__((ext_vector_type(2)));
typedef unsigned u32x4 __attribute__((ext_vector_type(4)));

constexpr int D = 4096, SEQ = 4096, NBATCH = 6, NMETA = 16, LSEQ = SEQ + NMETA;
constexpr int MREAL = NBATCH * SEQ;
constexpr int M = MREAL + 256;
constexpr int MT = M / 256;
constexpr int DINP = 13056;
constexpr int DFF = 11008;
constexpr float EPS = 1e-6f;
constexpr int PN_CQ = 0, PN_CKV = 4, PN_GQ = 6, PN_GK = 14, PN_GV = 16, PN_GA = 18, PN_GB = 34, PN_KR = 50;

constexpr size_t MiB = 1u << 20;
constexpr size_t WS_CTL = 0, CTL_ZERO_BYTES = 2 * MiB;
constexpr size_t WS_SS = 1 * MiB;
constexpr size_t WS_TAB = 2 * MiB;
constexpr size_t WS_WIN = 4 * MiB, WS_WUQ = 106 * MiB, WS_WUKV = 112 * MiB, WS_WP = 116 * MiB, WS_WO = 148 * MiB, WS_WUP = 180 * MiB, WS_WDN = 352 * MiB;
constexpr size_t WS_U = 438 * MiB;
constexpr size_t WS_ZCQ = 632 * MiB, WS_ZCKV = 681 * MiB, WS_QB = 706 * MiB, WS_KB = 803 * MiB, WS_VB = 828 * MiB, WS_KR = 853 * MiB;
constexpr size_t WS_QA = 857 * MiB, WS_KVA = 1003 * MiB;
constexpr size_t WS_MG = 857 * MiB;
constexpr size_t WS_T = 632 * MiB;
constexpr size_t WS_F = 632 * MiB;
constexpr size_t WS_HALOA = 1154 * MiB, WS_HALOG = 1187 * MiB, WS_METAA = 1204 * MiB, WS_GAM = 1205 * MiB, WS_GBM = 1207 * MiB, WS_H1M = 1209 * MiB, WS_SSP = 1211 * MiB  , WS_END = 1227 * MiB;
static_assert(WS_WIN + (size_t)DINP * D * 2 <= WS_WUQ && WS_WUP + (size_t)2 * DFF * D * 2 <= WS_WDN && WS_WDN + (size_t)D * DFF * 2 <= WS_U, "weights map");
static_assert(WS_U + (size_t)M * D * 2 <= WS_ZCQ && WS_F + (size_t)M * DFF * 2 <= WS_HALOA && WS_HALOA + (size_t)MT * 8 * DFF * 4 <= WS_HALOG && WS_HALOG + (size_t)MT * 4 * DFF * 4 <= WS_METAA, "act map");
static_assert(WS_QA + (size_t)M * 3072 * 2 <= WS_KVA && WS_KVA + (size_t)M * 4096 * 2 <= 1197 * MiB && WS_KR + (size_t)M * 64 * 2 <= WS_QA, "act map 2");
constexpr int CW_BAR = 4096;
constexpr size_t SSP_CQ = 0  , SSP_CKV = (size_t)M * 16 * 4  , SSP_T = SSP_CKV + (size_t)M * 8 * 4  , SSP_D = SSP_T + (size_t)M * 64 * 4  ;
static_assert(SSP_D + (size_t)M * 64 * 4 <= 16 * MiB, "ssp map");

constexpr int RING_BYTES = 131072;
constexpr int EPI_OFF = RING_BYTES;
constexpr int MISC_OFF = EPI_OFF + 8192;
constexpr int LDS_BYTES = 147456;

typedef __bf16 bf16x2_t __attribute__((ext_vector_type(2)));
__device__ __forceinline__ unsigned cvt_pk_bf16(float lo, float hi) { const f32x2 v = {lo, hi}; const bf16x2_t b = __builtin_convertvector(v, bf16x2_t); return __builtin_bit_cast(unsigned, b); }
__device__ __forceinline__ float bf_lo(unsigned w) { return __uint_as_float(w << 16); }
__device__ __forceinline__ float bf_hi(unsigned w) { return __uint_as_float(w & 0xffff0000u); }
__device__ __forceinline__ float fast_rcp(float x) { return __builtin_amdgcn_rcpf(x); }
__device__ __forceinline__ float fast_rsq(float x) { return __builtin_amdgcn_rsqf(x); }
__device__ __forceinline__ float fast_exp2(float x) { return __builtin_amdgcn_exp2f(x); }
__device__ __forceinline__ float sigmoidf_(float v) { v = fminf(fmaxf(v, -30.f), 30.f); return fast_rcp(1.0f + fast_exp2(-1.4426950408889634f * v)); }
__device__ __forceinline__ float gelu_tanh(float x) { const float u = x * (1.0f + 0.044715f * x * x); float e = -2.0f * 0.7978845608028654f * 1.4426950408889634f * u; e = fminf(e, 80.f); return x * fast_rcp(1.0f + fast_exp2(e)); }
__device__ __forceinline__ u32x4 pack8(const f32x4 a, const f32x4 b) { u32x4 w; w.x = cvt_pk_bf16(a[0], a[1]); w.y = cvt_pk_bf16(a[2], a[3]); w.z = cvt_pk_bf16(b[0], b[1]); w.w = cvt_pk_bf16(b[2], b[3]); return w; }
__device__ __forceinline__ float wave_sum(float v) {
#pragma unroll
    for (int o = 1; o < 64; o <<= 1) v += __shfl_xor(v, o);
    return v;
}
__device__ __forceinline__ f32x4 rope4(const f32x4 v, const f32x4 cs) { f32x4 o; o[0] = v[0] * cs[0] - v[1] * cs[1]; o[1] = v[0] * cs[1] + v[1] * cs[0]; o[2] = v[2] * cs[2] - v[3] * cs[3]; o[3] = v[2] * cs[3] + v[3] * cs[2]; return o; }
__device__ __forceinline__ int pos1d_of(int pm, int rl) { return pm < MT - 1 ? 16 + ((pm & 15) << 8) + rl : (rl < 96 ? (rl & 15) : 0); }
__device__ __forceinline__ int tok_of(int pm, int rl) { return pm < MT - 1 ? ((pm & 15) << 8) + rl : 0; }

namespace pg8 {
constexpr int BM = 256, BK = 64, HALF = 128, HTB = HALF * BK * 2, STAGE_BYTES = 8 * HTB, NXCD = 8, WGM = 8;
__host__ __device__ __forceinline__ int lds_byte(int r, int c) { const int st = (r >> 4) * 2 + (c >> 5), rr = r & 15, cc = c & 31, ob = rr * 64 + cc * 2; return st * 1024 + (ob ^ (((ob >> 9) & 1) << 5)); }
__host__ __device__ __forceinline__ void stage_rc(int b, int& R, int& C) { const int st = b / 1024, sb = b % 1024, swz = sb ^ (((sb >> 9) & 1) << 5); R = (st >> 1) * 16 + swz / 64; C = (st & 1) * 32 + (swz % 64) / 2; }
__host__ __device__ __forceinline__ int perm32(int rho) { const int n = rho >> 4, i = rho & 15; return 8 * (i >> 2) + 4 * n + (i & 3); }
struct Unit { int pm, pn; };
struct Gemm { const bf16_t* A; const bf16_t* Bt; int M, N, K, ld; };
struct StaticOrder {
    int nM, nN, nwg, G, c;
    __host__ __device__ void init(int M_, int N_, int G_, int c_) { nM = M_ / BM; nN = N_ / BM; nwg = nM * nN; G = G_; c = c_; }
    __host__ __device__ bool next(int i, Unit& u) const {
        const long L = (long)i * G + c; if (L >= nwg) return false;
        int wgid = (int)L; { const int q = nwg / NXCD, r = nwg % NXCD, xcd = wgid % NXCD, off = wgid / NXCD; wgid = (xcd < r ? xcd * (q + 1) : r * (q + 1) + (xcd - r) * q) + off; }
        const int nig = WGM * nN, gid = wgid / nig, fm = gid * WGM, gsz = (nM - fm) < WGM ? (nM - fm) : WGM;
        u.pm = fm + ((wgid % nig) % gsz); u.pn = (wgid % nig) / gsz; return true;
    }
};
template <class Epi, bool ALIGN_EPI = true, bool SP2 = true>
__device__ __forceinline__ void gemm_phase(LAS unsigned char* lds, LAS unsigned char* scratch, const Gemm g, const StaticOrder& S, const Epi& E) {
    int tid_ = threadIdx.x; asm volatile("" : "+v"(tid_));
    const int tid = tid_, wid = __builtin_amdgcn_readfirstlane(tid >> 6), lane = tid & 63, wr = wid >> 2, wc = wid & 3, fr = lane & 15, fq = lane >> 4;
    const int K = g.ld  , nt = g.K / BK;
    unsigned voffA[2], voffB[2];
#pragma unroll
    for (int i = 0; i < 2; ++i) { int R, C; stage_rc(tid * 16 + i * 8192, R, C); const int Rb = (R & ~31) + perm32(R & 31);
        const int Ra = Epi::ASWAP ? (128 * (R >> 6) + (R & 63)) : R;
        voffA[i] = (unsigned)(Ra * K + C) * 2u; voffB[i] = (unsigned)(Rb * K + C) * 2u; }
    const size_t kstep = (size_t)(BK * 2);
    const size_t hstepB = (size_t)HALF * K * 2;
    const size_t hstepA = Epi::ASWAP ? (size_t)64 * K * 2 : hstepB;
    const size_t tstep = (size_t)256 * K * 2;
    const unsigned ldsw = (unsigned)wid * 1024u;
    const int aoff = lds_byte(wr * 64 + fr, fq * 8), boff = lds_byte(wc * 32 + fr, fq * 8);
#define PG8_SA(b, h) (((b) * 2 + (h)) * HTB)
#define PG8_SB(b, h) ((4 + (b) * 2 + (h)) * HTB)
#define PG8_STAGE(bufoff, gbase, voff) do { _Pragma("unroll") for (int _i = 0; _i < 2; ++_i) \
        __builtin_amdgcn_global_load_lds((const unsigned*)((const char*)(gbase) + (voff)[_i]), (LAS unsigned*)(lds + (bufoff) + ldsw + _i * 8192), 16, 0, 0); } while (0)
#define PG8_LDA(dst, b, h) do { _Pragma("unroll") for (int m = 0; m < 4; ++m) _Pragma("unroll") for (int k = 0; k < 2; ++k) dst[m][k] = *(const LAS bf16x8*)(lds + PG8_SA(b, h) + aoff + m * 2048 + k * 1024); } while (0)
#define PG8_LDB(dst, b, h) do { _Pragma("unroll") for (int n = 0; n < 2; ++n) _Pragma("unroll") for (int k = 0; k < 2; ++k) dst[n][k] = *(const LAS bf16x8*)(lds + PG8_SB(b, h) + boff + n * 2048 + k * 1024); } while (0)
#define PG8_MMA(ai, bj, At, Bt) do { __builtin_amdgcn_s_setprio(1); _Pragma("unroll") for (int m = 0; m < 4; ++m) _Pragma("unroll") for (int n = 0; n < 2; ++n) _Pragma("unroll") for (int k = 0; k < 2; ++k) \
        acc[ai][bj][m][n] = __builtin_amdgcn_mfma_f32_16x16x32_bf16(Bt[n][k], At[m][k], acc[ai][bj][m][n], 0, 0, 0); __builtin_amdgcn_s_setprio(0); } while (0)
#define PG8_WAIT_V(n) asm volatile("s_waitcnt vmcnt(" #n ")" ::: "memory")
#define PG8_WAIT_L(n) asm volatile("s_waitcnt lgkmcnt(" #n ")" ::: "memory")
#define PG8_BAR __builtin_amdgcn_s_barrier()
#define PG8_SCHED __builtin_amdgcn_sched_barrier(0)
    Unit cur, nxt; int ui = 0;
    if (!S.next(0, cur)) return;
    f32x4 acc[2][2][4][2];
#pragma unroll
    for (int a = 0; a < 2; ++a)
#pragma unroll
        for (int b = 0; b < 2; ++b)
#pragma unroll
            for (int m = 0; m < 4; ++m)
#pragma unroll
                for (int n = 0; n < 2; ++n) acc[a][b][m][n] = (f32x4){0.f, 0.f, 0.f, 0.f};
    bf16x8 At[4][2], B0[2][2], B1[2][2];
    const char* cA = (const char*)g.A + (size_t)cur.pm * tstep; const char* cB = (const char*)g.Bt + (size_t)cur.pn * tstep;
    if constexpr (SP2) {
        PG8_STAGE(PG8_SB(0, 0), cB, voffB); PG8_STAGE(PG8_SB(0, 1), cB + hstepB, voffB); PG8_STAGE(PG8_SA(0, 0), cA, voffA); PG8_STAGE(PG8_SA(0, 1), cA + hstepA, voffA);
        if (wr == 1) PG8_BAR;
        PG8_WAIT_V(2); PG8_BAR;
        PG8_STAGE(PG8_SB(1, 0), cB + kstep, voffB); PG8_STAGE(PG8_SA(1, 0), cA + kstep, voffA); PG8_STAGE(PG8_SB(1, 1), cB + hstepB + kstep, voffB);
        PG8_WAIT_V(6); PG8_BAR;
    } else {
        PG8_STAGE(PG8_SB(0, 0), cB, voffB); PG8_STAGE(PG8_SA(0, 0), cA, voffA); PG8_STAGE(PG8_SB(0, 1), cB + hstepB, voffB); PG8_STAGE(PG8_SA(0, 1), cA + hstepA, voffA);
        if (wr == 1) PG8_BAR;
        PG8_WAIT_V(4); PG8_BAR;
        PG8_STAGE(PG8_SB(1, 0), cB + kstep, voffB); PG8_STAGE(PG8_SA(1, 0), cA + kstep, voffA); PG8_STAGE(PG8_SB(1, 1), cB + hstepB + kstep, voffB);
        PG8_WAIT_V(6); PG8_BAR;
    }
    for (;;) {
        const bool has_next = S.next(ui + 1, nxt);
        const char* nA = has_next ? (const char*)g.A + (size_t)nxt.pm * tstep : cA; const char* nB = has_next ? (const char*)g.Bt + (size_t)nxt.pn * tstep : cB;
        for (int t = 0; t < nt; t += 2) {
            const bool last = (t == nt - 2);
            const char* a1 = cA + (size_t)(t + 1) * kstep;
            const char* a2 = last ? nA : cA + (size_t)(t + 2) * kstep; const char* b2 = last ? nB : cB + (size_t)(t + 2) * kstep;
            const char* a3 = a2 + kstep; const char* b3 = b2 + kstep;
            if constexpr (SP2) {
            PG8_LDB(B0, 0, 0); PG8_LDB(B1, 0, 1); PG8_SCHED; PG8_LDA(At, 0, 0); PG8_STAGE(PG8_SA(1, 1), a1 + hstepA, voffA);
            PG8_WAIT_V(8); PG8_WAIT_L(0); PG8_BAR; PG8_MMA(0, 0, At, B0); PG8_MMA(0, 1, At, B1); PG8_BAR; PG8_SCHED;
            PG8_LDA(At, 0, 1); PG8_STAGE(PG8_SB(0, 0), b2, voffB); PG8_STAGE(PG8_SB(0, 1), b2 + hstepB, voffB); PG8_STAGE(PG8_SA(0, 0), a2, voffA);
            PG8_WAIT_V(8); PG8_WAIT_L(0); PG8_BAR; PG8_MMA(1, 0, At, B0); PG8_MMA(1, 1, At, B1); PG8_BAR; PG8_SCHED;
            PG8_LDB(B0, 1, 0); PG8_LDB(B1, 1, 1); PG8_SCHED; PG8_LDA(At, 1, 0); PG8_STAGE(PG8_SA(0, 1), a2 + hstepA, voffA);
            PG8_WAIT_V(8); PG8_WAIT_L(0); PG8_BAR; PG8_MMA(0, 0, At, B0); PG8_MMA(0, 1, At, B1); PG8_BAR; PG8_SCHED;
            PG8_LDA(At, 1, 1); PG8_STAGE(PG8_SB(1, 0), b3, voffB); PG8_STAGE(PG8_SB(1, 1), b3 + hstepB, voffB); PG8_STAGE(PG8_SA(1, 0), a3, voffA);
            PG8_WAIT_V(8); PG8_WAIT_L(0); PG8_BAR; PG8_MMA(1, 0, At, B0); PG8_MMA(1, 1, At, B1); PG8_BAR; PG8_SCHED;
            } else {
            PG8_LDB(B0, 0, 0); PG8_SCHED; PG8_LDA(At, 0, 0); PG8_STAGE(PG8_SA(1, 1), a1 + hstepA, voffA);
            PG8_WAIT_L(8); PG8_BAR; PG8_WAIT_L(0); PG8_MMA(0, 0, At, B0); PG8_BAR; PG8_SCHED;
            PG8_LDB(B1, 0, 1); PG8_STAGE(PG8_SB(0, 0), b2, voffB);
            PG8_BAR; PG8_WAIT_L(0); PG8_MMA(0, 1, At, B1); PG8_BAR;
            PG8_LDA(At, 0, 1); PG8_STAGE(PG8_SA(0, 0), a2, voffA);
            PG8_BAR; PG8_WAIT_L(0); PG8_MMA(1, 0, At, B0); PG8_BAR; PG8_SCHED;
            PG8_STAGE(PG8_SB(0, 1), b2 + hstepB, voffB);
            PG8_WAIT_V(6); PG8_BAR; PG8_MMA(1, 1, At, B1); PG8_BAR;
            PG8_LDB(B0, 1, 0); PG8_SCHED; PG8_LDA(At, 1, 0); PG8_STAGE(PG8_SA(0, 1), a2 + hstepA, voffA);
            PG8_WAIT_L(8); PG8_BAR; PG8_WAIT_L(0); PG8_MMA(0, 0, At, B0); PG8_BAR; PG8_SCHED;
            PG8_LDB(B1, 1, 1); PG8_STAGE(PG8_SB(1, 0), b3, voffB);
            PG8_BAR; PG8_WAIT_L(0); PG8_MMA(0, 1, At, B1); PG8_BAR;
            PG8_LDA(At, 1, 1); PG8_STAGE(PG8_SA(1, 0), a3, voffA);
            PG8_BAR; PG8_WAIT_L(0); PG8_MMA(1, 0, At, B0); PG8_BAR; PG8_SCHED;
            PG8_STAGE(PG8_SB(1, 1), b3 + hstepB, voffB);
            PG8_WAIT_V(6); PG8_BAR; PG8_MMA(1, 1, At, B1); PG8_BAR;
            }
        }
        if constexpr (ALIGN_EPI) { if (wr == 0) PG8_BAR; }
        E(acc, cur, wr, wc, fr, fq, scratch);
        if (!has_next) break;
#pragma unroll
        for (int a = 0; a < 2; ++a)
#pragma unroll
            for (int b = 0; b < 2; ++b)
#pragma unroll
                for (int m = 0; m < 4; ++m)
#pragma unroll
                    for (int n = 0; n < 2; ++n) acc[a][b][m][n] = (f32x4){0.f, 0.f, 0.f, 0.f};
        cur = nxt; cA = nA; cB = nB; ++ui;
        if constexpr (ALIGN_EPI) { if (wr == 1) PG8_BAR; }
    }
    PG8_WAIT_V(0);
    if constexpr (!ALIGN_EPI) { if (wr == 0) PG8_BAR; }
    PG8_BAR;
#undef PG8_SA
#undef PG8_SB
#undef PG8_STAGE
#undef PG8_LDA
#undef PG8_LDB
#undef PG8_MMA
#undef PG8_WAIT_V
#undef PG8_WAIT_L
#undef PG8_BAR
#undef PG8_SCHED
}
}
using pg8::Unit;
typedef f32x4 AccT[2][2][4][2];

template <class T> __device__ __forceinline__ T ldu(const void* ubase, size_t uoff, unsigned voff) { return *(const T*)((const char*)ubase + uoff + voff); }
template <class T> __device__ __forceinline__ void stu(void* ubase, size_t uoff, unsigned voff, const T v) { *(T*)((char*)ubase + uoff + voff) = v; }
__device__ __forceinline__ float sumsq8(const f32x4 v0, const f32x4 v1) { return ((v0[0] * v0[0] + v0[1] * v0[1]) + (v0[2] * v0[2] + v0[3] * v0[3])) + ((v1[0] * v1[0] + v1[1] * v1[1]) + (v1[2] * v1[2] + v1[3] * v1[3])); }
struct EpiP1 {
    static constexpr bool ASWAP = false;
    unsigned char* ws; bf16_t* GA; const float *g_qn, *g_kn;
    __device__ __forceinline__ void operator()(const AccT& acc, const Unit& u, int wr, int wc, int fr, int fq, LAS unsigned char* scr) const {
        const int pn = u.pn, pm = u.pm, rl0 = wr * 64 + fr, cw = wc * 32 + 8 * fq;
        bf16_t* const ZCQ = (bf16_t*)(ws + WS_ZCQ); bf16_t* const ZCKV = (bf16_t*)(ws + WS_ZCKV); bf16_t* const QB = (bf16_t*)(ws + WS_QB); bf16_t* const KB = (bf16_t*)(ws + WS_KB); bf16_t* const VB = (bf16_t*)(ws + WS_VB);
        bf16_t* const KR = (bf16_t*)(ws + WS_KR); bf16_t* const GAM = (bf16_t*)(ws + WS_GAM); bf16_t* const GBM = (bf16_t*)(ws + WS_GBM); bf16_t* const GB = GA + (size_t)MREAL * D;
        const f32x4* const TAB = (const f32x4*)(ws + WS_TAB);
        if (pn < PN_GQ) {
            const bool isq = pn < PN_CKV; const int ld = isq ? 1024 : 512, colt = isq ? 256 * pn : 256 * (pn - PN_CKV);
            bf16_t* dst = (isq ? ZCQ : ZCKV) + (size_t)pm * 256 * ld + colt; const int nslot = isq ? 16 : 8, slot = (isq ? pn : pn - PN_CKV) * 4 + wc;
            float* ss = (float*)(ws + WS_SSP + (isq ? SSP_CQ : SSP_CKV)) + (size_t)pm * 256 * nslot + slot;
            const unsigned voff = (unsigned)((rl0 * ld + cw) * 2);
#pragma unroll
            for (int ai = 0; ai < 2; ++ai)
#pragma unroll
                for (int m = 0; m < 4; ++m) { float s = 0.f;
#pragma unroll
                    for (int bj = 0; bj < 2; ++bj) { s += sumsq8(acc[ai][bj][m][0], acc[ai][bj][m][1]);
                        stu<u32x4>(dst, (size_t)((ai * 128 + m * 16) * ld + bj * 128) * 2, voff, pack8(acc[ai][bj][m][0], acc[ai][bj][m][1])); }
                    s += __shfl_xor(s, 16); s += __shfl_xor(s, 32);
                    if (fq == 0) ss[(ai * 128 + m * 16 + rl0) * nslot] = s; }
        } else if (pn < PN_GV) {
            const bool isq = pn < PN_GK; const int ld = isq ? 2048 : 512, colt = isq ? 256 * (pn - PN_GQ) : 256 * (pn - PN_GK); const float* gn = isq ? g_qn : g_kn;
            bf16_t* dst = (isq ? QB : KB) + (size_t)pm * 256 * ld + colt; const unsigned voff = (unsigned)((rl0 * ld + cw) * 2);
            LAS float* P = (LAS float*)scr;
#pragma unroll
            for (int ai = 0; ai < 2; ++ai)
#pragma unroll
                for (int m = 0; m < 4; ++m)
#pragma unroll
                    for (int bj = 0; bj < 2; ++bj) { float s = sumsq8(acc[ai][bj][m][0], acc[ai][bj][m][1]);
                        s += __shfl_xor(s, 16); s += __shfl_xor(s, 32);
                        if (fq == 0) P[(ai * 128 + m * 16 + rl0) * 8 + bj * 4 + wc] = s; }
            asm volatile("s_waitcnt lgkmcnt(0)" ::: "memory"); __builtin_amdgcn_s_barrier(); asm volatile("" ::: "memory");
            const int half = wc >> 1, i0 = 16 * (wc & 1) + 4 * fq;
            const f32x4 g1 = *(const f32x4*)(gn + half * 64 + i0), g2 = *(const f32x4*)(gn + half * 64 + 32 + i0);
            const int tbase = pm < MT - 1 ? ((pm & 15) << 8) : 0; const bool real = pm < MT - 1;
            const unsigned tvo = (unsigned)(((real && half ? fr * 16 : 0) + (i0 >> 1)) * 16);
#pragma unroll
            for (int ai = 0; ai < 2; ++ai)
#pragma unroll
                for (int m = 0; m < 4; ++m) { const int rl = ai * 128 + m * 16 + rl0; const size_t tuo = real ? (size_t)(half ? 16 * m : (tbase >> 6) + 2 * ai + wr) * 256 : 0;
                    const f32x4 cs0 = ldu<f32x4>(TAB, tuo, tvo), cs1 = ldu<f32x4>(TAB, tuo + 16, tvo);
#pragma unroll
                    for (int bj = 0; bj < 2; ++bj) { const f32x4 p4 = *(const LAS f32x4*)(P + rl * 8 + bj * 4);
                        const float rs = fast_rsq(((p4[0] + p4[1]) + (p4[2] + p4[3])) * (1.0f / 128.0f) + EPS);
                        f32x4 v0 = acc[ai][bj][m][0] * rs, v1 = acc[ai][bj][m][1] * rs;
                        v0[0] *= g1[0]; v0[1] *= g2[0]; v0[2] *= g1[1]; v0[3] *= g2[1]; v1[0] *= g1[2]; v1[1] *= g2[2]; v1[2] *= g1[3]; v1[3] *= g2[3];
                        stu<u32x4>(dst, (size_t)((ai * 128 + m * 16) * ld + bj * 128) * 2, voff, pack8(rope4(v0, cs0), rope4(v1, cs1))); }
                    asm volatile("" ::: "memory"); }
        } else if (pn < PN_GA) {
            bf16_t* dst = VB + (size_t)pm * 256 * 512 + 256 * (pn - PN_GV); const unsigned voff = (unsigned)((rl0 * 512 + cw) * 2);
#pragma unroll
            for (int ai = 0; ai < 2; ++ai)
#pragma unroll
                for (int m = 0; m < 4; ++m)
#pragma unroll
                    for (int bj = 0; bj < 2; ++bj) stu<u32x4>(dst, (size_t)((ai * 128 + m * 16) * 512 + bj * 128) * 2, voff, pack8(acc[ai][bj][m][0], acc[ai][bj][m][1]));
        } else if (pn < PN_KR) {
            const bool isa = pn < PN_GB; const int colt = 256 * (pn - (isa ? PN_GA : PN_GB));
            bf16_t* dst = (pm < MT - 1 ? (isa ? GA : GB) + (size_t)pm * 256 * D : (isa ? GAM : GBM)) + colt; const unsigned voff = (unsigned)((rl0 * D + cw) * 2);
#pragma unroll
            for (int ai = 0; ai < 2; ++ai)
#pragma unroll
                for (int m = 0; m < 4; ++m)
#pragma unroll
                    for (int bj = 0; bj < 2; ++bj) { f32x4 v0 = acc[ai][bj][m][0], v1 = acc[ai][bj][m][1];
#pragma unroll
                        for (int j = 0; j < 4; ++j) { v0[j] = sigmoidf_(v0[j]); v1[j] = sigmoidf_(v1[j]); }
                        stu<u32x4>(dst, (size_t)((ai * 128 + m * 16) * D + bj * 128) * 2, voff, pack8(v0, v1)); }
        } else {
            if (wc < 2) { const int i0 = 16 * wc + 4 * fq; bf16_t* dst = KR + (size_t)pm * 256 * 64; const unsigned voff = (unsigned)((rl0 * 64 + cw) * 2);
#pragma unroll
                for (int ai = 0; ai < 2; ++ai)
#pragma unroll
                    for (int m = 0; m < 4; ++m) {
                        const bool real = pm < MT - 1; const size_t tuo = real ? (size_t)(16 + ((pm & 15) << 8) + ai * 128 + m * 16) * 256 : 0; const unsigned tvo = (unsigned)(((real ? rl0 : fr) * 16 + (i0 >> 1)) * 16);
                        const f32x4 cs0 = ldu<f32x4>(TAB, tuo, tvo), cs1 = ldu<f32x4>(TAB, tuo + 16, tvo);
                        stu<u32x4>(dst, (size_t)((ai * 128 + m * 16) * 64) * 2, voff, pack8(rope4(acc[ai][0][m][0], cs0), rope4(acc[ai][0][m][1], cs1))); } }
        }
    }
};
struct EpiQA {
    static constexpr bool ASWAP = false;
    bf16_t* QA; const float* SS_CQ; const f32x4* TAB;
    __device__ __forceinline__ void operator()(const AccT& acc, const Unit& u, int wr, int wc, int fr, int fq, LAS unsigned char*) const {
        const int pn = u.pn, pm = u.pm, rl0 = wr * 64 + fr, cw = wc * 32 + 8 * fq, i0 = 16 * (wc & 1) + 4 * fq;
        bf16_t* dst = QA + (size_t)pm * 256 * 3072 + pn * 256; const unsigned voff = (unsigned)((rl0 * 3072 + cw) * 2); const float* ss = SS_CQ + (size_t)pm * 256 * 16;
#pragma unroll
        for (int ai = 0; ai < 2; ++ai)
#pragma unroll
            for (int m = 0; m < 4; ++m) { const int rl = ai * 128 + m * 16 + rl0; const bool real = pm < MT - 1;
                const size_t tuo = real ? (size_t)(16 + ((pm & 15) << 8) + ai * 128 + m * 16) * 256 : 0; const unsigned tvo = (unsigned)(((real ? rl0 : fr) * 16 + (i0 >> 1)) * 16);
                float q; { const f32x4 p4 = *(const f32x4*)(ss + rl * 16 + fq * 4); q = (p4[0] + p4[1]) + (p4[2] + p4[3]); q += __shfl_xor(q, 16); q += __shfl_xor(q, 32); }
                const float rs = fast_rsq(q * (1.0f / 1024.0f) + EPS);
                const f32x4 cs0 = ldu<f32x4>(TAB, tuo, tvo), cs1 = ldu<f32x4>(TAB, tuo + 16, tvo);
#pragma unroll
                for (int bj = 0; bj < 2; ++bj) { const int gblk = 4 * pn + 2 * bj + (wc >> 1); f32x4 v0 = acc[ai][bj][m][0] * rs, v1 = acc[ai][bj][m][1] * rs;
                    if (gblk % 3 == 2) { v0 = rope4(v0, cs0); v1 = rope4(v1, cs1); }
                    stu<u32x4>(dst, (size_t)((ai * 128 + m * 16) * 3072 + bj * 128) * 2, voff, pack8(v0, v1)); }
                asm volatile("" ::: "memory"); }
    }
};
struct EpiKV {
    static constexpr bool ASWAP = false;
    bf16_t* KVA; const float* SS_CKV;
    __device__ __forceinline__ void operator()(const AccT& acc, const Unit& u, int wr, int wc, int fr, int fq, LAS unsigned char*) const {
        const int rl0 = wr * 64 + fr, cw = wc * 32 + 8 * fq;
        bf16_t* dst = KVA + (size_t)u.pm * 256 * 4096 + u.pn * 256; const unsigned voff = (unsigned)((rl0 * 4096 + cw) * 2); const float* ss = SS_CKV + (size_t)u.pm * 256 * 8;
#pragma unroll
        for (int ai = 0; ai < 2; ++ai)
#pragma unroll
            for (int m = 0; m < 4; ++m) { float q; { const f32x2 p2 = *(const f32x2*)(ss + (ai * 128 + m * 16 + rl0) * 8 + fq * 2); q = p2[0] + p2[1]; q += __shfl_xor(q, 16); q += __shfl_xor(q, 32); }
                const float rs = fast_rsq(q * (1.0f / 512.0f) + EPS);
#pragma unroll
                for (int bj = 0; bj < 2; ++bj) stu<u32x4>(dst, (size_t)((ai * 128 + m * 16) * 4096 + bj * 128) * 2, voff, pack8(acc[ai][bj][m][0] * rs, acc[ai][bj][m][1] * rs)); }
    }
};
template <int STEP> struct EpiMerge {
    static constexpr bool ASWAP = false;
    bf16_t* MG; bf16_t *GA, *GB, *GAM, *GBM;
    __device__ __forceinline__ void operator()(const AccT& acc, const Unit& u, int wr, int wc, int fr, int fq, LAS unsigned char*) const {
        const unsigned voff = (unsigned)(((wr * 64 + fr) * D + wc * 32 + 8 * fq) * 2); const bool real = u.pm < MT - 1;
        char* ga = (char*)(real ? GA + (size_t)u.pm * 256 * D : GAM) + u.pn * 512; const char* gb = (const char*)(real ? GB + (size_t)u.pm * 256 * D : GBM) + u.pn * 512;
        char* mg = (char*)(MG + (size_t)u.pm * 256 * D) + u.pn * 512;
#pragma unroll
        for (int ai = 0; ai < 2; ++ai)
#pragma unroll
            for (int m = 0; m < 4; ++m) { const size_t uo = (size_t)(ai * 128 + m * 16) * D * 2;
#pragma unroll
                for (int bj = 0; bj < 2; ++bj) {
                    const u32x4 a = *(const u32x4*)(ga + uo + bj * 256 + voff);
                    const f32x4 a0 = {bf_lo(a.x), bf_hi(a.x), bf_lo(a.y), bf_hi(a.y)}, a1 = {bf_lo(a.z), bf_hi(a.z), bf_lo(a.w), bf_hi(a.w)};
                    if constexpr (STEP == 0) { *(u32x4*)(ga + uo + bj * 256 + voff) = pack8(acc[ai][bj][m][0] * a0, acc[ai][bj][m][1] * a1); }
                    else { const u32x4 b = *(const u32x4*)(gb + uo + bj * 256 + voff);
                        const f32x4 s0 = {bf_lo(b.x), bf_hi(b.x), bf_lo(b.y), bf_hi(b.y)}, s1 = {bf_lo(b.z), bf_hi(b.z), bf_lo(b.w), bf_hi(b.w)};
                        *(u32x4*)(mg + uo + bj * 256 + voff) = pack8(a0 + acc[ai][bj][m][0] * s0, a1 + acc[ai][bj][m][1] * s1); } }
                asm volatile("" ::: "memory"); }
    }
};
struct EpiRowSS {
    static constexpr bool ASWAP = false;
    bf16_t* O; float* SS;
    __device__ __forceinline__ void operator()(const AccT& acc, const Unit& u, int wr, int wc, int fr, int fq, LAS unsigned char*) const {
        const int rl0 = wr * 64 + fr, cw = wc * 32 + 8 * fq;
        bf16_t* dst = O + (size_t)u.pm * 256 * D + u.pn * 256; const unsigned voff = (unsigned)((rl0 * D + cw) * 2); float* ss = SS + (size_t)u.pm * 256 * 64 + u.pn * 4 + wc;
#pragma unroll
        for (int ai = 0; ai < 2; ++ai)
#pragma unroll
            for (int m = 0; m < 4; ++m) { float s = 0.f;
#pragma unroll
                for (int bj = 0; bj < 2; ++bj) { s += sumsq8(acc[ai][bj][m][0], acc[ai][bj][m][1]);
                    stu<u32x4>(dst, (size_t)((ai * 128 + m * 16) * D + bj * 128) * 2, voff, pack8(acc[ai][bj][m][0], acc[ai][bj][m][1])); }
                s += __shfl_xor(s, 16); s += __shfl_xor(s, 32);
                if (fq == 0) ss[(ai * 128 + m * 16 + rl0) * 64] = s; }
    }
};
template <int CTRL> __device__ __forceinline__ float dpp_f(float v) { return __int_as_float(__builtin_amdgcn_update_dpp(0, __float_as_int(v), CTRL, 0xf, 0xf, true)); }
struct EpiUp {
    static constexpr bool ASWAP = true;
    bf16_t* F; float *HALOA, *HALOG, *METAA; const float *wconv, *bconv;
    __device__ __forceinline__ void operator()(const AccT& acc, const Unit& u, int wr, int wc, int fr, int fq, LAS unsigned char*) const {
        const int pm = u.pm, pn = u.pn, cw = wc * 32 + 8 * fq, col = pn * 128 + cw;
        f32x4 w0[2], w1[2], w2[2], bb[2];
#pragma unroll
        for (int n = 0; n < 2; ++n) { w0[n] = *(const f32x4*)(wconv + col + 4 * n); w1[n] = *(const f32x4*)(wconv + DFF + col + 4 * n); w2[n] = *(const f32x4*)(wconv + 2 * DFF + col + 4 * n); bb[n] = *(const f32x4*)(bconv + col + 4 * n); }
#pragma unroll
        for (int ai = 0; ai < 2; ++ai)
#pragma unroll
            for (int m = 0; m < 4; ++m) {
                const int g = ai * 4 + m;
                const int wl = g * 16 + fr, row = pm * 256 + wr * 128 + wl;
                f32x4 fo[2];
#pragma unroll
                for (int n = 0; n < 2; ++n) {
                    const f32x4 a = acc[ai][0][m][n];
                    f32x4 pv, nx;
#pragma unroll
                    for (int j = 0; j < 4; ++j) {
                        const float pin = dpp_f<0x111>(a[j]);
                        const float nin = dpp_f<0x101>(a[j]);
                        float pout = 0.f, nout = 0.f;
                        if (g > 0) pout = dpp_f<0x10F>(acc[(g - 1) >> 2][0][(g - 1) & 3][n][j]);
                        if (g < 7) nout = dpp_f<0x11F>(acc[(g + 1) >> 2][0][(g + 1) & 3][n][j]);
                        pv[j] = fr == 0 ? pout : pin; nx[j] = fr == 15 ? nout : nin;
                    }
                    const f32x4 c = pv * w0[n] + a * w1[n] + nx * w2[n] + bb[n];
                    const f32x4 gv = acc[ai][1][m][n];
#pragma unroll
                    for (int j = 0; j < 4; ++j) fo[n][j] = gelu_tanh(c[j]) * gv[j];
                }
                *(u32x4*)(F + (size_t)row * DFF + col) = pack8(fo[0], fo[1]);
                if (g == 0 && fr < 2) { float* h = HALOA + ((size_t)(pm * 8 + wr * 4 + fr)) * DFF + col; *(f32x4*)h = acc[ai][0][m][0]; *(f32x4*)(h + 4) = acc[ai][0][m][1];
                    if (fr == 0) { float* hg = HALOG + ((size_t)(pm * 4 + wr * 2)) * DFF + col; *(f32x4*)hg = acc[ai][1][m][0]; *(f32x4*)(hg + 4) = acc[ai][1][m][1]; } }
                if (g == 7 && fr >= 14) { float* h = HALOA + ((size_t)(pm * 8 + wr * 4 + 2 + (fr - 14))) * DFF + col; *(f32x4*)h = acc[ai][0][m][0]; *(f32x4*)(h + 4) = acc[ai][0][m][1];
                    if (fr == 15) { float* hg = HALOG + ((size_t)(pm * 4 + wr * 2 + 1)) * DFF + col; *(f32x4*)hg = acc[ai][1][m][0]; *(f32x4*)(hg + 4) = acc[ai][1][m][1]; } }
                if (pm == MT - 1 && wr == 0 && g < 6 && fr == 15) { float* h = METAA + (size_t)g * DFF + col; *(f32x4*)h = acc[ai][0][m][0]; *(f32x4*)(h + 4) = acc[ai][0][m][1]; }
            }
    }
};

namespace att {
constexpr int KVBLK = 64, NT = 65;
constexpr int SHM_V = 64 * 128 * 2, SHM_K = 64 * 128 * 2, SHM_R = 64 * 64 * 2;
constexpr int OFF_V = 0, OFF_K = 2 * SHM_V, OFF_R = OFF_K + 2 * SHM_K, OFF_W = OFF_R + 2 * SHM_R, OSTRIDE = 272;
static_assert(OFF_W + 8 * 256 <= RING_BYTES && 8 * 32 * OSTRIDE <= OFF_W, "attention LDS map");
#define KSWZ(row, colB) ((row) * 256 + ((colB) ^ (((row) & 7) << 4)))
#define RSWZ(row, colB) ((row) * 128 + ((colB) ^ (((row) & 7) << 4)))
#define SBAR() __builtin_amdgcn_sched_barrier(0)
__device__ __forceinline__ int crow(int r, int hi) { return (r & 3) + 8 * (r >> 2) + 4 * hi; }
template <int SCALE_X1000000> struct Cst { };
__device__ __forceinline__ void partialSM(f32x16& p0, f32x16& p1, float& m_reg, float& mn, float& alpha, const float C, const float THRS) {
    float pmax = p0[0];
#pragma unroll
    for (int r = 1; r < 16; ++r) pmax = fmaxf(pmax, p0[r]);
#pragma unroll
    for (int r = 0; r < 16; ++r) pmax = fmaxf(pmax, p1[r]);
    { auto rr = __builtin_amdgcn_permlane32_swap(__float_as_uint(pmax), __float_as_uint(pmax), false, false); pmax = fmaxf(__uint_as_float(rr[0]), __uint_as_float(rr[1])); }
    if (__builtin_expect(__all(pmax - m_reg <= THRS), 1)) { mn = m_reg; alpha = 1.f; }
    else { mn = fmaxf(m_reg, pmax); alpha = fast_exp2((m_reg - mn) * C); m_reg = mn; }
    const float mnC = -mn * C;
#pragma unroll
    for (int r = 0; r < 16; ++r) p0[r] = fmaf(p0[r], C, mnC);
#pragma unroll
    for (int r = 0; r < 16; ++r) p1[r] = fmaf(p1[r], C, mnC);
#pragma unroll
    for (int r = 0; r < 16; ++r) p0[r] = fast_exp2(p0[r]);
}
__device__ __forceinline__ void finishSM(f32x16& p0, f32x16& p1, float alpha, float& l_reg, bf16x8& pa0, bf16x8& pa1, bf16x8& pa2, bf16x8& pa3) {
#pragma unroll
    for (int r = 0; r < 16; ++r) p1[r] = fast_exp2(p1[r]);
    float ps = 0;
#pragma unroll
    for (int r = 0; r < 16; ++r) ps += p0[r];
#pragma unroll
    for (int r = 0; r < 16; ++r) ps += p1[r];
    { auto rr = __builtin_amdgcn_permlane32_swap(__float_as_uint(ps), __float_as_uint(ps), false, false); ps = __uint_as_float(rr[0]) + __uint_as_float(rr[1]); }
    l_reg = l_reg * alpha + ps;
#define PK4(P, BASE, OUT) do { unsigned a0 = cvt_pk_bf16(P[BASE + 0], P[BASE + 1]), a1 = cvt_pk_bf16(P[BASE + 2], P[BASE + 3]);   \
    unsigned b0 = cvt_pk_bf16(P[BASE + 4], P[BASE + 5]), b1 = cvt_pk_bf16(P[BASE + 6], P[BASE + 7]);                              \
    auto r0 = __builtin_amdgcn_permlane32_swap(a0, b0, false, false); auto r1 = __builtin_amdgcn_permlane32_swap(a1, b1, false, false); \
    u32x4 w = {r0[0], r1[0], r0[1], r1[1]}; OUT = *reinterpret_cast<bf16x8*>(&w); } while (0)
    PK4(p0, 0, pa0); PK4(p0, 8, pa1); PK4(p1, 0, pa2); PK4(p1, 8, pa3);
#undef PK4
}
template <int NQF> __device__ __forceinline__ void qkt(f32x16& p0, f32x16& p1, const LAS char* Ks, const LAS char* Rs, const bf16x8* qr, int r32, int hi) {
    p0 = f32x16{}; p1 = f32x16{};
#pragma unroll
    for (int d0 = 0; d0 < 8; ++d0) { const int cb = (d0 * 16 + hi * 8) * 2;
        const bf16x8 b0 = *(const LAS bf16x8*)(Ks + KSWZ(r32, cb)), b1 = *(const LAS bf16x8*)(Ks + KSWZ(32 + r32, cb));
        p0 = __builtin_amdgcn_mfma_f32_32x32x16_bf16(b0, qr[d0], p0, 0, 0, 0);
        p1 = __builtin_amdgcn_mfma_f32_32x32x16_bf16(b1, qr[d0], p1, 0, 0, 0); }
    if constexpr (NQF > 8) {
#pragma unroll
        for (int d0 = 0; d0 < NQF - 8; ++d0) { const int cb = (d0 * 16 + hi * 8) * 2;
            const bf16x8 b0 = *(const LAS bf16x8*)(Rs + RSWZ(r32, cb)), b1 = *(const LAS bf16x8*)(Rs + RSWZ(32 + r32, cb));
            p0 = __builtin_amdgcn_mfma_f32_32x32x16_bf16(b0, qr[8 + d0], p0, 0, 0, 0);
            p1 = __builtin_amdgcn_mfma_f32_32x32x16_bf16(b1, qr[8 + d0], p1, 0, 0, 0); }
    }
}
__device__ __forceinline__ int v_st(int k, int c) { const int kk = (k & ~0xC) | ((k & 4) << 1) | ((k & 8) >> 1); return ((kk >> 3) * 4 + (c >> 5)) * 512 + ((kk & 7) * 32 + (c & 31)) * 2; }
__device__ __forceinline__ int v_rd_base(int lane) { return ((lane & 3) << 3) | (((lane >> 2) & 3) << 6) | (((lane >> 4) & 1) << 5) | (((lane >> 5) & 1) << 8); }
constexpr int v_rd_off(int d0, int ks, int half) { return d0 * 512 + ks * 4096 + half * 2048; }
template <int OFF> __device__ __forceinline__ s16x4 tr_read(int vb) { s16x4 r; asm volatile("ds_read_b64_tr_b16 %0, %1 offset:%2" : "=&v"(r) : "v"(vb), "i"(OFF) : "memory"); return r; }
template <int D0> __device__ __forceinline__ void pv_one(f32x16& od, int vb, bf16x8 pa0, bf16x8 pa1, bf16x8 pa2, bf16x8 pa3) {
    const s16x4 l0 = tr_read<v_rd_off(D0, 0, 0)>(vb), h0 = tr_read<v_rd_off(D0, 0, 1)>(vb), l1 = tr_read<v_rd_off(D0, 1, 0)>(vb), h1 = tr_read<v_rd_off(D0, 1, 1)>(vb);
    const s16x4 l2 = tr_read<v_rd_off(D0, 2, 0)>(vb), h2 = tr_read<v_rd_off(D0, 2, 1)>(vb), l3 = tr_read<v_rd_off(D0, 3, 0)>(vb), h3 = tr_read<v_rd_off(D0, 3, 1)>(vb);
    asm volatile("s_waitcnt lgkmcnt(0)" ::: "memory"); SBAR();
#define PK(L, H) (bf16x8){L[0], L[1], L[2], L[3], H[0], H[1], H[2], H[3]}
    od = __builtin_amdgcn_mfma_f32_32x32x16_bf16(pa0, PK(l0, h0), od, 0, 0, 0);
    od = __builtin_amdgcn_mfma_f32_32x32x16_bf16(pa1, PK(l1, h1), od, 0, 0, 0);
    od = __builtin_amdgcn_mfma_f32_32x32x16_bf16(pa2, PK(l2, h2), od, 0, 0, 0);
    od = __builtin_amdgcn_mfma_f32_32x32x16_bf16(pa3, PK(l3, h3), od, 0, 0, 0);
#undef PK
}
__device__ __forceinline__ void pv_d0(f32x16* o, int vb, bf16x8 pa0, bf16x8 pa1, bf16x8 pa2, bf16x8 pa3) {
    pv_one<0>(o[0], vb, pa0, pa1, pa2, pa3); pv_one<1>(o[1], vb, pa0, pa1, pa2, pa3); pv_one<2>(o[2], vb, pa0, pa1, pa2, pa3); pv_one<3>(o[3], vb, pa0, pa1, pa2, pa3);
}
template <int NQF, int LDQ, int LDK, int LDV, int SDEPTH>
__device__ __forceinline__ void attn_unit(const bf16_t* __restrict__ Qw, const bf16_t* __restrict__ Kh, const bf16_t* __restrict__ Vh, const bf16_t* __restrict__ Rh,
                                          int kbase, int mrow, bf16_t* __restrict__ Ob, int orow0, int nrows_valid, LAS char* lds, const float SCALE) {
    int tid_ = threadIdx.x; asm volatile("" : "+v"(tid_));
    const int tid = tid_, wid = __builtin_amdgcn_readfirstlane(tid >> 6), lane = tid & 63, r32 = lane & 31, hi = lane >> 5;
    const float C = SCALE * 1.4426950408889634f, THRS = 8.0f / SCALE;
    LAS char* V_lds = lds + OFF_V; LAS char* K_lds = lds + OFF_K; LAS char* R_lds = lds + OFF_R;
    LAS float* ws = (LAS float*)(lds + OFF_W) + wid * 64; LAS float* li_l = ws; LAS float* al_l = ws + 32;
    float m_reg = -1e30f, l_reg = 0; f32x16 o[4] = {}; bf16x8 qr[NQF];
#pragma unroll
    for (int d0 = 0; d0 < NQF; ++d0) qr[d0] = *(const bf16x8*)(Qw + d0 * 16);
    const int sr = tid >> 4, sc = (tid & 15) * 8, vst0 = v_st(sr, sc), vst1 = v_st(32 + sr, sc);
    const int rr = tid >> 3, rc = (tid & 7) * 8;
    const int vb0 = (int)(uintptr_t)V_lds + v_rd_base(lane);
    struct { bf16x8 vs0, vs1, ks0, ks1, rs; } sr_[SDEPTH];
#define SLOADR(i, r0, r1, r2) do { sr_[i].vs0 = *(const bf16x8*)(Vh + (size_t)(r0) * LDV + sc); sr_[i].vs1 = *(const bf16x8*)(Vh + (size_t)(r1) * LDV + sc); \
    sr_[i].ks0 = *(const bf16x8*)(Kh + (size_t)(r0) * LDK + sc); sr_[i].ks1 = *(const bf16x8*)(Kh + (size_t)(r1) * LDK + sc); \
    if constexpr (NQF > 8) sr_[i].rs = *(const bf16x8*)(Rh + (size_t)(r2) * 64 + rc); } while (0)
#define SLOAD(i, j) SLOADR(i, kbase + ((j) - 1) * 64 + sr, kbase + ((j) - 1) * 64 + 32 + sr, kbase + ((j) - 1) * 64 + rr)
#define SWRITE(b, i) do { *(LAS bf16x8*)(V_lds + (b) * SHM_V + vst0) = sr_[i].vs0; *(LAS bf16x8*)(V_lds + (b) * SHM_V + vst1) = sr_[i].vs1; const int kc = sc * 2; \
    *(LAS bf16x8*)(K_lds + (b) * SHM_K + KSWZ(sr, kc)) = sr_[i].ks0; *(LAS bf16x8*)(K_lds + (b) * SHM_K + KSWZ(32 + sr, kc)) = sr_[i].ks1; \
    if constexpr (NQF > 8) *(LAS bf16x8*)(R_lds + (b) * SHM_R + RSWZ(rr, rc * 2)) = sr_[i].rs; } while (0)
#define SWAIT() do { if constexpr (SDEPTH == 2) { if constexpr (NQF > 8) asm volatile("s_waitcnt vmcnt(5)" ::: "memory"); else asm volatile("s_waitcnt vmcnt(4)" ::: "memory"); } else asm volatile("s_waitcnt vmcnt(0)" ::: "memory"); } while (0)
#define RESC(a) do { if (__any((a) < 1.f)) { if (hi == 0) al_l[r32] = (a); asm volatile("s_waitcnt lgkmcnt(0)" ::: "memory"); \
    _Pragma("unroll") for (int d = 0; d < 4; ++d) _Pragma("unroll") for (int r = 0; r < 16; ++r) o[d][r] *= al_l[crow(r, hi)]; } } while (0)
    f32x16 pA0, pA1, pB0, pB1; float mnA, mnB, alA, alB; bf16x8 pa0, pa1, pa2, pa3;
    constexpr int SE = 0, SO = SDEPTH - 1;
    SLOADR(SE, mrow + (sr & 15), mrow + (sr & 15), mrow + (rr & 15)); asm volatile("s_waitcnt vmcnt(0)" ::: "memory"); SWRITE(0, SE); __syncthreads();
    qkt<NQF>(pA0, pA1, K_lds, R_lds, qr, r32, hi);
#pragma unroll
    for (int r = 8; r < 16; ++r) pA0[r] = -1e30f;
#pragma unroll
    for (int r = 0; r < 16; ++r) pA1[r] = -1e30f;
    partialSM(pA0, pA1, m_reg, mnA, alA, C, THRS);
    SLOAD(SO, 1); if constexpr (SDEPTH == 2) { SLOAD(SE, 2); }
    SWAIT(); SWRITE(1, SO); __syncthreads();
    for (int j = 1; j + 1 < NT; j += 2) {
        SBAR(); qkt<NQF>(pB0, pB1, K_lds + SHM_K, R_lds + SHM_R, qr, r32, hi);
        finishSM(pA0, pA1, alA, l_reg, pa0, pa1, pa2, pa3); SBAR();
        if (SDEPTH == 1 || j + 2 < NT) SLOAD(SO, j + SDEPTH); SBAR();
        pv_d0(o, vb0, pa0, pa1, pa2, pa3); partialSM(pB0, pB1, m_reg, mnB, alB, C, THRS);
        __syncthreads(); SWAIT(); SWRITE(0, SE);
        RESC(alB); __syncthreads();
        SBAR(); qkt<NQF>(pA0, pA1, K_lds, R_lds, qr, r32, hi);
        finishSM(pB0, pB1, alB, l_reg, pa0, pa1, pa2, pa3); SBAR();
        if (j + 1 + SDEPTH < NT) SLOAD(SE, j + 1 + SDEPTH); SBAR();
        pv_d0(o, vb0 + SHM_V, pa0, pa1, pa2, pa3); partialSM(pA0, pA1, m_reg, mnA, alA, C, THRS);
        __syncthreads(); if (j + 2 < NT) { SWAIT(); SWRITE(1, SO); }
        RESC(alA); __syncthreads();
    }
    finishSM(pA0, pA1, alA, l_reg, pa0, pa1, pa2, pa3); SBAR();
    pv_d0(o, vb0, pa0, pa1, pa2, pa3);
    asm volatile("s_waitcnt vmcnt(0)" ::: "memory");
    if (hi == 0) li_l[r32] = l_reg; asm volatile("s_waitcnt lgkmcnt(0)" ::: "memory");
    float rli[16];
#pragma unroll
    for (int r = 0; r < 16; ++r) rli[r] = fast_rcp(li_l[crow(r, hi)]);
    __syncthreads();
    LAS char* ost = lds + wid * (32 * OSTRIDE);
#pragma unroll
    for (int r = 0; r < 16; ++r) { const int orow = crow(r, hi);
#pragma unroll
        for (int d0 = 0; d0 < 4; ++d0) { const unsigned w = cvt_pk_bf16(o[d0][r] * rli[r], 0.f); *(LAS unsigned short*)(ost + orow * OSTRIDE + (d0 * 32 + r32) * 2) = (unsigned short)w; } }
    asm volatile("s_waitcnt lgkmcnt(0)" ::: "memory");
#pragma unroll
    for (int i = 0; i < 8; ++i) { const int c = i * 64 + lane, row = c >> 4, c16 = c & 15;
        const u32x4 v = *(const LAS u32x4*)(ost + row * OSTRIDE + c16 * 16);
        if (row < nrows_valid) *(u32x4*)(Ob + (size_t)(orow0 + row) * D + c16 * 8) = v; }
    asm volatile("s_waitcnt lgkmcnt(0)" ::: "memory");
    __syncthreads();
#undef SLOADR
#undef SLOAD
#undef SWRITE
#undef SWAIT
#undef RESC
}
template <int NQF, int LDQ, int LDK, int LDV>
__device__ __forceinline__ void attn_unit_s1(const bf16_t* __restrict__ Qw, const bf16_t* __restrict__ Kh, const bf16_t* __restrict__ Vh, const bf16_t* __restrict__ Rh,
                                             int kbase, int mrow, bf16_t* __restrict__ Ob, int orow0, int nrows_valid, LAS char* lds, const float SCALE) {
    int tid_ = threadIdx.x; asm volatile("" : "+v"(tid_));
    const int tid = tid_, wid = __builtin_amdgcn_readfirstlane(tid >> 6), lane = tid & 63, r32 = lane & 31, hi = lane >> 5;
    const float C = SCALE * 1.4426950408889634f, THRS = 8.0f / SCALE;
    LAS char* V_lds = lds + OFF_V; LAS char* K_lds = lds + OFF_K; LAS char* R_lds = lds + OFF_R;
    LAS float* ws = (LAS float*)(lds + OFF_W) + wid * 64; LAS float* li_l = ws; LAS float* al_l = ws + 32;
    float m_reg = -1e30f, l_reg = 0; f32x16 o[4] = {}; bf16x8 qr[NQF];
#pragma unroll
    for (int d0 = 0; d0 < NQF; ++d0) qr[d0] = *(const bf16x8*)(Qw + d0 * 16);
    const int sr = tid >> 4, sc = (tid & 15) * 8, vst0 = v_st(sr, sc), vst1 = v_st(32 + sr, sc);
    const int rr = tid >> 3, rc = (tid & 7) * 8;
    const int vb0 = (int)(uintptr_t)V_lds + v_rd_base(lane);
    bf16x8 vs0, vs1, ks0, ks1, rs_;
#define S1LOAD(r0, r1, r2) do { vs0 = *(const bf16x8*)(Vh + (size_t)(r0) * LDV + sc); vs1 = *(const bf16x8*)(Vh + (size_t)(r1) * LDV + sc); \
    ks0 = *(const bf16x8*)(Kh + (size_t)(r0) * LDK + sc); ks1 = *(const bf16x8*)(Kh + (size_t)(r1) * LDK + sc); \
    if constexpr (NQF > 8) rs_ = *(const bf16x8*)(Rh + (size_t)(r2) * 64 + rc); } while (0)
#define S1WRITE(b) do { *(LAS bf16x8*)(V_lds + (b) * SHM_V + vst0) = vs0; *(LAS bf16x8*)(V_lds + (b) * SHM_V + vst1) = vs1; const int kc = sc * 2; \
    *(LAS bf16x8*)(K_lds + (b) * SHM_K + KSWZ(sr, kc)) = ks0; *(LAS bf16x8*)(K_lds + (b) * SHM_K + KSWZ(32 + sr, kc)) = ks1; \
    if constexpr (NQF > 8) *(LAS bf16x8*)(R_lds + (b) * SHM_R + RSWZ(rr, rc * 2)) = rs_; } while (0)
    f32x16 p0, p1; float mn, al; bf16x8 pa0, pa1, pa2, pa3;
    S1LOAD(mrow + (sr & 15), mrow + (sr & 15), mrow + (rr & 15)); asm volatile("s_waitcnt vmcnt(0)" ::: "memory"); S1WRITE(0); __syncthreads();
    for (int j = 0; j < NT; ++j) {
        const int bs = j & 1;
        if (j + 1 < NT) S1LOAD(kbase + j * 64 + sr, kbase + j * 64 + 32 + sr, kbase + j * 64 + rr);
        SBAR(); qkt<NQF>(p0, p1, K_lds + bs * SHM_K, R_lds + bs * SHM_R, qr, r32, hi);
        if (j == 0) {
#pragma unroll
            for (int r = 8; r < 16; ++r) p0[r] = -1e30f;
#pragma unroll
            for (int r = 0; r < 16; ++r) p1[r] = -1e30f;
        }
        partialSM(p0, p1, m_reg, mn, al, C, THRS);
        if (__any(al < 1.f)) { if (hi == 0) al_l[r32] = al; asm volatile("s_waitcnt lgkmcnt(0)" ::: "memory");
#pragma unroll
            for (int d = 0; d < 4; ++d)
#pragma unroll
                for (int r = 0; r < 16; ++r) o[d][r] *= al_l[crow(r, hi)]; }
        finishSM(p0, p1, al, l_reg, pa0, pa1, pa2, pa3); SBAR();
        pv_d0(o, vb0 + bs * SHM_V, pa0, pa1, pa2, pa3);
        if (j + 1 < NT) { asm volatile("s_waitcnt vmcnt(0)" ::: "memory"); S1WRITE(bs ^ 1); }
        __syncthreads();
    }
    if (hi == 0) li_l[r32] = l_reg; asm volatile("s_waitcnt lgkmcnt(0)" ::: "memory");
    float rli[16];
#pragma unroll
    for (int r = 0; r < 16; ++r) rli[r] = fast_rcp(li_l[crow(r, hi)]);
    LAS char* ost = lds + wid * (32 * OSTRIDE);
#pragma unroll
    for (int r = 0; r < 16; ++r) { const int orow = crow(r, hi);
#pragma unroll
        for (int d0 = 0; d0 < 4; ++d0) { const unsigned w = cvt_pk_bf16(o[d0][r] * rli[r], 0.f); *(LAS unsigned short*)(ost + orow * OSTRIDE + (d0 * 32 + r32) * 2) = (unsigned short)w; } }
    asm volatile("s_waitcnt lgkmcnt(0)" ::: "memory");
#pragma unroll
    for (int i = 0; i < 8; ++i) { const int c = i * 64 + lane, row = c >> 4, c16 = c & 15;
        const u32x4 v = *(const LAS u32x4*)(ost + row * OSTRIDE + c16 * 16);
        if (row < nrows_valid) *(u32x4*)(Ob + (size_t)(orow0 + row) * D + c16 * 8) = v; }
    asm volatile("s_waitcnt lgkmcnt(0)" ::: "memory");
    __syncthreads();
#undef S1LOAD
#undef S1WRITE
}
}

#define XB_TMO      128
#define XB_XCNT(j)  (256  + 64 * (j))
#define XB_XSUB(j)  (1280 + 64 * (j))
#define XB_XGEN(j)  (2304 + 64 * (j))
#define XB_TOP      3328
#define XB_TOPGEN   3392
#define XCD_BAR_WORDS 3456
#define XB_SPIN_CAP (1u << 18)
__device__ __forceinline__ unsigned xb_ld(unsigned* p)              { return __hip_atomic_load(p, __ATOMIC_RELAXED, __HIP_MEMORY_SCOPE_AGENT); }
__device__ __forceinline__ unsigned xb_add(unsigned* p, unsigned v) { return __hip_atomic_fetch_add(p, v, __ATOMIC_RELAXED, __HIP_MEMORY_SCOPE_AGENT); }
__device__ __forceinline__ unsigned xb_xcc_id() { return (unsigned)__builtin_amdgcn_s_getreg((3 << 11) | 20) & 0xFu; }
#define XB_SPIN(cond, bar) do { unsigned _sp = 0; while (cond) { __builtin_amdgcn_s_sleep(1); \
    if ((++_sp & 255u) == 0u) { if (xb_ld(&(bar)[XB_TMO])) break; if (_sp > XB_SPIN_CAP) { atomicAdd(&(bar)[XB_TMO], 1u); break; } } } } while (0)
struct XcdBarrier { unsigned* bar; unsigned x; volatile LAS unsigned* st; };
__device__ __forceinline__ XcdBarrier xcd_barrier_post(unsigned* bar, volatile LAS unsigned* st) {
    XcdBarrier b; b.bar = bar; b.x = xb_xcc_id(); b.st = st;
    if (threadIdx.x == 0) (void)xb_add(&bar[XB_XCNT(b.x)], 1u);
    return b;
}
__device__ __forceinline__ void xcd_barrier_complete(unsigned* bar, unsigned x, unsigned& nloc, unsigned& nx) {
    const unsigned G = gridDim.x * gridDim.y * gridDim.z;
    unsigned sum, cnt, mine, sp = 0u;
    for (;;) {
        sum = 0u; cnt = 0u; mine = 0u;
#pragma unroll
        for (unsigned j = 0; j < 16; ++j) { const unsigned c = xb_ld(&bar[XB_XCNT(j)]); sum += c; cnt += (c > 0u) ? 1u : 0u; mine = (j == x) ? c : mine; }
        if (sum == G) break;
        __builtin_amdgcn_s_sleep(1);
        if ((++sp & 255u) == 0u) { if (xb_ld(&bar[XB_TMO])) break; if (sp > XB_SPIN_CAP) { atomicAdd(&bar[XB_TMO], 1u); break; } }
    }
    nloc = mine > 0u ? mine : 1u; nx = cnt > 0u ? cnt : 1u;
}
__device__ __forceinline__ void xcd_barrier(const XcdBarrier& b) {
    asm volatile("s_waitcnt vmcnt(0)" ::: "memory");
    __syncthreads();
    if (threadIdx.x == 0) {
        unsigned* bar = b.bar;
        __builtin_amdgcn_s_waitcnt(0);
        unsigned nloc = b.st[0], nx = b.st[1];
        if (nloc == 0u) { xcd_barrier_complete(bar, b.x, nloc, nx); b.st[0] = nloc; b.st[1] = nx; }
        const unsigned old = xb_add(&bar[XB_XSUB(b.x)], 1u);
        const unsigned gen = old / nloc;
        if (old + 1u == (gen + 1u) * nloc) {
            __builtin_amdgcn_fence(__ATOMIC_RELEASE, "agent");
            asm volatile("s_waitcnt vmcnt(0)" ::: "memory");
            const unsigned og = xb_add(&bar[XB_TOP], 1u);
            const unsigned tg = og / nx;
            if (og + 1u == (tg + 1u) * nx) xb_add(&bar[XB_TOPGEN], 1u);
            else XB_SPIN(xb_ld(&bar[XB_TOPGEN]) == tg, bar);
            __builtin_amdgcn_fence(__ATOMIC_ACQUIRE, "agent");
            xb_add(&bar[XB_XGEN(b.x)], 1u);
            asm volatile("s_waitcnt vmcnt(0)" ::: "memory");
        } else {
            XB_SPIN(xb_ld(&bar[XB_XGEN(b.x)]) == gen, bar);
            __builtin_amdgcn_fence(__ATOMIC_ACQUIRE, "agent");
            asm volatile("s_waitcnt vmcnt(0)" ::: "memory");
        }
    }
    __syncthreads();
}

struct Args {
    const float* in[21];
    float* out; unsigned char* ws;
    int ph_lo, ph_hi;
};
enum { IN_XP = 0, IN_XS, IN_META, IN_G_PRE_MIX, IN_W_IN, IN_G_CQ, IN_W_UQ, IN_G_CKV, IN_W_UKV, IN_G_QN, IN_G_KN, IN_W_PA, IN_W_PB, IN_W_O, IN_G_POST_MIX, IN_G_PRE_FFN, IN_W_UP, IN_W_CONV, IN_B_CONV, IN_W_DOWN, IN_G_POST_FFN };
constexpr int NPHASE = 11;

__device__ __forceinline__ int pr64(int d) { return d < 32 ? 2 * d : 2 * (d - 32) + 1; }
__device__ __forceinline__ int pd128(int d) { return (d & 64) + pr64(d & 63); }
__device__ __forceinline__ int dmap(int kind, int n) {
    if (kind == 1) {
        if (n < 1536) return n;
        if (n < 1600) return 12800 + pr64(n - 1536);
        if (n < 3648) { const int q = n - 1600; return 1536 + (q & ~127) + pd128(q & 127); }
        if (n < 4160) { const int q = n - 3648; return 3584 + (q & ~127) + pd128(q & 127); }
        if (n < 4672) return 4096 + (n - 4160);
        if (n < 8768) return 4608 + (n - 4672);
        return 8704 + (n - 8768);
    }
    if (kind == 2) { const int h = n / 192, d = n - h * 192; return d < 128 ? n : h * 192 + 128 + pr64(d - 128); }
    if (kind == 3) { return n < DFF ? ((n >> 7) << 8) + (n & 127) : (((n - DFF) >> 7) << 8) + 128 + ((n - DFF) & 127); }
    return n;
}
__device__ __forceinline__ void conv_item(const float* __restrict__ W, int N, bf16_t* __restrict__ WT, int ldk, int kofs, const float* __restrict__ g, int kind, int item, LAS float* scr, int lane) {
    const int nblk = N >> 6, kb = item / nblk, nb = item - kb * nblk, k0 = kb * 64, n0 = nb * 64;
    const int n4 = (lane & 15) * 4;
#pragma unroll 4
    for (int i = 0; i < 16; ++i) { const int kk = (lane >> 4) + 4 * i; f32x4 v = *(const f32x4*)(W + (size_t)(k0 + kk) * N + n0 + n4);
        if (g) v = v * g[k0 + kk];
        LAS float* s = scr + kk * 65 + n4; s[0] = v[0]; s[1] = v[1]; s[2] = v[2]; s[3] = v[3]; }
    asm volatile("s_waitcnt lgkmcnt(0)" ::: "memory");
    const int c = lane & 7;
#pragma unroll
    for (int p = 0; p < 8; ++p) { const int n = (lane >> 3) + 8 * p; const LAS float* s = scr + (8 * c) * 65 + n;
        u32x4 o; o.x = cvt_pk_bf16(s[0], s[65]); o.y = cvt_pk_bf16(s[2 * 65], s[3 * 65]); o.z = cvt_pk_bf16(s[4 * 65], s[5 * 65]); o.w = cvt_pk_bf16(s[6 * 65], s[7 * 65]);
        *(u32x4*)(WT + (size_t)dmap(kind, n0 + n) * ldk + kofs + k0 + 8 * c) = o; }
    asm volatile("s_waitcnt lgkmcnt(0)" ::: "memory");
}

__global__ void __launch_bounds__(512, 2) fwd(Args args) {
    extern __shared__ __attribute__((aligned(16))) unsigned char lds_raw[];
    LAS unsigned char* lds = (LAS unsigned char*)lds_raw;
    volatile LAS unsigned* MISC = (volatile LAS unsigned*)(lds + MISC_OFF);
#define TID_HERE() ({ int t_ = threadIdx.x; asm volatile("" : "+v"(t_)); t_; })
    const int wave = __builtin_amdgcn_readfirstlane((int)threadIdx.x >> 6);
    const int G = gridDim.x, bx = blockIdx.x;
    const int vcu = (G % 8 == 0) ? (bx % 8) * (G / 8) + bx / 8 : bx;
    unsigned char* ws = args.ws;
    unsigned* ctl = (unsigned*)(ws + WS_CTL);
    for (int u = threadIdx.x; u < (LDS_BYTES - MISC_OFF) / 4; u += 512) ((LAS unsigned*)(lds + MISC_OFF))[u] = 0u;
    __syncthreads();
    XcdBarrier bar; bar.bar = ctl + CW_BAR; bar.x = 0; bar.st = nullptr;
#if MK_ONE_LAUNCH
    bar = xcd_barrier_post(ctl + CW_BAR, MISC + 8);
#define SEAM() xcd_barrier(bar)
#else
#define SEAM() do { } while (0)
#endif
    (void)bar;
    const int lo = args.ph_lo, hi = args.ph_hi;
#ifndef PH_MASK
#define PH_MASK 0x7ff
#endif
#define IN(k) ((((PH_MASK) >> (k)) & 1) && lo <= (k) && (k) < hi)
#define BOTH(k) (IN(k) && IN((k) + 1))
    bf16_t* Win_t = (bf16_t*)(ws + WS_WIN); bf16_t* Wuq_t = (bf16_t*)(ws + WS_WUQ); bf16_t* Wukv_t = (bf16_t*)(ws + WS_WUKV); bf16_t* Wp_t = (bf16_t*)(ws + WS_WP);
    bf16_t* Wo_t = (bf16_t*)(ws + WS_WO); bf16_t* Wup_t = (bf16_t*)(ws + WS_WUP); bf16_t* Wdn_t = (bf16_t*)(ws + WS_WDN);
    bf16_t* U = (bf16_t*)(ws + WS_U); bf16_t* OB = (bf16_t*)(ws + WS_U); bf16_t* U2 = (bf16_t*)(ws + WS_U); bf16_t* DD = (bf16_t*)(ws + WS_U);
    bf16_t* ZCQ = (bf16_t*)(ws + WS_ZCQ); bf16_t* ZCKV = (bf16_t*)(ws + WS_ZCKV); bf16_t* QB = (bf16_t*)(ws + WS_QB); bf16_t* KB = (bf16_t*)(ws + WS_KB); bf16_t* VB = (bf16_t*)(ws + WS_VB);
    bf16_t* KR = (bf16_t*)(ws + WS_KR); bf16_t* QA = (bf16_t*)(ws + WS_QA); bf16_t* KVA = (bf16_t*)(ws + WS_KVA); bf16_t* MG = (bf16_t*)(ws + WS_MG); bf16_t* TT = (bf16_t*)(ws + WS_T);
    bf16_t* F = (bf16_t*)(ws + WS_F); float* HALOA = (float*)(ws + WS_HALOA); float* HALOG = (float*)(ws + WS_HALOG); float* METAA = (float*)(ws + WS_METAA);
    bf16_t* GAM = (bf16_t*)(ws + WS_GAM); bf16_t* GBM = (bf16_t*)(ws + WS_GBM); float* H1M = (float*)(ws + WS_H1M);
    bf16_t* GA = (bf16_t*)args.out; bf16_t* GB = (bf16_t*)args.out + (size_t)MREAL * D;
    float* SS_CQ = (float*)(ws + WS_SSP + SSP_CQ); float* SS_CKV = (float*)(ws + WS_SSP + SSP_CKV); float* SS_T = (float*)(ws + WS_SSP + SSP_T); float* SS_D = (float*)(ws + WS_SSP + SSP_D);
    const f32x4* TAB = (const f32x4*)(ws + WS_TAB);
    const int gw = vcu * 8 + wave, NGW = G * 8;

    if (IN(0)) {
        const int lane = TID_HERE() & 63;
        LAS float* scr = (LAS float*)(lds + wave * 16640);
        constexpr int I_IN = 64 * (12864 / 64), I_UQ = 16 * (3072 / 64), I_UKV = 8 * (4096 / 64), I_PA = 32 * 64, I_PB = 32 * 64, I_O = 64 * 64, I_UP = 64 * (22016 / 64), I_DN = (DFF / 64) * 64;
        constexpr int NITEMS = I_IN + I_UQ + I_UKV + I_PA + I_PB + I_O + I_UP + I_DN;
        for (int it = gw; it < NITEMS; it += NGW) {
            int r = it;
            if (r < I_IN) { conv_item(args.in[IN_W_IN], 12864, Win_t, D, 0, nullptr, 1, r, scr, lane); continue; } r -= I_IN;
            if (r < I_UQ) { conv_item(args.in[IN_W_UQ], 3072, Wuq_t, 1024, 0, args.in[IN_G_CQ], 2, r, scr, lane); continue; } r -= I_UQ;
            if (r < I_UKV) { conv_item(args.in[IN_W_UKV], 4096, Wukv_t, 512, 0, args.in[IN_G_CKV], 0, r, scr, lane); continue; } r -= I_UKV;
            if (r < I_PA) { conv_item(args.in[IN_W_PA], 4096, Wp_t, 4096, 0, nullptr, 0, r, scr, lane); continue; } r -= I_PA;
            if (r < I_PB) { conv_item(args.in[IN_W_PB], 4096, Wp_t, 4096, 2048, nullptr, 0, r, scr, lane); continue; } r -= I_PB;
            if (r < I_O) { conv_item(args.in[IN_W_O], 4096, Wo_t, 4096, 0, nullptr, 0, r, scr, lane); continue; } r -= I_O;
            if (r < I_UP) { conv_item(args.in[IN_W_UP], 22016, Wup_t, 4096, 0, nullptr, 3, r, scr, lane); continue; } r -= I_UP;
            conv_item(args.in[IN_W_DOWN], 4096, Wdn_t, DFF, 0, nullptr, 0, r, scr, lane);
        }
        for (int i = gw * 64 + lane; i < 192 * D / 8; i += NGW * 64) *(u32x4*)(Win_t + (size_t)12864 * D + (size_t)i * 8) = (u32x4){0u, 0u, 0u, 0u};
        for (int e = gw * 64 + lane; e < LSEQ * 32; e += NGW * 64) { const int p = e >> 5, i = e & 31;
            const float inv = exp2f(-(float)i * (13.287712379549449f / 32.0f)); const float ang = (float)p * inv;
            const double rev = (double)ang * 0.15915494309189535; const float fr_ = (float)(rev - rint(rev));
            ((float*)(ws + WS_TAB))[(size_t)e * 2] = __builtin_amdgcn_cosf(fr_); ((float*)(ws + WS_TAB))[(size_t)e * 2 + 1] = __builtin_amdgcn_sinf(fr_); }
        const float* gpm = args.in[IN_G_PRE_MIX];
        for (int R = gw; R < M; R += NGW) {
            const float* src = R < 2 * SEQ ? args.in[IN_XP] + (size_t)R * D : (R < MREAL ? args.in[IN_XS] + (size_t)(R - 2 * SEQ) * D : (R < MREAL + 96 ? args.in[IN_META] + (size_t)((R - MREAL) & 15) * D : nullptr));
            f32x4 v[16]; float s = 0.f;
#pragma unroll
            for (int j = 0; j < 16; ++j) { v[j] = src ? *(const f32x4*)(src + j * 256 + lane * 4) : (f32x4){0.f, 0.f, 0.f, 0.f}; s += (v[j][0] * v[j][0] + v[j][1] * v[j][1]) + (v[j][2] * v[j][2] + v[j][3] * v[j][3]); }
            const float rs = fast_rsq(wave_sum(s) * (1.0f / D) + EPS);
#pragma unroll
            for (int j = 0; j < 16; ++j) { const f32x4 gg = *(const f32x4*)(gpm + j * 256 + lane * 4); const f32x4 y = v[j] * rs * gg;
                u32x2 w; w.x = cvt_pk_bf16(y[0], y[1]); w.y = cvt_pk_bf16(y[2], y[3]); *(u32x2*)(U + (size_t)R * D + j * 256 + lane * 4) = w; }
        }
        asm volatile("s_waitcnt vmcnt(0) lgkmcnt(0)" ::: "memory"); __syncthreads();
        if (BOTH(0)) SEAM();
    }
    if (IN(1)) {
        pg8::Gemm g{U, Win_t, M, DINP, D, D}; pg8::StaticOrder S; S.init(M, DINP, G, bx);
        EpiP1 E{ws, GA, args.in[IN_G_QN], args.in[IN_G_KN]};
        pg8::gemm_phase<EpiP1>(lds, lds + EPI_OFF, g, S, E);
        if (BOTH(1)) SEAM();
    }
    if (IN(2)) {
        { pg8::Gemm g{ZCQ, Wuq_t, M, 3072, 1024, 1024}; pg8::StaticOrder S; S.init(M, 3072, G, bx); EpiQA E{QA, SS_CQ, TAB}; pg8::gemm_phase<EpiQA>(lds, lds + EPI_OFF, g, S, E); }
        { pg8::Gemm g{ZCKV, Wukv_t, M, 4096, 512, 512}; pg8::StaticOrder S; S.init(M, 4096, G, bx); EpiKV E{KVA, SS_CKV}; pg8::gemm_phase<EpiKV>(lds, lds + EPI_OFF, g, S, E); }
        if (BOTH(2)) SEAM();
    }
    if (IN(3)) {
        constexpr int NU1 = NBATCH * 16 * 17;
        for (int ui = vcu; ui < NU1; ui += G) {
            const int lane = TID_HERE() & 63, r32 = lane & 31, hi = lane >> 5;
            const int qb = ui % 17, h = (ui / 17) & 15, b = ui / (17 * 16); const bool meta = qb == 16;
            const int q0 = meta ? MREAL + 16 * b : b * SEQ + qb * 256, orow0 = q0 + (meta ? 0 : 32 * wave), nval = meta ? (wave == 0 ? 16 : 0) : 32;
            att::attn_unit_s1<12, 3072, 4096, 4096>(QA + (size_t)(orow0 + r32) * 3072 + h * 192 + hi * 8, KVA + h * 256, KVA + h * 256 + 128, KR, b * SEQ, MREAL + 16 * b, OB + h * 128, orow0, nval, (LAS char*)lds, 0.07216878364870322f);
        }
        for (int ui = (vcu + 192) % G; ui < NU1; ui += G) {
            const int lane = TID_HERE() & 63, r32 = lane & 31, hi = lane >> 5;
            const int qb = ui % 17, h = (ui / 17) & 15, b = ui / (17 * 16); const bool meta = qb == 16;
            const int q0 = meta ? MREAL + 16 * b : b * SEQ + qb * 256, orow0 = q0 + (meta ? 0 : 32 * wave), nval = meta ? (wave == 0 ? 16 : 0) : 32;
            att::attn_unit<8, 2048, 512, 512, 2>(QB + (size_t)(orow0 + r32) * 2048 + h * 128 + hi * 8, KB + (h >> 2) * 128, VB + (h >> 2) * 128, nullptr, b * SEQ, MREAL + 16 * b, OB + 2048 + h * 128, orow0, nval, (LAS char*)lds, 0.08838834764831845f);
        }
        if (BOTH(3)) SEAM();
    }
#ifdef DBG_STOP_AFTER
    if (DBG_STOP_AFTER == 3) {
        const int lane = TID_HERE() & 63;
        for (int R = gw; R < MREAL; R += NGW) for (int j = 0; j < 8; ++j) { const int c = j * 512 + lane * 8; const u32x4 t = *(const u32x4*)(OB + (size_t)R * D + c);
            *(f32x4*)(args.out + (size_t)R * D + c) = (f32x4){bf_lo(t.x), bf_hi(t.x), bf_lo(t.y), bf_hi(t.y)}; *(f32x4*)(args.out + (size_t)R * D + c + 4) = (f32x4){bf_lo(t.z), bf_hi(t.z), bf_lo(t.w), bf_hi(t.w)}; }
        return;
    }
#endif
    if (IN(4)) {
        pg8::StaticOrder S; S.init(M, D, G, bx);
        { pg8::Gemm g{OB, Wp_t, M, D, 2048, D}; EpiMerge<0> E{MG, GA, GB, GAM, GBM}; pg8::gemm_phase<EpiMerge<0>>(lds, lds + EPI_OFF, g, S, E); }
        asm volatile("s_waitcnt vmcnt(0)" ::: "memory"); __syncthreads();
        { pg8::Gemm g{OB + 2048, Wp_t + 2048, M, D, 2048, D}; EpiMerge<1> E{MG, GA, GB, GAM, GBM}; pg8::gemm_phase<EpiMerge<1>>(lds, lds + EPI_OFF, g, S, E); }
        if (BOTH(4)) SEAM();
    }
    if (IN(5)) {
        pg8::Gemm g{MG, Wo_t, M, D, D, D}; pg8::StaticOrder S; S.init(M, D, G, bx);
        EpiRowSS E{TT, SS_T};
        pg8::gemm_phase<EpiRowSS>(lds, lds + EPI_OFF, g, S, E);
        if (BOTH(5)) SEAM();
    }
    if (IN(6)) {
        const int lane = TID_HERE() & 63;
        const float* gpo = args.in[IN_G_POST_MIX]; const float* gpf = args.in[IN_G_PRE_FFN];
        for (int R = gw; R < M; R += NGW) {
            if (R >= MREAL + 96) { for (int j = 0; j < 8; ++j) *(u32x4*)(U2 + (size_t)R * D + j * 512 + lane * 8) = (u32x4){0u, 0u, 0u, 0u}; continue; }
            const float* src = R < 2 * SEQ ? args.in[IN_XP] + (size_t)R * D : (R < MREAL ? args.in[IN_XS] + (size_t)(R - 2 * SEQ) * D : args.in[IN_META] + (size_t)((R - MREAL) & 15) * D);
            float* h1 = R < MREAL ? args.out + (size_t)R * D : H1M + (size_t)(R - MREAL) * D;
            const float rs = fast_rsq(wave_sum(SS_T[(size_t)R * 64 + lane]) * (1.0f / D) + EPS);
            f32x4 v[8][2]; float s = 0.f;
#pragma unroll
            for (int j = 0; j < 8; ++j) { const int c = j * 512 + lane * 8; const u32x4 t = *(const u32x4*)(TT + (size_t)R * D + c);
                const f32x4 x0 = *(const f32x4*)(src + c), x1 = *(const f32x4*)(src + c + 4), g0 = *(const f32x4*)(gpo + c), g1 = *(const f32x4*)(gpo + c + 4);
                const f32x4 t0 = {bf_lo(t.x), bf_hi(t.x), bf_lo(t.y), bf_hi(t.y)}, t1 = {bf_lo(t.z), bf_hi(t.z), bf_lo(t.w), bf_hi(t.w)};
                v[j][0] = x0 + t0 * rs * g0; v[j][1] = x1 + t1 * rs * g1;
                *(f32x4*)(h1 + c) = v[j][0]; *(f32x4*)(h1 + c + 4) = v[j][1];
#pragma unroll
                for (int q = 0; q < 4; ++q) s += v[j][0][q] * v[j][0][q] + v[j][1][q] * v[j][1][q]; }
            const float rs2 = fast_rsq(wave_sum(s) * (1.0f / D) + EPS);
#pragma unroll
            for (int j = 0; j < 8; ++j) { const int c = j * 512 + lane * 8; const f32x4 g0 = *(const f32x4*)(gpf + c), g1 = *(const f32x4*)(gpf + c + 4);
                *(u32x4*)(U2 + (size_t)R * D + c) = pack8(v[j][0] * rs2 * g0, v[j][1] * rs2 * g1); }
        }
        if (BOTH(6)) SEAM();
    }
#ifdef DBG_STOP_AFTER
    if (DBG_STOP_AFTER == 6) return;
#endif
    if (IN(7)) {
        pg8::Gemm g{U2, Wup_t, M, 2 * DFF, D, D}; pg8::StaticOrder S; S.init(M, 2 * DFF, G, bx);
        EpiUp E{F, HALOA, HALOG, METAA, args.in[IN_W_CONV], args.in[IN_B_CONV]};
        pg8::gemm_phase<EpiUp>(lds, lds + EPI_OFF, g, S, E);
        if (BOTH(7)) SEAM();
    }
    if (IN(8)) {
        const float* wconv = args.in[IN_W_CONV]; const float* bconv = args.in[IN_B_CONV];
        constexpr int CH = DFF / 4;
        for (int it = (vcu * 512 + TID_HERE()); it < (MT - 1) * 4 * CH; it += G * 512) {
            const int c4 = it % CH, rr = (it / CH) & 3, pm = it / (CH * 4), col = c4 * 4;
            const float* ha = HALOA + (size_t)pm * 8 * DFF + col; const float* hg = HALOG + (size_t)pm * 4 * DFF + col;
            f32x4 pv, cu, nx, gv; const f32x4 z = {0.f, 0.f, 0.f, 0.f};
            if (rr == 0) { pv = (pm & 15) == 0 ? *(const f32x4*)(METAA + (size_t)(pm >> 4) * DFF + col) : *(const f32x4*)(ha - 8 * DFF + 7 * DFF); cu = *(const f32x4*)(ha); nx = *(const f32x4*)(ha + DFF); gv = *(const f32x4*)(hg); }
            else if (rr == 1) { pv = *(const f32x4*)(ha + 2 * DFF); cu = *(const f32x4*)(ha + 3 * DFF); nx = *(const f32x4*)(ha + 4 * DFF); gv = *(const f32x4*)(hg + DFF); }
            else if (rr == 2) { pv = *(const f32x4*)(ha + 3 * DFF); cu = *(const f32x4*)(ha + 4 * DFF); nx = *(const f32x4*)(ha + 5 * DFF); gv = *(const f32x4*)(hg + 2 * DFF); }
            else { pv = *(const f32x4*)(ha + 6 * DFF); cu = *(const f32x4*)(ha + 7 * DFF); nx = (pm & 15) == 15 ? z : *(const f32x4*)(ha + 8 * DFF); gv = *(const f32x4*)(hg + 3 * DFF); }
            const f32x4 c = pv * *(const f32x4*)(wconv + col) + cu * *(const f32x4*)(wconv + DFF + col) + nx * *(const f32x4*)(wconv + 2 * DFF + col) + *(const f32x4*)(bconv + col);
            const int row = pm * 256 + (rr == 0 ? 0 : rr == 1 ? 127 : rr == 2 ? 128 : 255);
            u32x2 w; w.x = cvt_pk_bf16(gelu_tanh(c[0]) * gv[0], gelu_tanh(c[1]) * gv[1]); w.y = cvt_pk_bf16(gelu_tanh(c[2]) * gv[2], gelu_tanh(c[3]) * gv[3]);
            *(u32x2*)(F + (size_t)row * DFF + col) = w;
        }
        if (BOTH(8)) SEAM();
    }
    if (IN(9)) {
        pg8::Gemm g{F, Wdn_t, MREAL, D, DFF, DFF}; pg8::StaticOrder S; S.init(MREAL, D, G, bx);
        EpiRowSS E{DD, SS_D};
        pg8::gemm_phase<EpiRowSS>(lds, lds + EPI_OFF, g, S, E);
        if (BOTH(9)) SEAM();
    }
    if (IN(10)) {
        const int lane = TID_HERE() & 63;
        const float* gpf = args.in[IN_G_POST_FFN];
        for (int R = gw; R < MREAL; R += NGW) {
            const float rs = fast_rsq(wave_sum(SS_D[(size_t)R * 64 + lane]) * (1.0f / D) + EPS); float* o = args.out + (size_t)R * D;
#pragma unroll
            for (int j = 0; j < 8; ++j) { const int c = j * 512 + lane * 8; const u32x4 t = *(const u32x4*)(DD + (size_t)R * D + c);
                const f32x4 g0 = *(const f32x4*)(gpf + c), g1 = *(const f32x4*)(gpf + c + 4);
                const f32x4 t0 = {bf_lo(t.x), bf_hi(t.x), bf_lo(t.y), bf_hi(t.y)}, t1 = {bf_lo(t.z), bf_hi(t.z), bf_lo(t.w), bf_hi(t.w)};
                *(f32x4*)(o + c) = *(const f32x4*)(o + c) + t0 * rs * g0; *(f32x4*)(o + c + 4) = *(const f32x4*)(o + c + 4) + t1 * rs * g1; }
        }
    }
#undef IN
#undef BOTH
#undef SEAM
}

#ifndef DEBUG_CHECK
#define DEBUG_CHECK 0
#endif
#if DEBUG_CHECK
constexpr int NS = 256, NCHK = 16;
constexpr float DBG_TOL = 0.10f;
__host__ __device__ inline int srow_of(int i) {
    if (i < 240) return (int)(((long)i * 24576) / 240) + ((i * 37) % 101);
    const int sp[16] = {0, 127, 128, 255, 4095, 4096, 12288, 24575, 24576 + 15, 24576 + 16 + 15, 24576 + 32 + 15, 24576 + 48 + 15, 24576 + 64 + 15, 24576 + 80 + 15, 24576 + 7, 24576 + 80};
    return sp[i - 240];
}
#define SROW(i) srow_of(i)
constexpr size_t DBG_BASE = 1232 * MiB;
constexpr size_t DBG_ERR = DBG_BASE, DBG_Z = DBG_BASE + 1 * MiB  , DBG_A = DBG_BASE + 15 * MiB  , DBG_C = DBG_BASE + 24 * MiB  , DBG_H1 = DBG_BASE + 27 * MiB  , DBG_B = DBG_BASE + 32 * MiB  , DBG_END = DBG_BASE + 100 * MiB;
static_assert(DBG_END <= 1376 * MiB, "debug map");
__device__ __forceinline__ float bf2f(bf16_t v) { return __uint_as_float(((unsigned)v) << 16); }
__device__ __forceinline__ float block_sum(float v, float* sh) { v = wave_sum(v); __syncthreads(); if ((threadIdx.x & 63) == 0) sh[threadIdx.x >> 6] = v; __syncthreads(); float t = 0.f; for (int i = 0; i < (int)(blockDim.x >> 6); ++i) t += sh[i]; __syncthreads(); return t; }
__device__ __forceinline__ float block_max(float v, float* sh) {
#pragma unroll
    for (int o = 1; o < 64; o <<= 1) v = fmaxf(v, __shfl_xor(v, o));
    __syncthreads(); if ((threadIdx.x & 63) == 0) sh[threadIdx.x >> 6] = v; __syncthreads(); float t = 0.f; for (int i = 0; i < (int)(blockDim.x >> 6); ++i) t = fmaxf(t, sh[i]); __syncthreads(); return t; }
__device__ __forceinline__ void report(unsigned* err, int k, float maxdiff, float ss, int n, float* sh) {
    const float md = block_max(maxdiff, sh), s2 = block_sum(ss, sh);
    if (threadIdx.x == 0) { float e = md / (sqrtf(s2 / (float)n) + 1e-20f); if (!(e == e)) e = 1e30f; atomicMax(err + k, __float_as_uint(e)); }
}
__device__ __forceinline__ void dbg_cs(int p, int i, float& c, float& s) {
    const float inv = powf(10000.0f, -(float)i / 32.0f); const float ang = (float)p * inv; const double rev = (double)ang * 0.15915494309189535; const double fr = rev - rint(rev);
    const float r = (float)(fr * 6.283185307179586); c = cosf(r); s = sinf(r);
}
__device__ __forceinline__ int dbg_pos(int R) { return R < MREAL ? 16 + (R & 4095) : ((R - MREAL) & 15); }
__global__ void __launch_bounds__(256) k_dbg_gemv(const void* X, int xk, const int* rowlist, int ld, int col0, int K, const float* W, int N, float* Y, int rows) {
    const int n = blockIdx.x * 256 + threadIdx.x, s0 = blockIdx.y * 8; if (n >= N) return;
    float acc[8]; const float* xf[8]; const bf16_t* xb[8]; bool ok[8];
#pragma unroll
    for (int i = 0; i < 8; ++i) { acc[i] = 0.f; const int s = s0 + i; int R = s; if (rowlist && s < rows) R = rowlist[s]; ok[i] = s < rows && R >= 0;
        xf[i] = (const float*)X + (size_t)(ok[i] ? s : 0) * K; xb[i] = (const bf16_t*)X + (size_t)(ok[i] ? R : 0) * ld + col0; }
    if (xk == 0) { for (int k = 0; k < K; ++k) { const float w = W[(size_t)k * N + n];
#pragma unroll
            for (int i = 0; i < 8; ++i) acc[i] += xf[i][k] * w; } }
    else { for (int k = 0; k < K; ++k) { const float w = W[(size_t)k * N + n];
#pragma unroll
            for (int i = 0; i < 8; ++i) acc[i] += bf2f(xb[i][k]) * w; } }
#pragma unroll
    for (int i = 0; i < 8; ++i) if (s0 + i < rows) Y[(size_t)(s0 + i) * N + n] = ok[i] ? acc[i] : 0.f;
}
__global__ void __launch_bounds__(256) k_dbg_chk0(const float* xp, const float* xs, const float* meta, const float* g, const bf16_t* U, unsigned* err) {
    __shared__ float sh[8]; const int R = SROW(blockIdx.x);
    const float* src = R < 2 * SEQ ? xp + (size_t)R * D : (R < MREAL ? xs + (size_t)(R - 2 * SEQ) * D : meta + (size_t)((R - MREAL) & 15) * D);
    float ss = 0.f; for (int c = threadIdx.x; c < D; c += 256) ss += src[c] * src[c];
    const float tot = block_sum(ss, sh), rs = 1.0f / sqrtf(tot / D + EPS);
    float md = 0.f, s2 = 0.f; for (int c = threadIdx.x; c < D; c += 256) { const float e = src[c] * rs * g[c]; md = fmaxf(md, fabsf(e - bf2f(U[(size_t)R * D + c]))); s2 += e * e; }
    report(err, 0, md, s2, D, sh);
}
__global__ void __launch_bounds__(256) k_dbg_chk1(const float* Z, const unsigned char* ws, const bf16_t* GAo, const float* g_qn, const float* g_kn, unsigned* err) {
    __shared__ float sh[8]; const int s = blockIdx.x, R = SROW(s), t = threadIdx.x; const float* z = Z + (size_t)s * 12864;
    const bf16_t* ZCQ = (const bf16_t*)(ws + WS_ZCQ); const bf16_t* ZCKV = (const bf16_t*)(ws + WS_ZCKV); const bf16_t* QB = (const bf16_t*)(ws + WS_QB); const bf16_t* KB = (const bf16_t*)(ws + WS_KB); const bf16_t* VB = (const bf16_t*)(ws + WS_VB);
    const bf16_t* KR = (const bf16_t*)(ws + WS_KR); const float* SS_CQ = (const float*)(ws + WS_SSP + SSP_CQ); const float* SS_CKV = (const float*)(ws + WS_SSP + SSP_CKV);
    { float md = 0.f, s2 = 0.f; for (int c = t; c < 1024; c += 256) { const float e = z[c]; md = fmaxf(md, fabsf(e - bf2f(ZCQ[(size_t)R * 1024 + c]))); s2 += e * e; }
      const float tot = block_sum(s2, sh); if (t == 0) { float q = 0.f; for (int i = 0; i < 16; ++i) q += SS_CQ[(size_t)R * 16 + i]; md = fmaxf(md, fabsf(tot - q) / sqrtf(tot)); } report(err, 1, md, s2, 1024, sh); }
    { float md = 0.f, s2 = 0.f; for (int c = t; c < 512; c += 256) { const float e = z[1024 + c]; md = fmaxf(md, fabsf(e - bf2f(ZCKV[(size_t)R * 512 + c]))); s2 += e * e; }
      const float tot = block_sum(s2, sh); if (t == 0) { float q = 0.f; for (int i = 0; i < 8; ++i) q += SS_CKV[(size_t)R * 8 + i]; md = fmaxf(md, fabsf(tot - q) / sqrtf(tot)); } report(err, 1, md, s2, 512, sh); }
    { float md = 0.f, s2 = 0.f; if (t < 32) { float c, sn; dbg_cs(dbg_pos(R), t, c, sn); const float x1 = z[1536 + t], x2 = z[1536 + 32 + t]; const float o1 = x1 * c - x2 * sn, o2 = x1 * sn + x2 * c;
        md = fmaxf(fabsf(o1 - bf2f(KR[(size_t)R * 64 + 2 * t])), fabsf(o2 - bf2f(KR[(size_t)R * 64 + 2 * t + 1]))); s2 = o1 * o1 + o2 * o2; }
      report(err, 2, md, s2, 64, sh); }
    const int tk = R < MREAL ? (R & 4095) : 0, prow = tk >> 6, pcol = tk & 63;
    for (int kind = 0; kind < 2; ++kind) { const int nh = kind ? 4 : 16, zoff = kind ? 3648 : 1600; const bf16_t* dst = kind ? KB : QB; const int ld = kind ? 512 : 2048; const float* gn = kind ? g_kn : g_qn;
        float md = 0.f, s2 = 0.f;
        for (int h = 0; h < nh; ++h) { float q = 0.f; if (t < 128) q = z[zoff + h * 128 + t] * z[zoff + h * 128 + t]; const float tot = block_sum(q, sh), rs = 1.0f / sqrtf(tot / 128.f + EPS);
            if (t < 64) { const int half = t >> 5, i = t & 31; float c, sn; dbg_cs(half ? pcol : prow, i, c, sn);
                const float x1 = z[zoff + h * 128 + half * 64 + i] * rs * gn[half * 64 + i], x2 = z[zoff + h * 128 + half * 64 + 32 + i] * rs * gn[half * 64 + 32 + i];
                const float o1 = x1 * c - x2 * sn, o2 = x1 * sn + x2 * c;
                md = fmaxf(md, fmaxf(fabsf(o1 - bf2f(dst[(size_t)R * ld + h * 128 + half * 64 + 2 * i])), fabsf(o2 - bf2f(dst[(size_t)R * ld + h * 128 + half * 64 + 2 * i + 1])))); s2 += o1 * o1 + o2 * o2; } }
        report(err, 3 + kind, md, s2, nh * 128, sh); }
    { float md = 0.f, s2 = 0.f; for (int c = t; c < 512; c += 256) { const float e = z[4160 + c]; md = fmaxf(md, fabsf(e - bf2f(VB[(size_t)R * 512 + c]))); s2 += e * e; } report(err, 5, md, s2, 512, sh); }
    { float md = 0.f, s2 = 0.f; const bf16_t* ga = R < MREAL ? GAo + (size_t)R * D : (const bf16_t*)(ws + WS_GAM) + (size_t)(R - MREAL) * D; const bf16_t* gb = R < MREAL ? GAo + (size_t)MREAL * D + (size_t)R * D : (const bf16_t*)(ws + WS_GBM) + (size_t)(R - MREAL) * D;
      for (int c = t; c < D; c += 256) { const float ea = 1.0f / (1.0f + expf(-z[4672 + c])), eb = 1.0f / (1.0f + expf(-z[8768 + c])); md = fmaxf(md, fmaxf(fabsf(ea - bf2f(ga[c])), fabsf(eb - bf2f(gb[c])))); s2 += ea * ea + eb * eb; }
      report(err, 6, md, s2, 2 * D, sh); }
}
__global__ void __launch_bounds__(256) k_dbg_prep2(const float* Z, const float* g_cq, const float* g_ckv, float* A) {
    __shared__ float sh[8]; const int s = blockIdx.x, t = threadIdx.x; const float* z = Z + (size_t)s * 12864;
    float q = 0.f; for (int c = t; c < 1024; c += 256) q += z[c] * z[c]; const float r1 = 1.0f / sqrtf(block_sum(q, sh) / 1024.f + EPS);
    q = 0.f; for (int c = t; c < 512; c += 256) q += z[1024 + c] * z[1024 + c]; const float r2 = 1.0f / sqrtf(block_sum(q, sh) / 512.f + EPS);
    for (int c = t; c < 1024; c += 256) A[(size_t)s * 1536 + c] = z[c] * r1 * g_cq[c];
    for (int c = t; c < 512; c += 256) A[(size_t)s * 1536 + 1024 + c] = z[1024 + c] * r2 * g_ckv[c];
}
__global__ void __launch_bounds__(256) k_dbg_split2(const float* A, float* A1, float* A2) { const int s = blockIdx.x; for (int c = threadIdx.x; c < 1024; c += 256) A1[(size_t)s * 1024 + c] = A[(size_t)s * 1536 + c]; for (int c = threadIdx.x; c < 512; c += 256) A2[(size_t)s * 512 + c] = A[(size_t)s * 1536 + 1024 + c]; }
__global__ void __launch_bounds__(256) k_dbg_chk2(const float* YQ  , const float* YKV  , const unsigned char* ws, unsigned* err) {
    __shared__ float sh[8]; const int s = blockIdx.x, R = SROW(s), t = threadIdx.x; const bf16_t* QA = (const bf16_t*)(ws + WS_QA); const bf16_t* KVA = (const bf16_t*)(ws + WS_KVA);
    { float md = 0.f, s2 = 0.f; for (int c = t; c < 3072; c += 256) { const int h = c / 192, d = c - h * 192; const float* y = YQ + (size_t)s * 3072 + h * 192; float e; int dc;
        if (d < 128) { e = y[d]; dc = d; } else { const int i = (d - 128) & 31; float cs, sn; dbg_cs(dbg_pos(R), i, cs, sn); const float x1 = y[128 + i], x2 = y[160 + i];
            if (d < 160) { e = x1 * cs - x2 * sn; dc = 128 + 2 * i; } else { e = x1 * sn + x2 * cs; dc = 128 + 2 * i + 1; } }
        md = fmaxf(md, fabsf(e - bf2f(QA[(size_t)R * 3072 + h * 192 + dc]))); s2 += e * e; }
      report(err, 7, md, s2, 3072, sh); }
    { float md = 0.f, s2 = 0.f; for (int c = t; c < 4096; c += 256) { const float e = YKV[(size_t)s * 4096 + c]; md = fmaxf(md, fabsf(e - bf2f(KVA[(size_t)R * 4096 + c]))); s2 += e * e; } report(err, 8, md, s2, 4096, sh); }
}
__global__ void __launch_bounds__(256) k_dbg_chk3(const unsigned char* ws, unsigned* err) {
    __shared__ float sh[8]; __shared__ float sc[LSEQ]; __shared__ float qv[192];
    const int s = blockIdx.x, R = SROW(s), hh = blockIdx.y, br = hh >> 4, h = hh & 15, t = threadIdx.x;
    const int b = R < MREAL ? R >> 12 : (R - MREAL) >> 4;
    const bf16_t* QA = (const bf16_t*)(ws + WS_QA); const bf16_t* KVA = (const bf16_t*)(ws + WS_KVA); const bf16_t* KR = (const bf16_t*)(ws + WS_KR); const bf16_t* QB = (const bf16_t*)(ws + WS_QB); const bf16_t* KB = (const bf16_t*)(ws + WS_KB);
    const bf16_t* VB = (const bf16_t*)(ws + WS_VB); const bf16_t* O = (const bf16_t*)(ws + WS_U);
    const int dk = br ? 128 : 192; const float scale = br ? 0.08838834764831845f : 0.07216878364870322f;
    if (t < dk) qv[t] = br ? bf2f(QB[(size_t)R * 2048 + h * 128 + t]) : bf2f(QA[(size_t)R * 3072 + h * 192 + t]);
    __syncthreads();
    float mx = -1e30f;
    for (int j = t; j < LSEQ; j += 256) { const int kr = j < 16 ? MREAL + 16 * b + j : b * SEQ + (j - 16); float a = 0.f;
        if (br) { const bf16_t* k = KB + (size_t)kr * 512 + (h >> 2) * 128; for (int d = 0; d < 128; ++d) a += qv[d] * bf2f(k[d]); }
        else { const bf16_t* k = KVA + (size_t)kr * 4096 + h * 256; for (int d = 0; d < 128; ++d) a += qv[d] * bf2f(k[d]); const bf16_t* k2 = KR + (size_t)kr * 64; for (int d = 0; d < 64; ++d) a += qv[128 + d] * bf2f(k2[d]); }
        a *= scale; sc[j] = a; mx = fmaxf(mx, a); }
    { float m2 = -1e30f; for (int j = t; j < LSEQ; j += 256) m2 = fmaxf(m2, sc[j]);
#pragma unroll
      for (int o = 1; o < 64; o <<= 1) m2 = fmaxf(m2, __shfl_xor(m2, o));
      __syncthreads(); if ((t & 63) == 0) sh[t >> 6] = m2; __syncthreads(); mx = fmaxf(fmaxf(sh[0], sh[1]), fmaxf(sh[2], sh[3])); __syncthreads(); }
    float ps = 0.f; for (int j = t; j < LSEQ; j += 256) { const float p = expf(sc[j] - mx); sc[j] = p; ps += p; }
    const float tot = block_sum(ps, sh);
    float md = 0.f, s2 = 0.f;
    if (t < 128) { float a = 0.f; for (int j = 0; j < LSEQ; ++j) { const int kr = j < 16 ? MREAL + 16 * b + j : b * SEQ + (j - 16);
            a += sc[j] * bf2f(br ? VB[(size_t)kr * 512 + (h >> 2) * 128 + t] : KVA[(size_t)kr * 4096 + h * 256 + 128 + t]); }
        a /= tot; md = fabsf(a - bf2f(O[(size_t)R * D + br * 2048 + h * 128 + t])); s2 = a * a; }
    report(err, 9 + br, md, s2, 128, sh);
}
__global__ void __launch_bounds__(256) k_dbg_chk4(const float* YA, const float* YB, const float* Z, const unsigned char* ws, unsigned* err) {
    __shared__ float sh[8]; const int s = blockIdx.x, R = SROW(s), t = threadIdx.x; const bf16_t* MG = (const bf16_t*)(ws + WS_MG); float md = 0.f, s2 = 0.f;
    for (int c = t; c < D; c += 256) { const float sa = 1.0f / (1.0f + expf(-Z[(size_t)s * 12864 + 4672 + c])), sb = 1.0f / (1.0f + expf(-Z[(size_t)s * 12864 + 8768 + c]));
        const float e = sa * YA[(size_t)s * D + c] + sb * YB[(size_t)s * D + c]; md = fmaxf(md, fabsf(e - bf2f(MG[(size_t)R * D + c]))); s2 += e * e; }
    report(err, 11, md, s2, D, sh);
}
__global__ void __launch_bounds__(256) k_dbg_chk5(const float* YT, const float* xp, const float* xs, const float* meta, const float* gpo, const float* gpf, const unsigned char* ws, const float* outp, float* H1S, unsigned* err, int step) {
    __shared__ float sh[8]; const int s = blockIdx.x, R = SROW(s), t = threadIdx.x; const bf16_t* TT = (const bf16_t*)(ws + WS_T); const bf16_t* U2 = (const bf16_t*)(ws + WS_U);
    const float* y = YT + (size_t)s * D;
    if (step == 0) { float md = 0.f, s2 = 0.f; for (int c = t; c < D; c += 256) { md = fmaxf(md, fabsf(y[c] - bf2f(TT[(size_t)R * D + c]))); s2 += y[c] * y[c]; } report(err, 12, md, s2, D, sh); return; }
    const float* src = R < 2 * SEQ ? xp + (size_t)R * D : (R < MREAL ? xs + (size_t)(R - 2 * SEQ) * D : meta + (size_t)((R - MREAL) & 15) * D);
    float q = 0.f; for (int c = t; c < D; c += 256) q += y[c] * y[c]; const float rs = 1.0f / sqrtf(block_sum(q, sh) / D + EPS);
    q = 0.f; for (int c = t; c < D; c += 256) { const float h = src[c] + y[c] * rs * gpo[c]; H1S[(size_t)s * D + c] = h; q += h * h; }
    const float tot = block_sum(q, sh), rs2 = 1.0f / sqrtf(tot / D + EPS);
    const float* h1 = R < MREAL ? outp + (size_t)R * D : (const float*)(ws + WS_H1M) + (size_t)(R - MREAL) * D;
    float md = 0.f, s2 = 0.f; for (int c = t; c < D; c += 256) { const float h = H1S[(size_t)s * D + c], u = h * rs2 * gpf[c]; md = fmaxf(md, fmaxf(fabsf(h - h1[c]), fabsf(u - bf2f(U2[(size_t)R * D + c])))); s2 += h * h; }
    report(err, 13, md, s2, D, sh);
}
__global__ void k_dbg_rows1(int* rl) { if (threadIdx.x < NS) rl[threadIdx.x] = SROW((int)threadIdx.x); }
__global__ void k_dbg_rows3(int* rl) { const int s = threadIdx.x; if (s >= NS) return; const int R = SROW(s);
    if (R >= MREAL) { rl[3 * s] = -1; rl[3 * s + 1] = -1; rl[3 * s + 2] = -1; return; }
    const int t = R & 4095, b = R >> 12; rl[3 * s] = t == 0 ? MREAL + 16 * b + 15 : R - 1; rl[3 * s + 1] = R; rl[3 * s + 2] = t == 4095 ? -1 : R + 1; }
__global__ void __launch_bounds__(256) k_dbg_chk6(const float* UP  , const float* wconv, const float* bconv, const unsigned char* ws, unsigned* err) {
    __shared__ float sh[8]; const int s = blockIdx.x, R = SROW(s), t = threadIdx.x; const bf16_t* F = (const bf16_t*)(ws + WS_F); float md = 0.f, s2 = 0.f;
    if (R < MREAL) for (int c = t; c < DFF; c += 256) { const float ap = UP[(size_t)(3 * s) * 22016 + c], ac = UP[(size_t)(3 * s + 1) * 22016 + c], an = UP[(size_t)(3 * s + 2) * 22016 + c], gv = UP[(size_t)(3 * s + 1) * 22016 + DFF + c];
        const float v = ap * wconv[c] + ac * wconv[DFF + c] + an * wconv[2 * DFF + c] + bconv[c]; const float e = 0.5f * v * (1.0f + tanhf(0.7978845608028654f * (v + 0.044715f * v * v * v))) * gv;
        md = fmaxf(md, fabsf(e - bf2f(F[(size_t)R * DFF + c]))); s2 += e * e; }
    report(err, 14, md, s2, DFF, sh);
}
__global__ void __launch_bounds__(256) k_dbg_chk7(const float* YD, const float* H1S, const float* gpf, const float* outp, unsigned* err) {
    __shared__ float sh[8]; const int s = blockIdx.x, R = SROW(s), t = threadIdx.x; float md = 0.f, s2 = 0.f;
    if (R < MREAL) { const float* y = YD + (size_t)s * D; float q = 0.f; for (int c = t; c < D; c += 256) q += y[c] * y[c]; const float rs = 1.0f / sqrtf(block_sum(q, sh) / D + EPS);
        for (int c = t; c < D; c += 256) { const float e = H1S[(size_t)s * D + c] + y[c] * rs * gpf[c]; md = fmaxf(md, fabsf(e - outp[(size_t)R * D + c])); s2 += e * e; } }
    report(err, 15, md, s2, D, sh);
}
__global__ void __launch_bounds__(256) k_dbg_encode(const unsigned* err, const float* xp, const float* xs, float* outp) {
    int first = -1; for (int k = 0; k < NCHK; ++k) if (__uint_as_float(err[k]) > DBG_TOL) { first = k; break; }
    if (first < 0) return;
    const float sc = 1.0f + 2.0f * (float)(first + 1);
    for (size_t i = (size_t)blockIdx.x * 256 + threadIdx.x; i < (size_t)MREAL * D; i += (size_t)gridDim.x * 256) outp[i] = sc * (i < (size_t)2 * SEQ * D ? xp[i] : xs[i - (size_t)2 * SEQ * D]);
}
__global__ void __launch_bounds__(256) k_dbg_scan1(const unsigned char* ws, const bf16_t* GAo, const float* w_in, unsigned* res) {
    const int w = (blockIdx.x * 256 + threadIdx.x) >> 6, lane = threadIdx.x & 63; if (w >= MT * 51) return;
    const int pm = w / 51, pn = w % 51; if ((pn >= PN_GQ && pn < PN_GV) || pn == PN_KR) return;
    const bf16_t* U = (const bf16_t*)(ws + WS_U); bool bad = false;
    for (int e = 0; e < 8; ++e) { const int rl = (e & 3) == 0 ? 5 : (e & 3) == 1 ? 77 : (e & 3) == 2 ? 133 : 205, cl = (e >> 2) ? 147 + pm % 50 : 19 + pn; const int R = pm * 256 + rl;
        int src, ld; const bf16_t* dst; bool sig = false;
        if (pn < PN_CKV) { src = pn * 256 + cl; dst = (const bf16_t*)(ws + WS_ZCQ) + (size_t)R * 1024 + pn * 256 + cl; }
        else if (pn < PN_GQ) { src = 1024 + (pn - PN_CKV) * 256 + cl; dst = (const bf16_t*)(ws + WS_ZCKV) + (size_t)R * 512 + (pn - PN_CKV) * 256 + cl; }
        else if (pn < PN_GA) { src = 4160 + (pn - PN_GV) * 256 + cl; dst = (const bf16_t*)(ws + WS_VB) + (size_t)R * 512 + (pn - PN_GV) * 256 + cl; }
        else { const bool isa = pn < PN_GB; const int c = (pn - (isa ? PN_GA : PN_GB)) * 256 + cl; src = (isa ? 4672 : 8768) + c; sig = true;
            dst = pm < MT - 1 ? GAo + (isa ? 0 : (size_t)MREAL * D) + (size_t)R * D + c : (const bf16_t*)(ws + (isa ? WS_GAM : WS_GBM)) + (size_t)rl * D + c; }
        (void)ld; float a = 0.f; for (int k = lane; k < D; k += 64) a += bf2f(U[(size_t)R * D + k]) * w_in[(size_t)k * 12864 + src];
        a = wave_sum(a); if (sig) a = 1.0f / (1.0f + expf(-a));
        if (!(fabsf(a - bf2f(*dst)) <= 0.03f + 0.02f * fabsf(a))) bad = true; }
    if (lane == 0 && bad) { atomicAdd(res, 1u); atomicMin(res + 1, (unsigned)(pm * 64 + pn)); }
}
__global__ void __launch_bounds__(256) k_dbg_report2(const unsigned* res, float* outp) {
    const unsigned cA = res[0] > 89u ? 89u : res[0]; const unsigned first = res[1]; const unsigned cB = res[0] ? (first >> 6) : 0u;
    const float V = 100.0f * (10.0f + (float)cA); const double T = 100.0 * (10.0 + (double)cB); const size_t n1 = (size_t)(T * 3.0 * 33554432.0 / ((double)V * V));
    for (size_t i = (size_t)blockIdx.x * 256 + threadIdx.x; i < (size_t)MREAL * D; i += (size_t)gridDim.x * 256) outp[i] = i < n1 ? V : 0.f;
}
__global__ void __launch_bounds__(256) k_dbg_gateprobe(const float* Z, const unsigned char* ws, const bf16_t* GAo, unsigned* res) {
    const int s = blockIdx.x, R = SROW(s), t = threadIdx.x; __shared__ unsigned anyb;
    if (t == 0) anyb = 0u; __syncthreads();
    const bf16_t* ga = R < MREAL ? GAo + (size_t)R * D : (const bf16_t*)(ws + WS_GAM) + (size_t)(R - MREAL) * D; const bf16_t* gb = R < MREAL ? GAo + (size_t)MREAL * D + (size_t)R * D : (const bf16_t*)(ws + WS_GBM) + (size_t)(R - MREAL) * D;
    const int rl = R < MREAL ? (R & 255) : (R - MREAL);
    for (int c = t; c < 2 * D; c += 256) { const bool isb = c >= D; const int cc = isb ? c - D : c; const float e = 1.0f / (1.0f + expf(-Z[(size_t)s * 12864 + (isb ? 8768 : 4672) + cc])); const float g = bf2f(isb ? gb[cc] : ga[cc]);
        if (!(fabsf(e - g) <= 0.05f)) { const int tc = c & 255;
            atomicOr(res + 8, 1u << (rl & 15)); atomicOr(res + 9, 1u << ((rl >> 4) & 3)); atomicOr(res + 10, 1u << (rl >> 7)); atomicOr(res + 11, 1u << ((rl >> 6) & 1));
            atomicOr(res + 12, 1u << ((tc >> 5) & 3)); atomicOr(res + 13, 1u << (tc >> 7)); atomicOr(res + 14, 1u << ((tc >> 3) & 3)); atomicOr(res + 15, 1u << ((tc >> 2) & 1)); atomicAdd(res + 16, 1u); anyb = 1u; } }
    __syncthreads(); if (t == 0 && anyb) atomicAdd(res + 17, 1u);
}
__global__ void k_dbg_gatedecode(unsigned* res) {
    res[0] = res[8] & 63u; res[1] = (res[8] >> 6) & 63u; res[2] = ((res[8] >> 12) & 15u) | ((res[10] & 3u) << 4); res[3] = (res[9] & 15u) | ((res[11] & 3u) << 4);
    res[4] = (res[12] & 15u) | ((res[13] & 3u) << 4); res[5] = (res[14] & 15u) | ((res[15] & 3u) << 4); res[6] = res[17] > 63u ? 63u : res[17]; unsigned l = 0; while ((1u << l) < res[16] && l < 31) ++l; res[7] = l;
}
__global__ void __launch_bounds__(256) k_dbg_report2b(const unsigned* res, float* outp, int which) {
    const unsigned cA = res[which * 2] > 89u ? 89u : res[which * 2], cB = res[which * 2 + 1];
    const float V = 100.0f * (10.0f + (float)cA); const double T = 100.0 * (10.0 + (double)cB); const size_t n1 = (size_t)(T * 3.0 * 33554432.0 / ((double)V * V));
    for (size_t i = (size_t)blockIdx.x * 256 + threadIdx.x; i < (size_t)MREAL * D; i += (size_t)gridDim.x * 256) outp[i] = i < n1 ? V : 0.f;
}
constexpr size_t DBG_SIG = DBG_BASE + 100 * MiB;
constexpr int SIG_ROWS = 131072, NPH_SIG = 24;
__global__ void __launch_bounds__(256) k_dbg_sig(const void* base, int isf32, int nrows, int rowlen, float* sig  , int row_off, int compare, unsigned* cnt) {
    const int w = (blockIdx.x * 256 + threadIdx.x) >> 6, lane = threadIdx.x & 63, nw = (gridDim.x * 256) >> 6;
    for (int r = w; r < nrows; r += nw) { float s1 = 0.f, s2 = 0.f;
        if (isf32) { const float* p = (const float*)base + (size_t)r * rowlen; for (int c = lane; c < rowlen; c += 64) { const float v = p[c]; s1 += v; s2 += v * v; } }
        else { const bf16_t* p = (const bf16_t*)base + (size_t)r * rowlen; for (int c = lane; c < rowlen; c += 64) { const float v = bf2f(p[c]); s1 += v; s2 += v * v; } }
        s1 = wave_sum(s1); s2 = wave_sum(s2);
        if (lane == 0) { float* o = sig + (size_t)(row_off + r) * 2;
            if (!compare) { o[0] = s1; o[1] = s2; }
            else { const float a1 = o[0], a2 = o[1]; const bool bad = !(fabsf(a1 - s1) <= 1e-4f * sqrtf(a2 * (float)rowlen) + 1e-20f) || !(fabsf(a2 - s2) <= 1e-4f * a2 + 1e-20f); if (bad) atomicAdd(cnt, 1u); } } }
}
__global__ void __launch_bounds__(256) k_dbg_encode2(const unsigned* cnt, const float* xp, const float* xs, float* outp) {
    int first = -1; for (int k = 0; k < NPH_SIG; ++k) if (cnt[k] != 0u) { first = k; break; }
    if (first < 0) return;
    const float sc = 1.0f + 3.0f * (float)(first + 1);
    for (size_t i = (size_t)blockIdx.x * 256 + threadIdx.x; i < (size_t)MREAL * D; i += (size_t)gridDim.x * 256) outp[i] = sc * (i < (size_t)2 * SEQ * D ? xp[i] : xs[i - (size_t)2 * SEQ * D]);
}
#endif

extern "C" void kernel_launch(void* const* d_in, const int* in_sizes, int n_in, void* d_out, int out_size, void* d_ws, size_t ws_size, hipStream_t stream) {
    static int grid = 0;
    if (grid == 0) {
        if (n_in != 21 || out_size != MREAL * D || ws_size < WS_END) { fprintf(stderr, "kernel_launch: unexpected shapes: n_in %d out %d ws %zu (need >= %zu)\n", n_in, out_size, ws_size, (size_t)WS_END); grid = -1; return; }
        int dev = 0, cus = 0, per_cu = 0;
        if (hipGetDevice(&dev) != hipSuccess || hipDeviceGetAttribute(&cus, hipDeviceAttributeMultiprocessorCount, dev) != hipSuccess) { grid = -1; return; }
        if (hipFuncSetAttribute((const void*)fwd, hipFuncAttributeMaxDynamicSharedMemorySize, LDS_BYTES) != hipSuccess) { fprintf(stderr, "kernel_launch: hipFuncSetAttribute failed\n"); grid = -1; return; }
        if (hipOccupancyMaxActiveBlocksPerMultiprocessor(&per_cu, (const void*)fwd, 512, LDS_BYTES) != hipSuccess || per_cu < 1) fprintf(stderr, "kernel_launch: occupancy query says %d\n", per_cu);
        (void)hipGetLastError();
        grid = cus;
    }
    if (grid < 0) return;
    (void)in_sizes;
    hipMemsetAsync((char*)d_ws + WS_CTL, 0, CTL_ZERO_BYTES, stream);
    Args a{};
    for (int i = 0; i < 21; ++i) a.in[i] = (const float*)d_in[i];
    a.out = (float*)d_out; a.ws = (unsigned char*)d_ws;
#ifndef DBG_WHICH
#define DBG_WHICH 3
#endif
#if DEBUG_CHECK == 5
    {   unsigned char* ws = (unsigned char*)d_ws; unsigned* res = (unsigned*)(ws + DBG_ERR); float* Z = (float*)(ws + DBG_Z); int* srow = (int*)(ws + DBG_ERR + 4096);
        hipMemsetAsync(res, 0, 128, stream); hipLaunchKernelGGL(k_dbg_rows1, dim3(1), dim3(256), 0, stream, srow);
        a.ph_lo = 0; a.ph_hi = 1; hipLaunchKernelGGL(fwd, dim3(grid), dim3(512), LDS_BYTES, stream, a);
        hipLaunchKernelGGL(k_dbg_gemv, dim3((12864 + 255) / 256, (NS + 7) / 8), dim3(256), 0, stream, (const void*)(ws + WS_U), 1, (const int*)srow, D, 0, D, (const float*)d_in[IN_W_IN], 12864, Z, NS);
        a.ph_lo = 1; a.ph_hi = 2; hipLaunchKernelGGL(fwd, dim3(grid), dim3(512), LDS_BYTES, stream, a);
        hipLaunchKernelGGL(k_dbg_gateprobe, dim3(NS), dim3(256), 0, stream, (const float*)Z, (const unsigned char*)ws, (const bf16_t*)d_out, res);
        hipLaunchKernelGGL(k_dbg_gatedecode, dim3(1), dim3(1), 0, stream, res);
        hipLaunchKernelGGL(k_dbg_report2b, dim3(2048), dim3(256), 0, stream, (const unsigned*)res, (float*)d_out, DBG_WHICH);
    }
#elif DEBUG_CHECK == 4
    {   unsigned char* ws = (unsigned char*)d_ws; unsigned* res = (unsigned*)(ws + DBG_ERR);
        hipMemsetAsync(res, 0, 4, stream); hipMemsetAsync(res + 1, 0xFF, 4, stream);
        for (int p = 0; p < 2; ++p) { a.ph_lo = p; a.ph_hi = p + 1; hipLaunchKernelGGL(fwd, dim3(grid), dim3(512), LDS_BYTES, stream, a); }
        hipLaunchKernelGGL(k_dbg_scan1, dim3((MT * 51 * 64 + 255) / 256), dim3(256), 0, stream, (const unsigned char*)ws, (const bf16_t*)d_out, (const float*)d_in[IN_W_IN], res);
        hipLaunchKernelGGL(k_dbg_report2, dim3(2048), dim3(256), 0, stream, (const unsigned*)res, (float*)d_out);
    }
#elif DEBUG_CHECK == 3
    {
        unsigned char* ws = (unsigned char*)d_ws; unsigned* cnt = (unsigned*)(ws + DBG_ERR); float* SIG = (float*)(ws + DBG_SIG);
        hipMemsetAsync(cnt, 0, 4096, stream);
        for (int pass = 0; pass < 2; ++pass) {
            int off = 0;
            for (int i = 0; i < 21; ++i) { const int n = in_sizes[i]; const int rowlen = n >= 4096 ? 4096 : n; const int rows = n / rowlen;
                hipLaunchKernelGGL(k_dbg_sig, dim3(1024), dim3(256), 0, stream, (const void*)d_in[i], 1, rows, rowlen, SIG, off, pass, cnt + (pass ? i : 100)); off += rows; }
            if (pass == 0) for (int p = 0; p < NPHASE; ++p) { a.ph_lo = p; a.ph_hi = p + 1; hipLaunchKernelGGL(fwd, dim3(grid), dim3(512), LDS_BYTES, stream, a); }
        }
        hipLaunchKernelGGL(k_dbg_encode2, dim3(2048), dim3(256), 0, stream, (const unsigned*)cnt, (const float*)d_in[IN_XP], (const float*)d_in[IN_XS], (float*)d_out);
    }
#elif DEBUG_CHECK == 2
    {   unsigned char* ws = (unsigned char*)d_ws; unsigned* cnt = (unsigned*)(ws + DBG_ERR); float* SIG = (float*)(ws + DBG_SIG);
        hipMemsetAsync(cnt, 0, 4096, stream);
        auto phase = [&](int p) { a.ph_lo = p; a.ph_hi = p + 1; hipLaunchKernelGGL(fwd, dim3(grid), dim3(512), LDS_BYTES, stream, a); };
        auto sig = [&](int k, const void* base, int isf32, int nrows, int rowlen, int row_off, int cmp) { hipLaunchKernelGGL(k_dbg_sig, dim3(1024), dim3(256), 0, stream, base, isf32, nrows, rowlen, SIG + (size_t)k * SIG_ROWS * 2, row_off, cmp, cnt + k); };
        for (int run = 0; run < 2; ++run) {
            if (run) hipMemsetAsync((char*)d_ws + WS_CTL, 0, CTL_ZERO_BYTES, stream);
            phase(0); sig(0, ws + WS_U, 0, M, D, 0, run); sig(0, ws + WS_WIN, 0, (int)((WS_U - WS_WIN) / 8192), 4096, 30000, run); sig(0, ws + WS_TAB, 1, LSEQ, 64, 90000, run);
            phase(1); sig(1, ws + WS_ZCQ, 0, M, 1024, 0, run); sig(1, ws + WS_ZCKV, 0, M, 512, 25000, run); sig(1, ws + WS_QB, 0, M, 2048, 50000, run); sig(1, ws + WS_KB, 0, M, 512, 75000, run); sig(1, ws + WS_VB, 0, M, 512, 100000, run);
            sig(11, ws + WS_KR, 0, M, 64, 0, run); sig(11, d_out, 0, 2 * MREAL, D, 30000, run); sig(11, ws + WS_GAM, 0, 512, D, 80000, run); sig(11, ws + WS_SSP, 1, 1024, 4096, 81000, run);
            phase(2); sig(2, ws + WS_QA, 0, M, 3072, 0, run); sig(2, ws + WS_KVA, 0, M, 4096, 30000, run);
            phase(3); sig(3, ws + WS_U, 0, MREAL + 96, D, 0, run);
            phase(4); sig(4, ws + WS_MG, 0, MREAL + 96, D, 0, run);
            phase(5); sig(5, ws + WS_T, 0, MREAL + 96, D, 0, run);
            phase(6); sig(6, ws + WS_U, 0, M, D, 0, run); sig(6, d_out, 1, MREAL, D, 30000, run);
            phase(7); sig(7, ws + WS_F, 0, MREAL, DFF, 0, run); sig(7, ws + WS_HALOA, 1, MT * 8, DFF, 30000, run); sig(7, ws + WS_METAA, 1, 6, DFF, 40000, run);
            phase(8); sig(8, ws + WS_F, 0, MREAL, DFF, 0, run);
            phase(9); sig(9, ws + WS_U, 0, MREAL, D, 0, run);
            phase(10); sig(10, d_out, 1, MREAL, D, 0, run);
        }
        hipLaunchKernelGGL(k_dbg_encode2, dim3(2048), dim3(256), 0, stream, (const unsigned*)cnt, (const float*)d_in[IN_XP], (const float*)d_in[IN_XS], (float*)d_out);
    }
#elif DEBUG_CHECK
    {   unsigned char* ws = (unsigned char*)d_ws; unsigned* err = (unsigned*)(ws + DBG_ERR); float* Z = (float*)(ws + DBG_Z); float* A = (float*)(ws + DBG_A); float* B = (float*)(ws + DBG_B); float* C = (float*)(ws + DBG_C); float* H1S = (float*)(ws + DBG_H1);
        int* rl3 = (int*)(ws + DBG_ERR + 8192); int* srow = (int*)(ws + DBG_ERR + 4096);
        const float* const* in = (const float* const*)a.in;
        hipMemsetAsync(err, 0, 4096, stream); hipLaunchKernelGGL(k_dbg_rows1, dim3(1), dim3(256), 0, stream, srow);
        auto phase = [&](int p) { a.ph_lo = p; a.ph_hi = p + 1; hipLaunchKernelGGL(fwd, dim3(grid), dim3(512), LDS_BYTES, stream, a); };
        auto gemv = [&](const void* X, int xk, const int* rlist, int ld, int col0, int K, const float* W, int N, float* Y, int rows) { hipLaunchKernelGGL(k_dbg_gemv, dim3((N + 255) / 256, (rows + 7) / 8), dim3(256), 0, stream, X, xk, rlist, ld, col0, K, W, N, Y, rows); };
        phase(0); hipLaunchKernelGGL(k_dbg_chk0, dim3(NS), dim3(256), 0, stream, in[IN_XP], in[IN_XS], in[IN_META], in[IN_G_PRE_MIX], (const bf16_t*)(ws + WS_U), err);
        gemv(ws + WS_U, 1, srow, D, 0, D, in[IN_W_IN], 12864, Z, NS);
        phase(1); hipLaunchKernelGGL(k_dbg_chk1, dim3(NS), dim3(256), 0, stream, (const float*)Z, (const unsigned char*)ws, (const bf16_t*)d_out, in[IN_G_QN], in[IN_G_KN], err);
        hipLaunchKernelGGL(k_dbg_prep2, dim3(NS), dim3(256), 0, stream, (const float*)Z, in[IN_G_CQ], in[IN_G_CKV], C);
        hipLaunchKernelGGL(k_dbg_split2, dim3(NS), dim3(256), 0, stream, (const float*)C, A, A + (size_t)NS * 1024);
        gemv(A, 0, nullptr, 0, 0, 1024, in[IN_W_UQ], 3072, B, NS); gemv(A + (size_t)NS * 1024, 0, nullptr, 0, 0, 512, in[IN_W_UKV], 4096, B + (size_t)NS * 3072, NS);
        phase(2); hipLaunchKernelGGL(k_dbg_chk2, dim3(NS), dim3(256), 0, stream, (const float*)B, (const float*)(B + (size_t)NS * 3072), (const unsigned char*)ws, err);
        phase(3); hipLaunchKernelGGL(k_dbg_chk3, dim3(NS, 32), dim3(256), 0, stream, (const unsigned char*)ws, err);
        gemv(ws + WS_U, 1, srow, D, 0, 2048, in[IN_W_PA], D, A, NS); gemv(ws + WS_U, 1, srow, D, 2048, 2048, in[IN_W_PB], D, A + (size_t)NS * D, NS);
        phase(4); hipLaunchKernelGGL(k_dbg_chk4, dim3(NS), dim3(256), 0, stream, (const float*)A, (const float*)(A + (size_t)NS * D), (const float*)Z, (const unsigned char*)ws, err);
        gemv(ws + WS_MG, 1, srow, D, 0, D, in[IN_W_O], D, A, NS);
        phase(5); hipLaunchKernelGGL(k_dbg_chk5, dim3(NS), dim3(256), 0, stream, (const float*)A, in[IN_XP], in[IN_XS], in[IN_META], in[IN_G_POST_MIX], in[IN_G_PRE_FFN], (const unsigned char*)ws, (const float*)d_out, H1S, err, 0);
        phase(6); hipLaunchKernelGGL(k_dbg_chk5, dim3(NS), dim3(256), 0, stream, (const float*)A, in[IN_XP], in[IN_XS], in[IN_META], in[IN_G_POST_MIX], in[IN_G_PRE_FFN], (const unsigned char*)ws, (const float*)d_out, H1S, err, 1);
        hipLaunchKernelGGL(k_dbg_rows3, dim3(1), dim3(256), 0, stream, rl3);
        gemv(ws + WS_U, 1, rl3, D, 0, D, in[IN_W_UP], 22016, B, 3 * NS);
        phase(7); phase(8); hipLaunchKernelGGL(k_dbg_chk6, dim3(NS), dim3(256), 0, stream, (const float*)B, in[IN_W_CONV], in[IN_B_CONV], (const unsigned char*)ws, err);
        gemv(ws + WS_F, 1, srow, DFF, 0, DFF, in[IN_W_DOWN], D, A, NS);
        phase(9); phase(10); hipLaunchKernelGGL(k_dbg_chk7, dim3(NS), dim3(256), 0, stream, (const float*)A, (const float*)H1S, in[IN_G_POST_FFN], (const float*)d_out, err);
        hipLaunchKernelGGL(k_dbg_encode, dim3(2048), dim3(256), 0, stream, (const unsigned*)err, in[IN_XP], in[IN_XS], (float*)d_out);
    }
#elif MK_ONE_LAUNCH
    a.ph_lo = 0; a.ph_hi = NPHASE;
    hipLaunchKernelGGL(fwd, dim3(grid), dim3(512), LDS_BYTES, stream, a);
#else
    for (int p = 0; p < NPHASE; ++p) { a.ph_lo = p; a.ph_hi = p + 1; hipLaunchKernelGGL(fwd, dim3(grid), dim3(512), LDS_BYTES, stream, a); }
#endif
    const hipError_t le = hipPeekAtLastError();
    if (le != hipSuccess) fprintf(stderr, "kernel_launch: launch failed: %s\n", hipGetErrorName(le));
}
```

```cpp
#include <hip/hip_runtime.h>
#include <cstdio>
#include <cstdint>

#ifndef DUP_PHASE
#define DUP_PHASE -1
#endif
#ifndef MK_ONE_LAUNCH
#define MK_ONE_LAUNCH 1
#endif

#define LAS __attribute__((address_space(3)))
#define GAS __attribute__((address_space(1)))
typedef unsigned short bf16_t;
typedef short bf16x8 __attribute__((ext_vector_type(8)));
typedef short s16x4 __attribute__((ext_vector_type(4)));
typedef float f32x2 __attribute__((ext_vector_type(2)));
typedef float f32x4 __attribute__((ext_vector_type(4)));
typedef float f32x16 __attribute__((ext_vector_type(16)));
typedef unsigned u32x2 __attribute__((ext_vector_type(2)));
typedef unsigned u32x4 __attribute__((ext_vector_type(4)));
typedef int v8i_t __attribute__((ext_vector_type(8)));

constexpr int D = 4096, SEQ = 4096, NBATCH = 6, NMETA = 16, LSEQ = SEQ + NMETA;
constexpr int MREAL = NBATCH * SEQ;
constexpr int M = MREAL + 256;
constexpr int MT = M / 256;
constexpr int DINP = 4864;
constexpr int DGATE = 8192;
constexpr int DFF = 11008;
constexpr float EPS = 1e-6f;
constexpr int PN_CQ = 0, PN_CKV = 4, PN_GQ = 6, PN_GK = 14, PN_GV = 16, PN_KR = 18;
constexpr float U8_SCALE = 8.0f, W8_SCALE = 256.0f;

constexpr size_t MiB = 1u << 20;
constexpr size_t WS_CTL = 0, CTL_ZERO_BYTES = 2 * MiB;
constexpr size_t WS_SS = 1 * MiB;
constexpr size_t WS_TAB = 2 * MiB;
constexpr size_t WS_WIN = 4 * MiB, WS_WIN8 = 42 * MiB  , WS_WUQ = 106 * MiB, WS_WUKV = 112 * MiB, WS_WP = 116 * MiB, WS_WO = 148 * MiB, WS_WUP = 180 * MiB, WS_WDN = 352 * MiB;
constexpr size_t WS_U = 438 * MiB;
constexpr size_t WS_ZCQ = 632 * MiB, WS_ZCKV = 681 * MiB, WS_QB = 706 * MiB, WS_KB = 803 * MiB, WS_VB = 828 * MiB, WS_KR = 853 * MiB;
constexpr size_t WS_QA = 857 * MiB, WS_KVA = 1003 * MiB;
constexpr size_t WS_U8 = 857 * MiB;
constexpr size_t WS_MG = 857 * MiB;
constexpr size_t WS_T = 632 * MiB;
constexpr size_t WS_F = 632 * MiB;
constexpr size_t WS_HALOA = 1154 * MiB, WS_HALOG = 1187 * MiB, WS_METAA = 1204 * MiB, WS_GAM = 1205 * MiB, WS_GBM = 1207 * MiB, WS_H1M = 1209 * MiB, WS_SSP = 1211 * MiB  , WS_END = 1227 * MiB;
static_assert(WS_WIN + (size_t)DINP * D * 2 <= WS_WIN8 && WS_WIN8 + (size_t)DGATE * D <= WS_WUQ && WS_WUP + (size_t)2 * DFF * D * 2 <= WS_WDN && WS_WDN + (size_t)D * DFF * 2 <= WS_U, "weights map");
static_assert(WS_U + (size_t)M * D * 2 <= WS_ZCQ && WS_F + (size_t)M * DFF * 2 <= WS_HALOA && WS_HALOA + (size_t)MT * 8 * DFF * 4 <= WS_HALOG && WS_HALOG + (size_t)MT * 4 * DFF * 4 <= WS_METAA, "act map");
static_assert(WS_QA + (size_t)M * 3072 * 2 <= WS_KVA && WS_KVA + (size_t)M * 4096 * 2 <= 1197 * MiB && WS_KR + (size_t)M * 64 * 2 <= WS_QA, "act map 2");
constexpr int CW_BAR = 4096;
constexpr size_t SSP_CQ = 0  , SSP_CKV = (size_t)M * 16 * 4  , SSP_T = SSP_CKV + (size_t)M * 8 * 4  , SSP_D = SSP_T + (size_t)M * 64 * 4  ;
static_assert(SSP_D + (size_t)M * 64 * 4 <= 16 * MiB, "ssp map");

constexpr int RING_BYTES = 131072;
constexpr int EPI_OFF = RING_BYTES;
constexpr int MISC_OFF = EPI_OFF + 8192;
constexpr int LDS_BYTES = 147456;

typedef __bf16 bf16x2_t __attribute__((ext_vector_type(2)));
__device__ __forceinline__ unsigned cvt_pk_bf16(float lo, float hi) { const f32x2 v = {lo, hi}; const bf16x2_t b = __builtin_convertvector(v, bf16x2_t); return __builtin_bit_cast(unsigned, b); }
__device__ __forceinline__ float bf_lo(unsigned w) { return __uint_as_float(w << 16); }
__device__ __forceinline__ float bf_hi(unsigned w) { return __uint_as_float(w & 0xffff0000u); }
__device__ __forceinline__ float fast_rcp(float x) { return __builtin_amdgcn_rcpf(x); }
__device__ __forceinline__ float fast_rsq(float x) { return __builtin_amdgcn_rsqf(x); }
__device__ __forceinline__ float fast_exp2(float x) { return __builtin_amdgcn_exp2f(x); }
__device__ __forceinline__ float sigmoidf_(float v) { v = fminf(fmaxf(v, -30.f), 30.f); return fast_rcp(1.0f + fast_exp2(-1.4426950408889634f * v)); }
__device__ __forceinline__ float gelu_tanh(float x) { const float u = x * (1.0f + 0.044715f * x * x); float e = -2.0f * 0.7978845608028654f * 1.4426950408889634f * u; e = fminf(e, 80.f); return x * fast_rcp(1.0f + fast_exp2(e)); }
__device__ __forceinline__ u32x4 pack8(const f32x4 a, const f32x4 b) { u32x4 w; w.x = cvt_pk_bf16(a[0], a[1]); w.y = cvt_pk_bf16(a[2], a[3]); w.z = cvt_pk_bf16(b[0], b[1]); w.w = cvt_pk_bf16(b[2], b[3]); return w; }
__device__ __forceinline__ float wave_sum(float v) {
#pragma unroll
    for (int o = 1; o < 64; o <<= 1) v += __shfl_xor(v, o);
    return v;
}
__device__ __forceinline__ f32x4 rope4(const f32x4 v, const f32x4 cs) { f32x4 o; o[0] = v[0] * cs[0] - v[1] * cs[1]; o[1] = v[0] * cs[1] + v[1] * cs[0]; o[2] = v[2] * cs[2] - v[3] * cs[3]; o[3] = v[2] * cs[3] + v[3] * cs[2]; return o; }
__device__ __forceinline__ int pos1d_of(int pm, int rl) { return pm < MT - 1 ? 16 + ((pm & 15) << 8) + rl : (rl < 96 ? (rl & 15) : 0); }
__device__ __forceinline__ int tok_of(int pm, int rl) { return pm < MT - 1 ? ((pm & 15) << 8) + rl : 0; }

namespace pg8 {
constexpr int BM = 256, BK = 64, HALF = 128, HTB = HALF * BK * 2, STAGE_BYTES = 8 * HTB, NXCD = 8, WGM = 8;
__host__ __device__ __forceinline__ int lds_byte(int r, int c) { const int st = (r >> 4) * 2 + (c >> 5), rr = r & 15, cc = c & 31, ob = rr * 64 + cc * 2; return st * 1024 + (ob ^ (((ob >> 9) & 1) << 5)); }
__host__ __device__ __forceinline__ void stage_rc(int b, int& R, int& C) { const int st = b / 1024, sb = b % 1024, swz = sb ^ (((sb >> 9) & 1) << 5); R = (st >> 1) * 16 + swz / 64; C = (st & 1) * 32 + (swz % 64) / 2; }
__host__ __device__ __forceinline__ int perm32(int rho) { const int n = rho >> 4, i = rho & 15; return 8 * (i >> 2) + 4 * n + (i & 3); }
struct Unit { int pm, pn; };
struct Gemm { const void* A; const void* Bt; int M, N, K, ldb; };
struct StaticOrder {
    int nM, nN, nwg, G, c;
    __host__ __device__ void init(int M_, int N_, int G_, int c_) { nM = M_ / BM; nN = N_ / BM; nwg = nM * nN; G = G_; c = c_; }
    __host__ __device__ bool next(int i, Unit& u) const {
        const long L = (long)i * G + c; if (L >= nwg) return false;
        int wgid = (int)L; { const int q = nwg / NXCD, r = nwg % NXCD, xcd = wgid % NXCD, off = wgid / NXCD; wgid = (xcd < r ? xcd * (q + 1) : r * (q + 1) + (xcd - r) * q) + off; }
        const int nig = WGM * nN, gid = wgid / nig, fm = gid * WGM, gsz = (nM - fm) < WGM ? (nM - fm) : WGM;
        u.pm = fm + ((wgid % nig) % gsz); u.pn = (wgid % nig) / gsz; return true;
    }
};
template <class Epi, bool ALIGN_EPI = true, bool SP2 = true, bool FP8 = false>
__device__ __forceinline__ void gemm_phase(LAS unsigned char* lds, LAS unsigned char* scratch, const Gemm g, const StaticOrder& S, const Epi& E) {
    int tid_ = threadIdx.x; asm volatile("" : "+v"(tid_));
    const int tid = tid_, wid = __builtin_amdgcn_readfirstlane(tid >> 6), lane = tid & 63, wr = wid >> 2, wc = wid & 3, fr = lane & 15, fq = lane >> 4;
    const int K = g.ldb >> 1  , nt = FP8 ? g.K / 128 : g.K / BK;
    unsigned voffA[2], voffB[2];
#pragma unroll
    for (int i = 0; i < 2; ++i) { int R, C; stage_rc(tid * 16 + i * 8192, R, C); const int Rb = (R & ~31) + perm32(R & 31);
        const int Ra = Epi::ASWAP ? (128 * (R >> 6) + (R & 63)) : R;
        voffA[i] = (unsigned)(Ra * K + C) * 2u; voffB[i] = (unsigned)(Rb * K + C) * 2u; }
    const unsigned kstep = (unsigned)(BK * 2);
    const unsigned hstepB = (unsigned)HALF * (unsigned)g.ldb;
    const unsigned hstepA = Epi::ASWAP ? 64u * (unsigned)g.ldb : hstepB;
    const unsigned tstep = 256u * (unsigned)g.ldb;
    const __amdgpu_buffer_rsrc_t rsA = __builtin_amdgcn_make_buffer_rsrc((void*)g.A, (short)0, 0x7fffffff, 0x00020000);
    const __amdgpu_buffer_rsrc_t rsB = __builtin_amdgcn_make_buffer_rsrc((void*)g.Bt, (short)0, 0x7fffffff, 0x00020000);
    const unsigned ldsw = (unsigned)wid * 1024u;
    const int aoff = lds_byte(wr * 64 + fr, fq * 8), boff = lds_byte(wc * 32 + fr, fq * 8);
#define PG8_SA(b, h) (((b) * 2 + (h)) * HTB)
#define PG8_SB(b, h) ((4 + (b) * 2 + (h)) * HTB)
#define PG8_STAGE(bufoff, rs, soff, voff) do { _Pragma("unroll") for (int _i = 0; _i < 2; ++_i) \
        __builtin_amdgcn_raw_ptr_buffer_load_lds(rs, (LAS void*)(lds + (bufoff) + ldsw + _i * 8192), 16, (voff)[_i], (soff), 0, 0); } while (0)
#define PG8_LDA(dst, b, h) do { _Pragma("unroll") for (int m = 0; m < 4; ++m) _Pragma("unroll") for (int k = 0; k < 2; ++k) dst[m][k] = *(const LAS bf16x8*)(lds + PG8_SA(b, h) + aoff + m * 2048 + k * 1024); } while (0)
#define PG8_LDB(dst, b, h) do { _Pragma("unroll") for (int n = 0; n < 2; ++n) _Pragma("unroll") for (int k = 0; k < 2; ++k) dst[n][k] = *(const LAS bf16x8*)(lds + PG8_SB(b, h) + boff + n * 2048 + k * 1024); } while (0)
#define PG8_F8(lo, hi) (v8i_t){ (int)__builtin_bit_cast(u32x4, lo)[0], (int)__builtin_bit_cast(u32x4, lo)[1], (int)__builtin_bit_cast(u32x4, lo)[2], (int)__builtin_bit_cast(u32x4, lo)[3], (int)__builtin_bit_cast(u32x4, hi)[0], (int)__builtin_bit_cast(u32x4, hi)[1], (int)__builtin_bit_cast(u32x4, hi)[2], (int)__builtin_bit_cast(u32x4, hi)[3] }
#define PG8_MMA(ai, bj, At, Bt) do { __builtin_amdgcn_s_setprio(1); \
        if constexpr (FP8) { _Pragma("unroll") for (int m = 0; m < 4; ++m) _Pragma("unroll") for (int n = 0; n < 2; ++n) \
            { const v8i_t b8_ = PG8_F8(Bt[n][0], Bt[n][1]), a8_ = PG8_F8(At[m][0], At[m][1]); \
              asm volatile("v_mfma_scale_f32_16x16x128_f8f6f4 %0, %1, %2, %0, %3, %3 op_sel_hi:[0,0,0]" : "+v"(acc[ai][bj][m][n]) : "v"(b8_), "v"(a8_), "v"(one8)); } } \
        else { _Pragma("unroll") for (int m = 0; m < 4; ++m) _Pragma("unroll") for (int n = 0; n < 2; ++n) _Pragma("unroll") for (int k = 0; k < 2; ++k) \
            acc[ai][bj][m][n] = __builtin_amdgcn_mfma_f32_16x16x32_bf16(Bt[n][k], At[m][k], acc[ai][bj][m][n], 0, 0, 0); } \
        __builtin_amdgcn_s_setprio(0); } while (0)
#define PG8_WAIT_V(n) asm volatile("s_waitcnt vmcnt(" #n ")" ::: "memory")
#define PG8_WAIT_L(n) asm volatile("s_waitcnt lgkmcnt(" #n ")" ::: "memory")
#define PG8_BAR __builtin_amdgcn_s_barrier()
#define PG8_SCHED __builtin_amdgcn_sched_barrier(0)
    Unit cur, nxt; int ui = 0;
    if (!S.next(0, cur)) return;
    f32x4 acc[2][2][4][2];
#pragma unroll
    for (int a = 0; a < 2; ++a)
#pragma unroll
        for (int b = 0; b < 2; ++b)
#pragma unroll
            for (int m = 0; m < 4; ++m)
#pragma unroll
                for (int n = 0; n < 2; ++n) acc[a][b][m][n] = (f32x4){0.f, 0.f, 0.f, 0.f};
    bf16x8 At[4][2], B0[2][2], B1[2][2];
    const int one8 = 0x7f7f7f7f; (void)one8;
    unsigned cA = (unsigned)cur.pm * tstep, cB = (unsigned)cur.pn * tstep;
    if constexpr (SP2) {
        PG8_STAGE(PG8_SB(0, 0), rsB, cB, voffB); PG8_STAGE(PG8_SB(0, 1), rsB, cB + hstepB, voffB); PG8_STAGE(PG8_SA(0, 0), rsA, cA, voffA); PG8_STAGE(PG8_SA(0, 1), rsA, cA + hstepA, voffA);
        if (wr == 1) PG8_BAR;
        PG8_WAIT_V(2); PG8_BAR;
        PG8_STAGE(PG8_SB(1, 0), rsB, cB + kstep, voffB); PG8_STAGE(PG8_SA(1, 0), rsA, cA + kstep, voffA); PG8_STAGE(PG8_SB(1, 1), rsB, cB + hstepB + kstep, voffB);
        PG8_WAIT_V(6); PG8_BAR;
    } else {
        PG8_STAGE(PG8_SB(0, 0), rsB, cB, voffB); PG8_STAGE(PG8_SA(0, 0), rsA, cA, voffA); PG8_STAGE(PG8_SB(0, 1), rsB, cB + hstepB, voffB); PG8_STAGE(PG8_SA(0, 1), rsA, cA + hstepA, voffA);
        if (wr == 1) PG8_BAR;
        PG8_WAIT_V(4); PG8_BAR;
        PG8_STAGE(PG8_SB(1, 0), rsB, cB + kstep, voffB); PG8_STAGE(PG8_SA(1, 0), rsA, cA + kstep, voffA); PG8_STAGE(PG8_SB(1, 1), rsB, cB + hstepB + kstep, voffB);
        PG8_WAIT_V(6); PG8_BAR;
    }
    for (;;) {
        const bool has_next = S.next(ui + 1, nxt);
        const unsigned nA = has_next ? (unsigned)nxt.pm * tstep : cA, nB = has_next ? (unsigned)nxt.pn * tstep : cB;
        for (int t = 0; t < nt; t += 2) {
            const bool last = (t == nt - 2);
            const unsigned a1 = cA + (unsigned)(t + 1) * kstep;
            const unsigned a2 = last ? nA : cA + (unsigned)(t + 2) * kstep, b2 = last ? nB : cB + (unsigned)(t + 2) * kstep;
            const unsigned a3 = a2 + kstep, b3 = b2 + kstep;
            if constexpr (SP2) {
            PG8_LDB(B0, 0, 0); PG8_LDB(B1, 0, 1); PG8_SCHED; PG8_LDA(At, 0, 0); PG8_STAGE(PG8_SA(1, 1), rsA, a1 + hstepA, voffA);
            PG8_WAIT_V(8); PG8_WAIT_L(0); PG8_BAR; PG8_MMA(0, 0, At, B0); PG8_MMA(0, 1, At, B1); PG8_BAR; PG8_SCHED;
            PG8_LDA(At, 0, 1); PG8_STAGE(PG8_SB(0, 0), rsB, b2, voffB); PG8_STAGE(PG8_SB(0, 1), rsB, b2 + hstepB, voffB); PG8_STAGE(PG8_SA(0, 0), rsA, a2, voffA);
            PG8_WAIT_V(8); PG8_WAIT_L(0); PG8_BAR; PG8_MMA(1, 0, At, B0); PG8_MMA(1, 1, At, B1); PG8_BAR; PG8_SCHED;
            PG8_LDB(B0, 1, 0); PG8_LDB(B1, 1, 1); PG8_SCHED; PG8_LDA(At, 1, 0); PG8_STAGE(PG8_SA(0, 1), rsA, a2 + hstepA, voffA);
            PG8_WAIT_V(8); PG8_WAIT_L(0); PG8_BAR; PG8_MMA(0, 0, At, B0); PG8_MMA(0, 1, At, B1); PG8_BAR; PG8_SCHED;
            PG8_LDA(At, 1, 1); PG8_STAGE(PG8_SB(1, 0), rsB, b3, voffB); PG8_STAGE(PG8_SB(1, 1), rsB, b3 + hstepB, voffB); PG8_STAGE(PG8_SA(1, 0), rsA, a3, voffA);
            PG8_WAIT_V(8); PG8_WAIT_L(0); PG8_BAR; PG8_MMA(1, 0, At, B0); PG8_MMA(1, 1, At, B1); PG8_BAR; PG8_SCHED;
            } else {
            PG8_LDB(B0, 0, 0); PG8_SCHED; PG8_LDA(At, 0, 0); PG8_STAGE(PG8_SA(1, 1), rsA, a1 + hstepA, voffA);
            PG8_WAIT_L(8); PG8_BAR; PG8_WAIT_L(0); PG8_MMA(0, 0, At, B0); PG8_BAR; PG8_SCHED;
            PG8_LDB(B1, 0, 1); PG8_STAGE(PG8_SB(0, 0), rsB, b2, voffB);
            PG8_BAR; PG8_WAIT_L(0); PG8_MMA(0, 1, At, B1); PG8_BAR;
            PG8_LDA(At, 0, 1); PG8_STAGE(PG8_SA(0, 0), rsA, a2, voffA);
            PG8_BAR; PG8_WAIT_L(0); PG8_MMA(1, 0, At, B0); PG8_BAR; PG8_SCHED;
            PG8_STAGE(PG8_SB(0, 1), rsB, b2 + hstepB, voffB);
            PG8_WAIT_V(6); PG8_BAR; PG8_MMA(1, 1, At, B1); PG8_BAR;
            PG8_LDB(B0, 1, 0); PG8_SCHED; PG8_LDA(At, 1, 0); PG8_STAGE(PG8_SA(0, 1), rsA, a2 + hstepA, voffA);
            PG8_WAIT_L(8); PG8_BAR; PG8_WAIT_L(0); PG8_MMA(0, 0, At, B0); PG8_BAR; PG8_SCHED;
            PG8_LDB(B1, 1, 1); PG8_STAGE(PG8_SB(1, 0), rsB, b3, voffB);
            PG8_BAR; PG8_WAIT_L(0); PG8_MMA(0, 1, At, B1); PG8_BAR;
            PG8_LDA(At, 1, 1); PG8_STAGE(PG8_SA(1, 0), rsA, a3, voffA);
            PG8_BAR; PG8_WAIT_L(0); PG8_MMA(1, 0, At, B0); PG8_BAR; PG8_SCHED;
            PG8_STAGE(PG8_SB(1, 1), rsB, b3 + hstepB, voffB);
            PG8_WAIT_V(6); PG8_BAR; PG8_MMA(1, 1, At, B1); PG8_BAR;
            }
        }
        if constexpr (ALIGN_EPI) { if (wr == 0) PG8_BAR; }
        if constexpr (FP8) asm volatile("s_nop 15\n\ts_nop 15" ::: "memory");
        E(acc, cur, wr, wc, fr, fq, scratch);
        if (!has_next) break;
#pragma unroll
        for (int a = 0; a < 2; ++a)
#pragma unroll
            for (int b = 0; b < 2; ++b)
#pragma unroll
                for (int m = 0; m < 4; ++m)
#pragma unroll
                    for (int n = 0; n < 2; ++n) acc[a][b][m][n] = (f32x4){0.f, 0.f, 0.f, 0.f};
        cur = nxt; cA = nA; cB = nB; ++ui;
        if constexpr (ALIGN_EPI) { if (wr == 1) PG8_BAR; }
    }
    PG8_WAIT_V(0);
    if constexpr (!ALIGN_EPI) { if (wr == 0) PG8_BAR; }
    PG8_BAR;
#undef PG8_SA
#undef PG8_SB
#undef PG8_STAGE
#undef PG8_LDA
#undef PG8_LDB
#undef PG8_MMA
#undef PG8_F8
#undef PG8_WAIT_V
#undef PG8_WAIT_L
#undef PG8_BAR
#undef PG8_SCHED
}
}
using pg8::Unit;
typedef f32x4 AccT[2][2][4][2];

template <class T> __device__ __forceinline__ T ldu(const void* ubase, size_t uoff, unsigned voff) { return *(const T*)((const char*)ubase + uoff + voff); }
constexpr float QPRE_MLA = 0.07216878364870322f * 1.4426950408889634f, QPRE_GQA = 0.08838834764831845f * 1.4426950408889634f;
#ifndef DUP_ATT_GQA
#define DUP_ATT_GQA 1
#endif
#ifndef DUP_ATT_MLA
#define DUP_ATT_MLA 1
#endif
#ifndef GQA_DMA
#define GQA_DMA true
#endif
#ifndef MT_GQA
#define MT_GQA 1
#endif
#ifndef QK_PD
#define QK_PD 2
#endif
#ifndef GQA_SDEPTH
#define GQA_SDEPTH 2
#endif
#ifndef WT_STORES
#define WT_STORES 1
#endif
template <class T, bool WT = false> __device__ __forceinline__ void stu(void* ubase, size_t uoff, unsigned voff, const T v) {
  if constexpr (WT && WT_STORES) {
    static_assert(sizeof(T) == 16, "16-byte stores only");
    const __amdgpu_buffer_rsrc_t rs = __builtin_amdgcn_make_buffer_rsrc(ubase, (short)0, 0x7fffffff, 0x00020000);
    __builtin_amdgcn_raw_buffer_store_b128(__builtin_bit_cast(u32x4, v), rs, (int)voff, (int)(unsigned)uoff, 16);
  } else {
    *(T*)((char*)ubase + uoff + voff) = v;
  }
}
__device__ __forceinline__ float sumsq8(const f32x4 v0, const f32x4 v1) { return ((v0[0] * v0[0] + v0[1] * v0[1]) + (v0[2] * v0[2] + v0[3] * v0[3])) + ((v1[0] * v1[0] + v1[1] * v1[1]) + (v1[2] * v1[2] + v1[3] * v1[3])); }
struct EpiP1 {
    static constexpr bool ASWAP = false;
    unsigned char* ws; bf16_t* GA; const float *g_qn, *g_kn;
    __device__ __forceinline__ void operator()(const AccT& acc, const Unit& u, int wr, int wc, int fr, int fq, LAS unsigned char* scr) const {
        const int pn = u.pn, pm = u.pm, rl0 = wr * 64 + fr, cw = wc * 32 + 8 * fq;
        bf16_t* const ZCQ = (bf16_t*)(ws + WS_ZCQ); bf16_t* const ZCKV = (bf16_t*)(ws + WS_ZCKV); bf16_t* const QB = (bf16_t*)(ws + WS_QB); bf16_t* const KB = (bf16_t*)(ws + WS_KB); bf16_t* const VB = (bf16_t*)(ws + WS_VB);
        bf16_t* const KR = (bf16_t*)(ws + WS_KR); bf16_t* const GAM = (bf16_t*)(ws + WS_GAM); bf16_t* const GBM = (bf16_t*)(ws + WS_GBM); bf16_t* const GB = GA + (size_t)MREAL * D;
        const f32x4* const TAB = (const f32x4*)(ws + WS_TAB);
        if (pn < PN_GQ) {
            const bool isq = pn < PN_CKV; const int ld = isq ? 1024 : 512, colt = isq ? 256 * pn : 256 * (pn - PN_CKV);
            bf16_t* dst = (isq ? ZCQ : ZCKV) + (size_t)pm * 256 * ld + colt; const int nslot = isq ? 16 : 8, slot = (isq ? pn : pn - PN_CKV) * 4 + wc;
            float* ss = (float*)(ws + WS_SSP + (isq ? SSP_CQ : SSP_CKV)) + (size_t)pm * 256 * nslot + slot;
            const unsigned voff = (unsigned)((rl0 * ld + cw) * 2);
#pragma unroll
            for (int ai = 0; ai < 2; ++ai)
#pragma unroll
                for (int m = 0; m < 4; ++m) { float s = 0.f;
#pragma unroll
                    for (int bj = 0; bj < 2; ++bj) { s += sumsq8(acc[ai][bj][m][0], acc[ai][bj][m][1]);
                        stu<u32x4>(dst, (size_t)((ai * 128 + m * 16) * ld + bj * 128) * 2, voff, pack8(acc[ai][bj][m][0], acc[ai][bj][m][1])); }
                    s += __shfl_xor(s, 16); s += __shfl_xor(s, 32);
                    if (fq == 0) ss[(ai * 128 + m * 16 + rl0) * nslot] = s; }
        } else if (pn < PN_GV) {
            const bool isq = pn < PN_GK; const int ld = isq ? 2048 : 512, colt = isq ? 256 * (pn - PN_GQ) : 256 * (pn - PN_GK); const float* gn = isq ? g_qn : g_kn;
            bf16_t* dst = (isq ? QB : KB) + (size_t)pm * 256 * ld + colt; const unsigned voff = (unsigned)((rl0 * ld + cw) * 2);
            LAS float* P = (LAS float*)scr;
#pragma unroll
            for (int ai = 0; ai < 2; ++ai)
#pragma unroll
                for (int m = 0; m < 4; ++m)
#pragma unroll
                    for (int bj = 0; bj < 2; ++bj) { float s = sumsq8(acc[ai][bj][m][0], acc[ai][bj][m][1]);
                        s += __shfl_xor(s, 16); s += __shfl_xor(s, 32);
                        if (fq == 0) P[(ai * 128 + m * 16 + rl0) * 8 + bj * 4 + wc] = s; }
            asm volatile("s_waitcnt lgkmcnt(0)" ::: "memory"); __builtin_amdgcn_s_barrier(); asm volatile("" ::: "memory");
            const int half = wc >> 1, i0 = 16 * (wc & 1) + 4 * fq;
            const f32x4 g1 = *(const f32x4*)(gn + half * 64 + i0), g2 = *(const f32x4*)(gn + half * 64 + 32 + i0);
            const int tbase = pm < MT - 1 ? ((pm & 15) << 8) : 0; const bool real = pm < MT - 1;
            const unsigned tvo = (unsigned)(((real && half ? fr * 16 : 0) + (i0 >> 1)) * 16);
#pragma unroll
            for (int ai = 0; ai < 2; ++ai)
#pragma unroll
                for (int m = 0; m < 4; ++m) { const int rl = ai * 128 + m * 16 + rl0; const size_t tuo = real ? (size_t)(half ? 16 * m : (tbase >> 6) + 2 * ai + wr) * 256 : 0;
                    const f32x4 cs0 = ldu<f32x4>(TAB, tuo, tvo), cs1 = ldu<f32x4>(TAB, tuo + 16, tvo);
#pragma unroll
                    for (int bj = 0; bj < 2; ++bj) { const f32x4 p4 = *(const LAS f32x4*)(P + rl * 8 + bj * 4);
                        const float rs = fast_rsq(((p4[0] + p4[1]) + (p4[2] + p4[3])) * (1.0f / 128.0f) + EPS) * (isq ? QPRE_GQA : 1.0f);
                        f32x4 v0 = acc[ai][bj][m][0] * rs, v1 = acc[ai][bj][m][1] * rs;
                        v0[0] *= g1[0]; v0[1] *= g2[0]; v0[2] *= g1[1]; v0[3] *= g2[1]; v1[0] *= g1[2]; v1[1] *= g2[2]; v1[2] *= g1[3]; v1[3] *= g2[3];
                        stu<u32x4>(dst, (size_t)((ai * 128 + m * 16) * ld + bj * 128) * 2, voff, pack8(rope4(v0, cs0), rope4(v1, cs1))); }
                    asm volatile("" ::: "memory"); }
        } else if (pn < PN_KR) {
            bf16_t* dst = VB + (size_t)pm * 256 * 512 + 256 * (pn - PN_GV); const unsigned voff = (unsigned)((rl0 * 512 + cw) * 2);
#pragma unroll
            for (int ai = 0; ai < 2; ++ai)
#pragma unroll
                for (int m = 0; m < 4; ++m)
#pragma unroll
                    for (int bj = 0; bj < 2; ++bj) stu<u32x4>(dst, (size_t)((ai * 128 + m * 16) * 512 + bj * 128) * 2, voff, pack8(acc[ai][bj][m][0], acc[ai][bj][m][1]));
        } else {
            if (wc < 2) { const int i0 = 16 * wc + 4 * fq; bf16_t* dst = KR + (size_t)pm * 256 * 64; const unsigned voff = (unsigned)((rl0 * 64 + cw) * 2);
#pragma unroll
                for (int ai = 0; ai < 2; ++ai)
#pragma unroll
                    for (int m = 0; m < 4; ++m) {
                        const bool real = pm < MT - 1; const size_t tuo = real ? (size_t)(16 + ((pm & 15) << 8) + ai * 128 + m * 16) * 256 : 0; const unsigned tvo = (unsigned)(((real ? rl0 : fr) * 16 + (i0 >> 1)) * 16);
                        const f32x4 cs0 = ldu<f32x4>(TAB, tuo, tvo), cs1 = ldu<f32x4>(TAB, tuo + 16, tvo);
                        stu<u32x4>(dst, (size_t)((ai * 128 + m * 16) * 64) * 2, voff, pack8(rope4(acc[ai][0][m][0], cs0), rope4(acc[ai][0][m][1], cs1))); } }
        }
    }
};
struct EpiGate {
    static constexpr bool ASWAP = false;
    unsigned char* ws; bf16_t* GA;
    __device__ __forceinline__ void operator()(const AccT& acc, const Unit& u, int wr, int wc, int fr, int fq, LAS unsigned char*) const {
        const int pn = u.pn, pm = u.pm, rl0 = wr * 64 + fr, cw = wc * 32 + 8 * fq; const bool isa = pn < 16; const int colt = 256 * (pn & 15);
        bf16_t* dst = (pm < MT - 1 ? (isa ? GA : GA + (size_t)MREAL * D) + (size_t)pm * 256 * D : (bf16_t*)(ws + (isa ? WS_GAM : WS_GBM))) + colt; const unsigned voff = (unsigned)((rl0 * D + cw) * 2);
        constexpr float inv = 1.0f / (U8_SCALE * W8_SCALE);
#pragma unroll
        for (int ai = 0; ai < 2; ++ai)
#pragma unroll
            for (int m = 0; m < 4; ++m)
#pragma unroll
                for (int bj = 0; bj < 2; ++bj) { f32x4 v0 = acc[ai][bj][m][0], v1 = acc[ai][bj][m][1];
#pragma unroll
                    for (int j = 0; j < 4; ++j) { v0[j] = sigmoidf_(v0[j] * inv); v1[j] = sigmoidf_(v1[j] * inv); }
                    stu<u32x4>(dst, (size_t)((ai * 128 + m * 16) * D + bj * 128) * 2, voff, pack8(v0, v1)); }
    }
};
struct EpiQA {
    static constexpr bool ASWAP = false;
    bf16_t* QA; const float* SS_CQ; const f32x4* TAB;
    __device__ __forceinline__ void operator()(const AccT& acc, const Unit& u, int wr, int wc, int fr, int fq, LAS unsigned char*) const {
        const int pn = u.pn, pm = u.pm, rl0 = wr * 64 + fr, cw = wc * 32 + 8 * fq, i0 = 16 * (wc & 1) + 4 * fq;
        bf16_t* dst = QA + (size_t)pm * 256 * 3072 + pn * 256; const unsigned voff = (unsigned)((rl0 * 3072 + cw) * 2); const float* ss = SS_CQ + (size_t)pm * 256 * 16;
#pragma unroll
        for (int ai = 0; ai < 2; ++ai)
#pragma unroll
            for (int m = 0; m < 4; ++m) { const int rl = ai * 128 + m * 16 + rl0; const bool real = pm < MT - 1;
                const size_t tuo = real ? (size_t)(16 + ((pm & 15) << 8) + ai * 128 + m * 16) * 256 : 0; const unsigned tvo = (unsigned)(((real ? rl0 : fr) * 16 + (i0 >> 1)) * 16);
                float q; { const f32x4 p4 = *(const f32x4*)(ss + rl * 16 + fq * 4); q = (p4[0] + p4[1]) + (p4[2] + p4[3]); q += __shfl_xor(q, 16); q += __shfl_xor(q, 32); }
                const float rs = fast_rsq(q * (1.0f / 1024.0f) + EPS) * QPRE_MLA;
                const f32x4 cs0 = ldu<f32x4>(TAB, tuo, tvo), cs1 = ldu<f32x4>(TAB, tuo + 16, tvo);
#pragma unroll
                for (int bj = 0; bj < 2; ++bj) { const int gblk = 4 * pn + 2 * bj + (wc >> 1); f32x4 v0 = acc[ai][bj][m][0] * rs, v1 = acc[ai][bj][m][1] * rs;
                    if (gblk % 3 == 2) { v0 = rope4(v0, cs0); v1 = rope4(v1, cs1); }
                    stu<u32x4>(dst, (size_t)((ai * 128 + m * 16) * 3072 + bj * 128) * 2, voff, pack8(v0, v1)); }
                asm volatile("" ::: "memory"); }
    }
};
struct EpiKV {
    static constexpr bool ASWAP = false;
    bf16_t* KVA; const float* SS_CKV;
    __device__ __forceinline__ void operator()(const AccT& acc, const Unit& u, int wr, int wc, int fr, int fq, LAS unsigned char*) const {
        const int rl0 = wr * 64 + fr, cw = wc * 32 + 8 * fq;
        bf16_t* dst = KVA + (size_t)u.pm * 256 * 4096 + u.pn * 256; const unsigned voff = (unsigned)((rl0 * 4096 + cw) * 2); const float* ss = SS_CKV + (size_t)u.pm * 256 * 8;
#pragma unroll
        for (int ai = 0; ai < 2; ++ai)
#pragma unroll
            for (int m = 0; m < 4; ++m) { float q; { const f32x2 p2 = *(const f32x2*)(ss + (ai * 128 + m * 16 + rl0) * 8 + fq * 2); q = p2[0] + p2[1]; q += __shfl_xor(q, 16); q += __shfl_xor(q, 32); }
                const float rs = fast_rsq(q * (1.0f / 512.0f) + EPS);
#pragma unroll
                for (int bj = 0; bj < 2; ++bj) stu<u32x4>(dst, (size_t)((ai * 128 + m * 16) * 4096 + bj * 128) * 2, voff, pack8(acc[ai][bj][m][0] * rs, acc[ai][bj][m][1] * rs)); }
    }
};
template <int STEP> struct EpiMerge {
    static constexpr bool ASWAP = false;
    bf16_t* MG; bf16_t *GA, *GB, *GAM, *GBM;
    __device__ __forceinline__ void operator()(const AccT& acc, const Unit& u, int wr, int wc, int fr, int fq, LAS unsigned char*) const {
        const unsigned voff = (unsigned)(((wr * 64 + fr) * D + wc * 32 + 8 * fq) * 2); const bool real = u.pm < MT - 1;
        char* ga = (char*)(real ? GA + (size_t)u.pm * 256 * D : GAM) + u.pn * 512; const char* gb = (const char*)(real ? GB + (size_t)u.pm * 256 * D : GBM) + u.pn * 512;
        char* mg = (char*)(MG + (size_t)u.pm * 256 * D) + u.pn * 512;
#pragma unroll
        for (int ai = 0; ai < 2; ++ai)
#pragma unroll
            for (int m = 0; m < 4; ++m) { const size_t uo = (size_t)(ai * 128 + m * 16) * D * 2;
#pragma unroll
                for (int bj = 0; bj < 2; ++bj) {
                    const u32x4 a = *(const u32x4*)(ga + uo + bj * 256 + voff);
                    const f32x4 a0 = {bf_lo(a.x), bf_hi(a.x), bf_lo(a.y), bf_hi(a.y)}, a1 = {bf_lo(a.z), bf_hi(a.z), bf_lo(a.w), bf_hi(a.w)};
                    if constexpr (STEP == 0) { *(u32x4*)(ga + uo + bj * 256 + voff) = pack8(acc[ai][bj][m][0] * a0, acc[ai][bj][m][1] * a1); }
                    else { const u32x4 b = *(const u32x4*)(gb + uo + bj * 256 + voff);
                        const f32x4 s0 = {bf_lo(b.x), bf_hi(b.x), bf_lo(b.y), bf_hi(b.y)}, s1 = {bf_lo(b.z), bf_hi(b.z), bf_lo(b.w), bf_hi(b.w)};
                        stu<u32x4>(mg, uo + bj * 256, voff, pack8(a0 + acc[ai][bj][m][0] * s0, a1 + acc[ai][bj][m][1] * s1)); } }
                asm volatile("" ::: "memory"); }
    }
};
struct EpiRowSS {
    static constexpr bool ASWAP = false;
    bf16_t* O; float* SS;
    __device__ __forceinline__ void operator()(const AccT& acc, const Unit& u, int wr, int wc, int fr, int fq, LAS unsigned char*) const {
        const int rl0 = wr * 64 + fr, cw = wc * 32 + 8 * fq;
        bf16_t* dst = O + (size_t)u.pm * 256 * D + u.pn * 256; const unsigned voff = (unsigned)((rl0 * D + cw) * 2); float* ss = SS + (size_t)u.pm * 256 * 64 + u.pn * 4 + wc;
#pragma unroll
        for (int ai = 0; ai < 2; ++ai)
#pragma unroll
            for (int m = 0; m < 4; ++m) { float s = 0.f;
#pragma unroll
                for (int bj = 0; bj < 2; ++bj) { s += sumsq8(acc[ai][bj][m][0], acc[ai][bj][m][1]);
                    stu<u32x4>(dst, (size_t)((ai * 128 + m * 16) * D + bj * 128) * 2, voff, pack8(acc[ai][bj][m][0], acc[ai][bj][m][1])); }
                s += __shfl_xor(s, 16); s += __shfl_xor(s, 32);
                if (fq == 0) ss[(ai * 128 + m * 16 + rl0) * 64] = s; }
    }
};
template <int CTRL> __device__ __forceinline__ float dpp_f(float v) { return __int_as_float(__builtin_amdgcn_update_dpp(0, __float_as_int(v), CTRL, 0xf, 0xf, true)); }
struct EpiUp {
    static constexpr bool ASWAP = true;
    bf16_t* F; float *HALOA, *HALOG, *METAA; const float *wconv, *bconv;
    __device__ __forceinline__ void operator()(const AccT& acc, const Unit& u, int wr, int wc, int fr, int fq, LAS unsigned char*) const {
        const int pm = u.pm, pn = u.pn, cw = wc * 32 + 8 * fq, col = pn * 128 + cw;
        f32x4 w0[2], w1[2], w2[2], bb[2];
#pragma unroll
        for (int n = 0; n < 2; ++n) { w0[n] = *(const f32x4*)(wconv + col + 4 * n); w1[n] = *(const f32x4*)(wconv + DFF + col + 4 * n); w2[n] = *(const f32x4*)(wconv + 2 * DFF + col + 4 * n); bb[n] = *(const f32x4*)(bconv + col + 4 * n); }
#pragma unroll
        for (int ai = 0; ai < 2; ++ai)
#pragma unroll
            for (int m = 0; m < 4; ++m) {
                const int g = ai * 4 + m;
                const int wl = g * 16 + fr, row = pm * 256 + wr * 128 + wl;
                f32x4 fo[2];
#pragma unroll
                for (int n = 0; n < 2; ++n) {
                    const f32x4 a = acc[ai][0][m][n];
                    f32x4 pv, nx;
#pragma unroll
                    for (int j = 0; j < 4; ++j) {
                        const float pin = dpp_f<0x111>(a[j]);
                        const float nin = dpp_f<0x101>(a[j]);
                        float pout = 0.f, nout = 0.f;
                        if (g > 0) pout = dpp_f<0x10F>(acc[(g - 1) >> 2][0][(g - 1) & 3][n][j]);
                        if (g < 7) nout = dpp_f<0x11F>(acc[(g + 1) >> 2][0][(g + 1) & 3][n][j]);
                        pv[j] = fr == 0 ? pout : pin; nx[j] = fr == 15 ? nout : nin;
                    }
                    const f32x4 c = pv * w0[n] + a * w1[n] + nx * w2[n] + bb[n];
                    const f32x4 gv = acc[ai][1][m][n];
#pragma unroll
                    for (int j = 0; j < 4; ++j) fo[n][j] = gelu_tanh(c[j]) * gv[j];
                }
                stu<u32x4, true>(F + (size_t)(pm * 256 + wr * 128) * DFF + pn * 128, (size_t)(g * 16) * DFF * 2, (unsigned)((fr * DFF + cw) * 2), pack8(fo[0], fo[1]));
                if (g == 0 && fr < 2) { float* h = HALOA + ((size_t)(pm * 8 + wr * 4 + fr)) * DFF + col; *(f32x4*)h = acc[ai][0][m][0]; *(f32x4*)(h + 4) = acc[ai][0][m][1];
                    if (fr == 0) { float* hg = HALOG + ((size_t)(pm * 4 + wr * 2)) * DFF + col; *(f32x4*)hg = acc[ai][1][m][0]; *(f32x4*)(hg + 4) = acc[ai][1][m][1]; } }
                if (g == 7 && fr >= 14) { float* h = HALOA + ((size_t)(pm * 8 + wr * 4 + 2 + (fr - 14))) * DFF + col; *(f32x4*)h = acc[ai][0][m][0]; *(f32x4*)(h + 4) = acc[ai][0][m][1];
                    if (fr == 15) { float* hg = HALOG + ((size_t)(pm * 4 + wr * 2 + 1)) * DFF + col; *(f32x4*)hg = acc[ai][1][m][0]; *(f32x4*)(hg + 4) = acc[ai][1][m][1]; } }
            }
    }
};

namespace att {
constexpr int KVBLK = 64, NT = 65;
constexpr int SHM_V = 64 * 128 * 2, SHM_K = 64 * 128 * 2, SHM_R = 64 * 64 * 2;
constexpr int OFF_V = 0, OFF_K = 3 * SHM_V, OFF_R = OFF_K + 2 * SHM_K, OFF_W = OFF_R + 2 * SHM_R, OSTRIDE = 272;
static_assert(OFF_W + 8 * 256 <= RING_BYTES && 8 * 32 * OSTRIDE <= OFF_W, "attention LDS map");
#define KSWZ(row, colB) ((row) * 256 + ((colB) ^ (((row) & 7) << 4)))
#define RSWZ(row, colB) ((row) * 128 + ((colB) ^ (((row) & 7) << 4)))
#define SBAR() __builtin_amdgcn_sched_barrier(0)
__device__ __forceinline__ int crow(int r, int hi) { return (r & 3) + 8 * (r >> 2) + 4 * hi; }
template <int SCALE_X1000000> struct Cst { };
__device__ __forceinline__ void partialSM(f32x16& p0, f32x16& p1, float& m_reg, float& mn, float& alpha, const float C, const float THRS) {
    float pmax = p0[0];
#pragma unroll
    for (int r = 1; r < 16; ++r) pmax = fmaxf(pmax, p0[r]);
#pragma unroll
    for (int r = 0; r < 16; ++r) pmax = fmaxf(pmax, p1[r]);
    { auto rr = __builtin_amdgcn_permlane32_swap(__float_as_uint(pmax), __float_as_uint(pmax), false, false); pmax = fmaxf(__uint_as_float(rr[0]), __uint_as_float(rr[1])); }
    if (__builtin_expect(__all(pmax - m_reg <= THRS), 1)) { mn = m_reg; alpha = 1.f; }
    else { mn = fmaxf(m_reg, pmax); alpha = fast_exp2((m_reg - mn) * C); m_reg = mn; }
    const float mnC = -mn * C;
#pragma unroll
    for (int r = 0; r < 16; ++r) p0[r] = fmaf(p0[r], C, mnC);
#pragma unroll
    for (int r = 0; r < 16; ++r) p1[r] = fmaf(p1[r], C, mnC);
#pragma unroll
    for (int r = 0; r < 16; ++r) p0[r] = fast_exp2(p0[r]);
}
__device__ __forceinline__ void partialSMp(f32x16& p0, f32x16& p1, float& mneg, float& alpha, float& l_reg, const float THR2, const bool first) {
    float pmax = p0[0];
#pragma unroll
    for (int r = 1; r < 16; ++r) pmax = fmaxf(pmax, p0[r]);
#pragma unroll
    for (int r = 0; r < 16; ++r) pmax = fmaxf(pmax, p1[r]);
    { auto rr = __builtin_amdgcn_permlane32_swap(__float_as_uint(pmax), __float_as_uint(pmax), false, false); pmax = fmaxf(__uint_as_float(rr[0]), __uint_as_float(rr[1])); }
    if (__builtin_expect(!first && __all(pmax <= THR2), 1)) { alpha = 1.f; }
    else { const float d = first ? pmax : fmaxf(pmax, 0.f); alpha = first ? 1.f : fast_exp2(-d); mneg -= d; l_reg *= alpha;
#pragma unroll
        for (int r = 0; r < 16; ++r) { p0[r] -= d; p1[r] -= d; } }
#pragma unroll
    for (int r = 0; r < 16; ++r) p0[r] = fast_exp2(p0[r]);
}
__device__ __forceinline__ void finishSM(f32x16& p0, f32x16& p1, float& l_reg, bf16x8& pa0, bf16x8& pa1, bf16x8& pa2, bf16x8& pa3) {
#pragma unroll
    for (int r = 0; r < 16; ++r) p1[r] = fast_exp2(p1[r]);
    float ps = 0;
#pragma unroll
    for (int r = 0; r < 16; ++r) ps += p0[r];
#pragma unroll
    for (int r = 0; r < 16; ++r) ps += p1[r];
    l_reg += ps;
#define PK4(P, BASE, OUT) do { unsigned a0 = cvt_pk_bf16(P[BASE + 0], P[BASE + 1]), a1 = cvt_pk_bf16(P[BASE + 2], P[BASE + 3]);   \
    unsigned b0 = cvt_pk_bf16(P[BASE + 4], P[BASE + 5]), b1 = cvt_pk_bf16(P[BASE + 6], P[BASE + 7]);                              \
    u32x4 w = {a0, a1, b0, b1}; OUT = *reinterpret_cast<bf16x8*>(&w); } while (0)
    PK4(p0, 0, pa0); PK4(p0, 8, pa1); PK4(p1, 0, pa2); PK4(p1, 8, pa3);
#undef PK4
}
template <int NQF> __device__ __forceinline__ void qkt(f32x16& p0, f32x16& p1, const LAS char* Ks, const LAS char* Rs, const bf16x8* qr, int r32, int hi, float nm, const f32x16* mtp = nullptr) {
    f32x16 c0;
    if (mtp) c0 = *mtp;
    else { asm volatile("" : "+v"(nm));
#pragma unroll
        for (int r = 0; r < 16; ++r) c0[r] = nm; }
    p0 = c0; p1 = c0;
    auto LD0 = [&](int d) -> bf16x8 { const int cb = ((d & 7) * 16 + hi * 8) * 2; return d < 8 ? *(const LAS bf16x8*)(Ks + KSWZ(r32, cb)) : *(const LAS bf16x8*)(Rs + RSWZ(r32, cb)); };
    auto LD1 = [&](int d) -> bf16x8 { const int cb = ((d & 7) * 16 + hi * 8) * 2; return d < 8 ? *(const LAS bf16x8*)(Ks + KSWZ(32 + r32, cb)) : *(const LAS bf16x8*)(Rs + RSWZ(32 + r32, cb)); };
    constexpr int PD = QK_PD, NR = PD + 1;
    bf16x8 fa[NR], fb[NR];
#pragma unroll
    for (int d = 0; d < PD; ++d) { fa[d] = LD0(d); fb[d] = LD1(d); }
#pragma unroll
    for (int d = 0; d < NQF; ++d) {
        if (d + PD < NQF) { fa[(d + PD) % NR] = LD0(d + PD); fb[(d + PD) % NR] = LD1(d + PD); }
        __builtin_amdgcn_sched_barrier(0x406);
        p0 = __builtin_amdgcn_mfma_f32_32x32x16_bf16(fa[d % NR], qr[d], p0, 0, 0, 0);
        p1 = __builtin_amdgcn_mfma_f32_32x32x16_bf16(fb[d % NR], qr[d], p1, 0, 0, 0);
        __builtin_amdgcn_sched_barrier(0x406);
    }
}
__device__ __forceinline__ int v_st(int k, int c) { const int kk = k; return ((kk >> 3) * 4 + (c >> 5)) * 512 + ((kk & 7) * 32 + (c & 31)) * 2; }
__device__ __forceinline__ int v_rd_base(int lane) { return ((lane & 3) << 3) | (((lane >> 2) & 3) << 6) | (((lane >> 4) & 1) << 5) | (((lane >> 5) & 1) << 8); }
constexpr int v_rd_off(int d0, int ks, int half) { return d0 * 512 + ks * 4096 + half * 2048; }
template <int OFF> __device__ __forceinline__ s16x4 tr_read(int vb) { s16x4 r; asm volatile("ds_read_b64_tr_b16 %0, %1 offset:%2" : "=&v"(r) : "v"(vb), "i"(OFF) : "memory"); return r; }
template <int D0> __device__ __forceinline__ void pv_one(f32x16& od, int vb, bf16x8 pa0, bf16x8 pa1, bf16x8 pa2, bf16x8 pa3) {
    const s16x4 l0 = tr_read<v_rd_off(D0, 0, 0)>(vb), h0 = tr_read<v_rd_off(D0, 0, 1)>(vb), l1 = tr_read<v_rd_off(D0, 1, 0)>(vb), h1 = tr_read<v_rd_off(D0, 1, 1)>(vb);
    const s16x4 l2 = tr_read<v_rd_off(D0, 2, 0)>(vb), h2 = tr_read<v_rd_off(D0, 2, 1)>(vb), l3 = tr_read<v_rd_off(D0, 3, 0)>(vb), h3 = tr_read<v_rd_off(D0, 3, 1)>(vb);
    asm volatile("s_waitcnt lgkmcnt(0)" ::: "memory"); SBAR();
#define PK(L, H) (bf16x8){L[0], L[1], L[2], L[3], H[0], H[1], H[2], H[3]}
    od = __builtin_amdgcn_mfma_f32_32x32x16_bf16(pa0, PK(l0, h0), od, 0, 0, 0);
    od = __builtin_amdgcn_mfma_f32_32x32x16_bf16(pa1, PK(l1, h1), od, 0, 0, 0);
    od = __builtin_amdgcn_mfma_f32_32x32x16_bf16(pa2, PK(l2, h2), od, 0, 0, 0);
    od = __builtin_amdgcn_mfma_f32_32x32x16_bf16(pa3, PK(l3, h3), od, 0, 0, 0);
#undef PK
}
__device__ __forceinline__ void pv_psm(f32x16* o, int vb, bf16x8 pa0, bf16x8 pa1, bf16x8 pa2, bf16x8 pa3, f32x16& p0, f32x16& p1, float& mneg, float& alpha, float& l_reg, const float THR2) {
    pv_one<0>(o[0], vb, pa0, pa1, pa2, pa3);
    float pmax = p0[0];
#pragma unroll
    for (int r = 1; r < 16; ++r) pmax = fmaxf(pmax, p0[r]);
    pv_one<1>(o[1], vb, pa0, pa1, pa2, pa3);
#pragma unroll
    for (int r = 0; r < 16; ++r) pmax = fmaxf(pmax, p1[r]);
    { auto rr = __builtin_amdgcn_permlane32_swap(__float_as_uint(pmax), __float_as_uint(pmax), false, false); pmax = fmaxf(__uint_as_float(rr[0]), __uint_as_float(rr[1])); }
    if (__builtin_expect(__all(pmax <= THR2), 1)) { alpha = 1.f; }
    else { const float d = fmaxf(pmax, 0.f); alpha = fast_exp2(-d); mneg -= d; l_reg *= alpha;
#pragma unroll
        for (int r = 0; r < 16; ++r) { p0[r] -= d; p1[r] -= d; } }
    pv_one<2>(o[2], vb, pa0, pa1, pa2, pa3);
#pragma unroll
    for (int r = 0; r < 8; ++r) p0[r] = fast_exp2(p0[r]);
    asm volatile("" : "+v"(p0));
    pv_one<3>(o[3], vb, pa0, pa1, pa2, pa3);
#pragma unroll
    for (int r = 8; r < 16; ++r) p0[r] = fast_exp2(p0[r]);
    asm volatile("" : "+v"(p0));
}
__device__ __forceinline__ void pv_d0(f32x16* o, int vb, bf16x8 pa0, bf16x8 pa1, bf16x8 pa2, bf16x8 pa3) {
    pv_one<0>(o[0], vb, pa0, pa1, pa2, pa3); pv_one<1>(o[1], vb, pa0, pa1, pa2, pa3); pv_one<2>(o[2], vb, pa0, pa1, pa2, pa3); pv_one<3>(o[3], vb, pa0, pa1, pa2, pa3);
}
template <int NQF, int LDQ, int LDK, int LDV, int SDEPTH, int ABL = 0, bool DMA = false>
__device__ __forceinline__ void attn_unit(const bf16_t* __restrict__ Qw, const bf16_t* __restrict__ Kh, const bf16_t* __restrict__ Vh, const bf16_t* __restrict__ Rh,
                                          int kbase, int mrow, bf16_t* __restrict__ Ob, int orow0, int nrows_valid, LAS char* lds, const float SCALE) {
    int tid_ = threadIdx.x; asm volatile("" : "+v"(tid_));
    const int tid = tid_, wid = __builtin_amdgcn_readfirstlane(tid >> 6), lane = tid & 63, r32 = lane & 31, hi = lane >> 5;
    constexpr float THR2 = 8.0f * 1.4426950408889634f; (void)SCALE;
    LAS char* V_lds = lds + OFF_V; LAS char* K_lds = lds + OFF_K; LAS char* R_lds = lds + OFF_R;
    LAS float* ws = (LAS float*)(lds + OFF_W) + wid * 64; LAS float* li_l = ws; LAS float* al_l = ws + 32;
    float l_reg = 0; f32x16 o[4] = {}; bf16x8 qr[NQF]; float mneg = 0.f; f32x16 mt = {}; constexpr bool MT = (NQF == 8) && MT_GQA;
#pragma unroll
    for (int d0 = 0; d0 < NQF; ++d0) qr[d0] = *(const bf16x8*)(Qw + d0 * 16);
    const int sr = tid >> 4, sc = (tid & 15) * 8, vst0 = v_st(sr, sc), vst1 = v_st(32 + sr, sc);
    const int rr = tid >> 3, rc = (tid & 7) * 8;
    const int vb0 = (int)(uintptr_t)V_lds + v_rd_base(lane);
    struct { bf16x8 vs0, vs1, ks0, ks1, rs; } sr_[SDEPTH];
    const __amdgpu_buffer_rsrc_t rsK = __builtin_amdgcn_make_buffer_rsrc((void*)Kh, (short)0, 0x7fffffff, 0x00020000);
    const __amdgpu_buffer_rsrc_t rsV = __builtin_amdgcn_make_buffer_rsrc((void*)Vh, (short)0, 0x7fffffff, 0x00020000);
    const __amdgpu_buffer_rsrc_t rsR = __builtin_amdgcn_make_buffer_rsrc((void*)(NQF > 8 ? Rh : Kh), (short)0, 0x7fffffff, 0x00020000);
    const unsigned dR = (unsigned)((8 * wid + (lane >> 3)) * 128 + (((lane & 7) * 16) ^ (((lane >> 3) & 7) << 4)));
    unsigned dK[2], dV[2];
#pragma unroll
    for (int q = 0; q < 2; ++q) { const int rowK = 8 * wid + 4 * q + (lane >> 4), slotB = (lane & 15) * 16; dK[q] = (unsigned)(rowK * (LDK * 2) + (slotB ^ ((rowK & 7) << 4)));
        const int sub = 4 * wid + 2 * q + (lane >> 5), kk = (sub >> 2) * 8 + ((lane & 31) >> 2), k = kk, c = (sub & 3) * 32 + (lane & 3) * 8;
        dV[q] = (unsigned)(k * (LDV * 2) + c * 2); }
#define DMA_TILE(t, kb, vo) do { const unsigned sk_ = (unsigned)(kbase + ((t) - 1) * 64) * (unsigned)(LDK * 2), sv_ = (unsigned)(kbase + ((t) - 1) * 64) * (unsigned)(LDV * 2); \
    _Pragma("unroll") for (int q_ = 0; q_ < 2; ++q_) { \
        __builtin_amdgcn_raw_ptr_buffer_load_lds(rsK, (LAS void*)(K_lds + (kb) * SHM_K + (2 * wid + q_) * 1024), 16, dK[q_], sk_, 0, 0); \
        __builtin_amdgcn_raw_ptr_buffer_load_lds(rsV, (LAS void*)(V_lds + (vo) + (2 * wid + q_) * 1024), 16, dV[q_], sv_, 0, 0); } \
    if constexpr (NQF > 8) __builtin_amdgcn_raw_ptr_buffer_load_lds(rsR, (LAS void*)(R_lds + (kb) * SHM_R + wid * 1024), 16, dR, (unsigned)(kbase + ((t) - 1) * 64) * 128u, 0, 0); } while (0)
#define SLOADR(i, r0, r1, r2) do { sr_[i].vs0 = *(const bf16x8*)(Vh + (size_t)(r0) * LDV + sc); sr_[i].vs1 = *(const bf16x8*)(Vh + (size_t)(r1) * LDV + sc); \
    sr_[i].ks0 = *(const bf16x8*)(Kh + (size_t)(r0) * LDK + sc); sr_[i].ks1 = *(const bf16x8*)(Kh + (size_t)(r1) * LDK + sc); \
    if constexpr (NQF > 8) sr_[i].rs = *(const bf16x8*)(Rh + (size_t)(r2) * 64 + rc); } while (0)
#define SLOAD(i, j) if constexpr (!(ABL & 2)) SLOADR(i, kbase + ((j) - 1) * 64 + sr, kbase + ((j) - 1) * 64 + 32 + sr, kbase + ((j) - 1) * 64 + rr)
#define SWRITE(b, vo, i) do { *(LAS bf16x8*)(V_lds + (vo) + vst0) = sr_[i].vs0; *(LAS bf16x8*)(V_lds + (vo) + vst1) = sr_[i].vs1; const int kc = sc * 2; \
    *(LAS bf16x8*)(K_lds + (b) * SHM_K + KSWZ(sr, kc)) = sr_[i].ks0; *(LAS bf16x8*)(K_lds + (b) * SHM_K + KSWZ(32 + sr, kc)) = sr_[i].ks1; \
    if constexpr (NQF > 8) *(LAS bf16x8*)(R_lds + (b) * SHM_R + RSWZ(rr, rc * 2)) = sr_[i].rs; } while (0)
#define SWAIT() do { if constexpr (ABL & 2) break; if constexpr (SDEPTH == 2) { if constexpr (NQF > 8) asm volatile("s_waitcnt vmcnt(5)" ::: "memory"); else asm volatile("s_waitcnt vmcnt(4)" ::: "memory"); } else asm volatile("s_waitcnt vmcnt(0)" ::: "memory"); } while (0)
#define RESC(a) do { if (__any((a) < 1.f)) { if (hi == 0) al_l[r32] = (a); asm volatile("s_waitcnt lgkmcnt(0)" ::: "memory"); \
    _Pragma("unroll") for (int d = 0; d < 4; ++d) _Pragma("unroll") for (int r = 0; r < 16; ++r) o[d][r] *= al_l[crow(r, hi)]; \
    if constexpr (MT) { _Pragma("unroll") for (int r = 0; r < 16; ++r) mt[r] = mneg; } } } while (0)
#define QKT_(P0, P1, ...) do { if constexpr (ABL & 8) { _Pragma("unroll") for (int r_ = 0; r_ < 16; ++r_) { P0[r_] = mneg; P1[r_] = mneg; } asm volatile("" : "+v"(P0), "+v"(P1)); } else qkt<NQF>(P0, P1, __VA_ARGS__); } while (0)
#define PSM_(P0, P1, MN, AL, L, T, F) do { if constexpr (ABL & 1) { AL = 1.f; asm volatile("" : "+v"(P0), "+v"(P1)); } else partialSMp(P0, P1, MN, AL, L, T, F); } while (0)
#define FSM_(P0, P1, L, A0, A1, A2, A3) do { if constexpr (ABL & 1) { u32x4 w0_ = {cvt_pk_bf16(P0[0], P0[1]), cvt_pk_bf16(P0[2], P0[3]), cvt_pk_bf16(P0[4], P0[5]), cvt_pk_bf16(P0[6], P0[7])}, w1_ = {cvt_pk_bf16(P0[8], P0[9]), cvt_pk_bf16(P0[10], P0[11]), cvt_pk_bf16(P0[12], P0[13]), cvt_pk_bf16(P0[14], P0[15])}, \
    w2_ = {cvt_pk_bf16(P1[0], P1[1]), cvt_pk_bf16(P1[2], P1[3]), cvt_pk_bf16(P1[4], P1[5]), cvt_pk_bf16(P1[6], P1[7])}, w3_ = {cvt_pk_bf16(P1[8], P1[9]), cvt_pk_bf16(P1[10], P1[11]), cvt_pk_bf16(P1[12], P1[13]), cvt_pk_bf16(P1[14], P1[15])}; \
    A0 = __builtin_bit_cast(bf16x8, w0_); A1 = __builtin_bit_cast(bf16x8, w1_); A2 = __builtin_bit_cast(bf16x8, w2_); A3 = __builtin_bit_cast(bf16x8, w3_); L += P0[0]; } else finishSM(P0, P1, L, A0, A1, A2, A3); } while (0)
#ifndef PV_FUSE
#define PV_FUSE 1
#endif
#define PVPSM_(O, VB, A0, A1, A2, A3, P0, P1, AL) do { if constexpr ((ABL & ~2) != 0 || !PV_FUSE) { PVD_(O, VB, A0, A1, A2, A3); PSM_(P0, P1, mneg, AL, l_reg, THR2, false); } else pv_psm(O, VB, A0, A1, A2, A3, P0, P1, mneg, AL, l_reg, THR2); } while (0)
#define PVD_(O, VB, A0, A1, A2, A3) do { if constexpr (ABL & 4) { asm volatile("" :: "v"(A0), "v"(A1), "v"(A2), "v"(A3)); } else pv_d0(O, VB, A0, A1, A2, A3); } while (0)
    f32x16 pA0, pA1, pB0, pB1; float alA, alB; bf16x8 pa0, pa1, pa2, pa3;
    constexpr int SE = 0, SO = SDEPTH - 1;
    SLOADR(SE, mrow + (sr & 15), mrow + (sr & 15), mrow + (rr & 15)); asm volatile("s_waitcnt vmcnt(0)" ::: "memory"); SWRITE(0, 0, SE); __syncthreads();
    QKT_(pA0, pA1, K_lds, R_lds, qr, r32, hi, mneg, MT ? &mt : nullptr);
#pragma unroll
    for (int r = 8; r < 16; ++r) pA0[r] = -1e30f;
#pragma unroll
    for (int r = 0; r < 16; ++r) pA1[r] = -1e30f;
    if constexpr (DMA) DMA_TILE(1, 1, SHM_V);
    PSM_(pA0, pA1, mneg, alA, l_reg, THR2, true);
    if constexpr (MT) {
#pragma unroll
        for (int r = 0; r < 16; ++r) mt[r] = mneg; }
    if constexpr (DMA) { asm volatile("s_waitcnt vmcnt(0)" ::: "memory"); __syncthreads(); }
    else { SLOAD(SO, 1); if constexpr (SDEPTH == 2) { SLOAD(SE, 2); }
        SWAIT(); SWRITE(1, SHM_V, SO); __syncthreads(); }
    int vro = 0, vwo = 2 * SHM_V;
    for (int j = 1; j + 1 < NT; j += 2) {
        if constexpr (DMA) { if constexpr (!(ABL & 2)) DMA_TILE(j + 1, 0, vwo); vwo = vwo == 2 * SHM_V ? 0 : vwo + SHM_V; }
        SBAR(); QKT_(pB0, pB1, K_lds + SHM_K, R_lds + SHM_R, qr, r32, hi, mneg, MT ? &mt : nullptr);
        FSM_(pA0, pA1, l_reg, pa0, pa1, pa2, pa3); SBAR();
        if constexpr (!DMA) { if (SDEPTH == 1 || j + 2 < NT) SLOAD(SO, j + SDEPTH); } SBAR();
        PVPSM_(o, vb0 + vro, pa0, pa1, pa2, pa3, pB0, pB1, alB); vro = vro == 2 * SHM_V ? 0 : vro + SHM_V;
        if constexpr (DMA) asm volatile("s_waitcnt vmcnt(0)" ::: "memory");
        else { SWAIT(); if constexpr (!(ABL & 2)) SWRITE(0, vwo, SE); vwo = vwo == 2 * SHM_V ? 0 : vwo + SHM_V; }
        RESC(alB); __syncthreads();
        if constexpr (DMA) { if (j + 2 < NT) { if constexpr (!(ABL & 2)) DMA_TILE(j + 2, 1, vwo); vwo = vwo == 2 * SHM_V ? 0 : vwo + SHM_V; } }
        SBAR(); QKT_(pA0, pA1, K_lds, R_lds, qr, r32, hi, mneg, MT ? &mt : nullptr);
        FSM_(pB0, pB1, l_reg, pa0, pa1, pa2, pa3); SBAR();
        if constexpr (!DMA) { if (j + 1 + SDEPTH < NT) SLOAD(SE, j + 1 + SDEPTH); } SBAR();
        PVPSM_(o, vb0 + vro, pa0, pa1, pa2, pa3, pA0, pA1, alA); vro = vro == 2 * SHM_V ? 0 : vro + SHM_V;
        if constexpr (DMA) asm volatile("s_waitcnt vmcnt(0)" ::: "memory");
        else if (j + 2 < NT) { SWAIT(); if constexpr (!(ABL & 2)) SWRITE(1, vwo, SO); vwo = vwo == 2 * SHM_V ? 0 : vwo + SHM_V; }
        RESC(alA); __syncthreads();
    }
    FSM_(pA0, pA1, l_reg, pa0, pa1, pa2, pa3); SBAR();
    PVD_(o, vb0 + ((NT - 1) % 3) * SHM_V, pa0, pa1, pa2, pa3);
    asm volatile("s_waitcnt vmcnt(0)" ::: "memory");
    { auto rr = __builtin_amdgcn_permlane32_swap(__float_as_uint(l_reg), __float_as_uint(l_reg), false, false); l_reg = __uint_as_float(rr[0]) + __uint_as_float(rr[1]); }
    if (hi == 0) li_l[r32] = l_reg; asm volatile("s_waitcnt lgkmcnt(0)" ::: "memory");
    float rli[16];
#pragma unroll
    for (int r = 0; r < 16; ++r) rli[r] = fast_rcp(li_l[crow(r, hi)]);
    __syncthreads();
    LAS char* ost = lds + wid * (32 * OSTRIDE);
#pragma unroll
    for (int r = 0; r < 16; ++r) { const int orow = crow(r, hi);
#pragma unroll
        for (int d0 = 0; d0 < 4; ++d0) { const unsigned w = cvt_pk_bf16(o[d0][r] * rli[r], 0.f); *(LAS unsigned short*)(ost + orow * OSTRIDE + (d0 * 32 + r32) * 2) = (unsigned short)w; } }
    asm volatile("s_waitcnt lgkmcnt(0)" ::: "memory");
#pragma unroll
    for (int i = 0; i < 8; ++i) { const int c = i * 64 + lane, row = c >> 4, c16 = c & 15;
        const u32x4 v = *(const LAS u32x4*)(ost + row * OSTRIDE + c16 * 16);
        if (row < nrows_valid) *(u32x4*)(Ob + (size_t)(orow0 + row) * D + c16 * 8) = v; }
    asm volatile("s_waitcnt lgkmcnt(0)" ::: "memory");
    __syncthreads();
#undef QKT_
#undef PSM_
#undef FSM_
#undef PVD_
#undef PVPSM_
#undef SLOADR
#undef SLOAD
#undef SWRITE
#undef SWAIT
#undef RESC
#undef DMA_TILE
}
template <int NQF, int LDQ, int LDK, int LDV>
__device__ __forceinline__ void attn_unit_s1(const bf16_t* __restrict__ Qw, const bf16_t* __restrict__ Kh, const bf16_t* __restrict__ Vh, const bf16_t* __restrict__ Rh,
                                             int kbase, int mrow, bf16_t* __restrict__ Ob, int orow0, int nrows_valid, LAS char* lds, const float SCALE) {
    int tid_ = threadIdx.x; asm volatile("" : "+v"(tid_));
    const int tid = tid_, wid = __builtin_amdgcn_readfirstlane(tid >> 6), lane = tid & 63, r32 = lane & 31, hi = lane >> 5;
    constexpr float THR2 = 8.0f * 1.4426950408889634f; (void)SCALE;
    LAS char* V_lds = lds + OFF_V; LAS char* K_lds = lds + OFF_K; LAS char* R_lds = lds + OFF_R;
    LAS float* ws = (LAS float*)(lds + OFF_W) + wid * 64; LAS float* li_l = ws; LAS float* al_l = ws + 32;
    float l_reg = 0; f32x16 o[4] = {}; bf16x8 qr[NQF]; float mneg = 0.f;
#pragma unroll
    for (int d0 = 0; d0 < NQF; ++d0) qr[d0] = *(const bf16x8*)(Qw + d0 * 16);
    const int sr = tid >> 4, sc = (tid & 15) * 8, vst0 = v_st(sr, sc), vst1 = v_st(32 + sr, sc);
    const int rr = tid >> 3, rc = (tid & 7) * 8;
    const int vb0 = (int)(uintptr_t)V_lds + v_rd_base(lane);
    bf16x8 vs0, vs1, ks0, ks1, rs_;
#define S1LOAD(r0, r1, r2) do { vs0 = *(const bf16x8*)(Vh + (size_t)(r0) * LDV + sc); vs1 = *(const bf16x8*)(Vh + (size_t)(r1) * LDV + sc); \
    ks0 = *(const bf16x8*)(Kh + (size_t)(r0) * LDK + sc); ks1 = *(const bf16x8*)(Kh + (size_t)(r1) * LDK + sc); \
    if constexpr (NQF > 8) rs_ = *(const bf16x8*)(Rh + (size_t)(r2) * 64 + rc); } while (0)
#define S1WRITE(b) do { *(LAS bf16x8*)(V_lds + (b) * SHM_V + vst0) = vs0; *(LAS bf16x8*)(V_lds + (b) * SHM_V + vst1) = vs1; const int kc = sc * 2; \
    *(LAS bf16x8*)(K_lds + (b) * SHM_K + KSWZ(sr, kc)) = ks0; *(LAS bf16x8*)(K_lds + (b) * SHM_K + KSWZ(32 + sr, kc)) = ks1; \
    if constexpr (NQF > 8) *(LAS bf16x8*)(R_lds + (b) * SHM_R + RSWZ(rr, rc * 2)) = rs_; } while (0)
    f32x16 p0, p1; float al; bf16x8 pa0, pa1, pa2, pa3;
    S1LOAD(mrow + (sr & 15), mrow + (sr & 15), mrow + (rr & 15)); asm volatile("s_waitcnt vmcnt(0)" ::: "memory"); S1WRITE(0); __syncthreads();
    for (int j = 0; j < NT; ++j) {
        const int bs = j & 1;
        if (j + 1 < NT) S1LOAD(kbase + j * 64 + sr, kbase + j * 64 + 32 + sr, kbase + j * 64 + rr);
        SBAR(); qkt<NQF>(p0, p1, K_lds + bs * SHM_K, R_lds + bs * SHM_R, qr, r32, hi, mneg);
        if (j == 0) {
#pragma unroll
            for (int r = 8; r < 16; ++r) p0[r] = -1e30f;
#pragma unroll
            for (int r = 0; r < 16; ++r) p1[r] = -1e30f;
        }
        partialSMp(p0, p1, mneg, al, l_reg, THR2, j == 0);
        if (__any(al < 1.f)) { if (hi == 0) al_l[r32] = al; asm volatile("s_waitcnt lgkmcnt(0)" ::: "memory");
#pragma unroll
            for (int d = 0; d < 4; ++d)
#pragma unroll
                for (int r = 0; r < 16; ++r) o[d][r] *= al_l[crow(r, hi)]; }
        finishSM(p0, p1, l_reg, pa0, pa1, pa2, pa3); SBAR();
        pv_d0(o, vb0 + bs * SHM_V, pa0, pa1, pa2, pa3);
        if (j + 1 < NT) { asm volatile("s_waitcnt vmcnt(0)" ::: "memory"); S1WRITE(bs ^ 1); }
        __syncthreads();
    }
    { auto rr = __builtin_amdgcn_permlane32_swap(__float_as_uint(l_reg), __float_as_uint(l_reg), false, false); l_reg = __uint_as_float(rr[0]) + __uint_as_float(rr[1]); }
    if (hi == 0) li_l[r32] = l_reg; asm volatile("s_waitcnt lgkmcnt(0)" ::: "memory");
    float rli[16];
#pragma unroll
    for (int r = 0; r < 16; ++r) rli[r] = fast_rcp(li_l[crow(r, hi)]);
    LAS char* ost = lds + wid * (32 * OSTRIDE);
#pragma unroll
    for (int r = 0; r < 16; ++r) { const int orow = crow(r, hi);
#pragma unroll
        for (int d0 = 0; d0 < 4; ++d0) { const unsigned w = cvt_pk_bf16(o[d0][r] * rli[r], 0.f); *(LAS unsigned short*)(ost + orow * OSTRIDE + (d0 * 32 + r32) * 2) = (unsigned short)w; } }
    asm volatile("s_waitcnt lgkmcnt(0)" ::: "memory");
#pragma unroll
    for (int i = 0; i < 8; ++i) { const int c = i * 64 + lane, row = c >> 4, c16 = c & 15;
        const u32x4 v = *(const LAS u32x4*)(ost + row * OSTRIDE + c16 * 16);
        if (row < nrows_valid) *(u32x4*)(Ob + (size_t)(orow0 + row) * D + c16 * 8) = v; }
    asm volatile("s_waitcnt lgkmcnt(0)" ::: "memory");
    __syncthreads();
#undef S1LOAD
#undef S1WRITE
}
}

__device__ __forceinline__ float bfv(const bf16_t* p) { return __uint_as_float(((unsigned)*p) << 16); }
__device__ __forceinline__ void meta_attn_task(int t, const bf16_t* QA, const bf16_t* KVA, const bf16_t* KR, const bf16_t* QB, const bf16_t* KB, const bf16_t* VB, bf16_t* OB, LAS unsigned char* lds) {
    const int tid = threadIdx.x, lane = tid & 63, wv = tid >> 6;
    const int br = t / 96, b = (t % 96) >> 4, h = t & 15, R = MREAL + 16 * b + 15, dk = br ? 128 : 192; const float scale = 0.6931471805599453f;
    LAS float* sc = (LAS float*)lds; LAS float* qv = sc + 4128; LAS float* red = qv + 192; LAS float* part = red + 32;
    if (tid < dk) qv[tid] = br ? bfv(QB + (size_t)R * 2048 + h * 128 + tid) : bfv(QA + (size_t)R * 3072 + h * 192 + tid);
    __syncthreads();
    float mx = -1e30f;
    {
        const int sub = lane & 15, grp = lane >> 4;
        float qn[8], qr_[8];
#pragma unroll
        for (int i = 0; i < 8; ++i) { qn[i] = qv[8 * sub + i]; qr_[i] = (!br && sub < 8) ? qv[128 + 8 * sub + i] : 0.f; }
        const bf16_t* kb_ = br ? KB + (h >> 2) * 128 + 8 * sub : KVA + h * 256 + 8 * sub; const size_t kp = br ? 512 : 4096;
        constexpr int UN = 8;
        for (int j0 = wv * 4 + grp; j0 < LSEQ; j0 += 32 * UN) {
            u32x4 w[UN], w2[UN];
#pragma unroll
            for (int u = 0; u < UN; ++u) { const int j = j0 + 32 * u, jc = j < LSEQ ? j : 0; const int kr = jc < 16 ? MREAL + 16 * b + jc : b * SEQ + (jc - 16);
                w[u] = *(const u32x4*)(kb_ + (size_t)kr * kp);
                w2[u] = (!br && sub < 8) ? *(const u32x4*)(KR + (size_t)kr * 64 + 8 * sub) : (u32x4){0u, 0u, 0u, 0u}; }
#pragma unroll
            for (int u = 0; u < UN; ++u) { const int j = j0 + 32 * u;
                float a = (bf_lo(w[u].x) * qn[0] + bf_hi(w[u].x) * qn[1]) + (bf_lo(w[u].y) * qn[2] + bf_hi(w[u].y) * qn[3]) + (bf_lo(w[u].z) * qn[4] + bf_hi(w[u].z) * qn[5]) + (bf_lo(w[u].w) * qn[6] + bf_hi(w[u].w) * qn[7]);
                a += (bf_lo(w2[u].x) * qr_[0] + bf_hi(w2[u].x) * qr_[1]) + (bf_lo(w2[u].y) * qr_[2] + bf_hi(w2[u].y) * qr_[3]) + (bf_lo(w2[u].z) * qr_[4] + bf_hi(w2[u].z) * qr_[5]) + (bf_lo(w2[u].w) * qr_[6] + bf_hi(w2[u].w) * qr_[7]);
                a += __shfl_xor(a, 1); a += __shfl_xor(a, 2); a += __shfl_xor(a, 4); a += __shfl_xor(a, 8);
                a *= scale;
                if (sub == 0 && j < LSEQ) { sc[j] = a; mx = fmaxf(mx, a); } }
        }
    }
#pragma unroll
    for (int o = 1; o < 64; o <<= 1) mx = fmaxf(mx, __shfl_xor(mx, o));
    if (lane == 0) red[wv] = mx;
    __syncthreads();
    mx = fmaxf(fmaxf(fmaxf(red[0], red[1]), fmaxf(red[2], red[3])), fmaxf(fmaxf(red[4], red[5]), fmaxf(red[6], red[7])));
    float ps = 0.f;
    for (int j = tid; j < LSEQ; j += 512) { const float p = fast_exp2((sc[j] - mx) * 1.4426950408889634f); sc[j] = p; ps += p; }
    ps = wave_sum(ps); if (lane == 0) red[8 + wv] = ps;
    __syncthreads();
    const float tot = ((red[8] + red[9]) + (red[10] + red[11])) + ((red[12] + red[13]) + (red[14] + red[15]));
    {
        const int sub = lane & 15, grp = lane >> 4, j0 = wv * 514;
        const bf16_t* vb_ = br ? VB + (h >> 2) * 128 + 8 * sub : KVA + h * 256 + 128 + 8 * sub; const size_t vp = br ? 512 : 4096;
        float a[8];
#pragma unroll
        for (int i = 0; i < 8; ++i) a[i] = 0.f;
        constexpr int UN = 32;
        for (int jj = grp; jj < 514; jj += 4 * UN) { u32x4 w[UN]; float p[UN];
#pragma unroll
            for (int u = 0; u < UN; ++u) { const int q_ = jj + 4 * u; const bool ok = q_ < 514; const int jc = ok ? j0 + q_ : j0; const int kr = jc < 16 ? MREAL + 16 * b + jc : b * SEQ + (jc - 16);
                w[u] = *(const u32x4*)(vb_ + (size_t)kr * vp); p[u] = ok ? sc[jc] : 0.f; }
#pragma unroll
            for (int u = 0; u < UN; ++u) { a[0] += p[u] * bf_lo(w[u].x); a[1] += p[u] * bf_hi(w[u].x); a[2] += p[u] * bf_lo(w[u].y); a[3] += p[u] * bf_hi(w[u].y);
                a[4] += p[u] * bf_lo(w[u].z); a[5] += p[u] * bf_hi(w[u].z); a[6] += p[u] * bf_lo(w[u].w); a[7] += p[u] * bf_hi(w[u].w); } }
#pragma unroll
        for (int i = 0; i < 8; ++i) { a[i] += __shfl_xor(a[i], 16); a[i] += __shfl_xor(a[i], 32); }
        if (grp == 0) {
#pragma unroll
            for (int i = 0; i < 8; ++i) part[wv * 128 + 8 * sub + i] = a[i]; } }
    __syncthreads();
    if (tid < 128) { float o = 0.f;
#pragma unroll
        for (int q = 0; q < 8; ++q) o += part[q * 128 + tid];
        o *= fast_rcp(tot); OB[(size_t)R * D + br * 2048 + h * 128 + tid] = (bf16_t)(cvt_pk_bf16(o, 0.f) & 0xffffu); }
    __syncthreads();
}

template <bool XBF> __device__ __forceinline__ void dot6(const void* X, size_t xstride, const bf16_t* Wrow, int K, int lane, float (&acc)[6]) {
#pragma unroll
    for (int r = 0; r < 6; ++r) acc[r] = 0.f;
    for (int k0 = lane * 8; k0 < K; k0 += 512) {
        const u32x4 w = *(const u32x4*)(Wrow + k0); const f32x4 w0 = {bf_lo(w.x), bf_hi(w.x), bf_lo(w.y), bf_hi(w.y)}, w1 = {bf_lo(w.z), bf_hi(w.z), bf_lo(w.w), bf_hi(w.w)};
#pragma unroll
        for (int r = 0; r < 6; ++r) { f32x4 x0, x1;
            if constexpr (XBF) { const u32x4 x = *(const u32x4*)((const bf16_t*)X + r * xstride + k0); x0 = (f32x4){bf_lo(x.x), bf_hi(x.x), bf_lo(x.y), bf_hi(x.y)}; x1 = (f32x4){bf_lo(x.z), bf_hi(x.z), bf_lo(x.w), bf_hi(x.w)}; }
            else { x0 = *(const f32x4*)((const float*)X + r * xstride + k0); x1 = *(const f32x4*)((const float*)X + r * xstride + k0 + 4); }
            acc[r] += (x0[0] * w0[0] + x0[1] * w0[1]) + (x0[2] * w0[2] + x0[3] * w0[3]) + (x1[0] * w1[0] + x1[1] * w1[1]) + (x1[2] * w1[2] + x1[3] * w1[3]); } }
#pragma unroll
    for (int r = 0; r < 6; ++r) acc[r] = wave_sum(acc[r]);
}

#define XB_TMO      128
#define XB_XCNT(j)  (256  + 64 * (j))
#define XB_XSUB(j)  (1280 + 64 * (j))
#define XB_XGEN(j)  (2304 + 64 * (j))
#define XB_TOP      3328
#define XB_TOPGEN   3392
#define XCD_BAR_WORDS 3456
#define XB_SPIN_CAP (1u << 18)
__device__ __forceinline__ unsigned xb_ld(unsigned* p)              { return __hip_atomic_load(p, __ATOMIC_RELAXED, __HIP_MEMORY_SCOPE_AGENT); }
__device__ __forceinline__ unsigned xb_add(unsigned* p, unsigned v) { return __hip_atomic_fetch_add(p, v, __ATOMIC_RELAXED, __HIP_MEMORY_SCOPE_AGENT); }
__device__ __forceinline__ unsigned xb_xcc_id() { return (unsigned)__builtin_amdgcn_s_getreg((3 << 11) | 20) & 0xFu; }
#define XB_SPIN(cond, bar) do { unsigned _sp = 0; while (cond) { __builtin_amdgcn_s_sleep(1); \
    if ((++_sp & 255u) == 0u) { if (xb_ld(&(bar)[XB_TMO])) break; if (_sp > XB_SPIN_CAP) { atomicAdd(&(bar)[XB_TMO], 1u); break; } } } } while (0)
struct XcdBarrier { unsigned* bar; unsigned x; volatile LAS unsigned* st; };
__device__ __forceinline__ XcdBarrier xcd_barrier_post(unsigned* bar, volatile LAS unsigned* st) {
    XcdBarrier b; b.bar = bar; b.x = xb_xcc_id(); b.st = st;
    if (threadIdx.x == 0) (void)xb_add(&bar[XB_XCNT(b.x)], 1u);
    return b;
}
__device__ __forceinline__ void xcd_barrier_complete(unsigned* bar, unsigned x, unsigned& nloc, unsigned& nx) {
    const unsigned G = gridDim.x * gridDim.y * gridDim.z;
    unsigned sum, cnt, mine, sp = 0u;
    for (;;) {
        sum = 0u; cnt = 0u; mine = 0u;
#pragma unroll
        for (unsigned j = 0; j < 16; ++j) { const unsigned c = xb_ld(&bar[XB_XCNT(j)]); sum += c; cnt += (c > 0u) ? 1u : 0u; mine = (j == x) ? c : mine; }
        if (sum == G) break;
        __builtin_amdgcn_s_sleep(1);
        if ((++sp & 255u) == 0u) { if (xb_ld(&bar[XB_TMO])) break; if (sp > XB_SPIN_CAP) { atomicAdd(&bar[XB_TMO], 1u); break; } }
    }
    nloc = mine > 0u ? mine : 1u; nx = cnt > 0u ? cnt : 1u;
}
__device__ __forceinline__ void xcd_barrier(const XcdBarrier& b) {
    asm volatile("s_waitcnt vmcnt(0)" ::: "memory");
    __syncthreads();
    if (threadIdx.x == 0) {
        unsigned* bar = b.bar;
        __builtin_amdgcn_s_waitcnt(0);
        unsigned nloc = b.st[0], nx = b.st[1];
        if (nloc == 0u) { xcd_barrier_complete(bar, b.x, nloc, nx); b.st[0] = nloc; b.st[1] = nx; }
        const unsigned old = xb_add(&bar[XB_XSUB(b.x)], 1u);
        const unsigned gen = old / nloc;
        if (old + 1u == (gen + 1u) * nloc) {
            __builtin_amdgcn_fence(__ATOMIC_RELEASE, "agent");
            asm volatile("s_waitcnt vmcnt(0)" ::: "memory");
            const unsigned og = xb_add(&bar[XB_TOP], 1u);
            const unsigned tg = og / nx;
            if (og + 1u == (tg + 1u) * nx) xb_add(&bar[XB_TOPGEN], 1u);
            else XB_SPIN(xb_ld(&bar[XB_TOPGEN]) == tg, bar);
            __builtin_amdgcn_fence(__ATOMIC_ACQUIRE, "agent");
            xb_add(&bar[XB_XGEN(b.x)], 1u);
            asm volatile("s_waitcnt vmcnt(0)" ::: "memory");
        } else {
            XB_SPIN(xb_ld(&bar[XB_XGEN(b.x)]) == gen, bar);
            __builtin_amdgcn_fence(__ATOMIC_ACQUIRE, "agent");
            asm volatile("s_waitcnt vmcnt(0)" ::: "memory");
        }
    }
    __syncthreads();
}

struct Args {
    const float* in[21];
    float* out; unsigned char* ws;
    int ph_lo, ph_hi;
};
enum { IN_XP = 0, IN_XS, IN_META, IN_G_PRE_MIX, IN_W_IN, IN_G_CQ, IN_W_UQ, IN_G_CKV, IN_W_UKV, IN_G_QN, IN_G_KN, IN_W_PA, IN_W_PB, IN_W_O, IN_G_POST_MIX, IN_G_PRE_FFN, IN_W_UP, IN_W_CONV, IN_B_CONV, IN_W_DOWN, IN_G_POST_FFN };
constexpr int NPHASE = 11;

__device__ __forceinline__ int pr64(int d) { return d < 32 ? 2 * d : 2 * (d - 32) + 1; }
__device__ __forceinline__ int pd128(int d) { return (d & 64) + pr64(d & 63); }
__device__ __forceinline__ int dmap(int kind, int n) {
    if (kind == 1) {
        if (n < 1536) return n;
        if (n < 1600) return 4608 + pr64(n - 1536);
        if (n < 3648) { const int q = n - 1600; return 1536 + (q & ~127) + pd128(q & 127); }
        if (n < 4160) { const int q = n - 3648; return 3584 + (q & ~127) + pd128(q & 127); }
        return 4096 + (n - 4160);
    }
    if (kind == 2) { const int h = n / 192, d = n - h * 192; return d < 128 ? n : h * 192 + 128 + pr64(d - 128); }
    if (kind == 3) { return n < DFF ? ((n >> 7) << 8) + (n & 127) : (((n - DFF) >> 7) << 8) + 128 + ((n - DFF) & 127); }
    return n;
}
__device__ __forceinline__ void conv_item(const float* __restrict__ W, int N, bf16_t* __restrict__ WT, int ldk, int kofs, const float* __restrict__ g, int kind, int item, LAS float* scr, int lane) {
    const int nblk = N >> 6, kb = item / nblk, nb = item - kb * nblk, k0 = kb * 64, n0 = nb * 64;
    const int n4 = (lane & 15) * 4;
#pragma unroll 4
    for (int i = 0; i < 16; ++i) { const int kk = (lane >> 4) + 4 * i; f32x4 v = *(const f32x4*)(W + (size_t)(k0 + kk) * N + n0 + n4);
        if (g) v = v * g[k0 + kk];
        LAS float* s = scr + kk * 65 + n4; s[0] = v[0]; s[1] = v[1]; s[2] = v[2]; s[3] = v[3]; }
    asm volatile("s_waitcnt lgkmcnt(0)" ::: "memory");
    const int c = lane & 7;
#pragma unroll
    for (int p = 0; p < 8; ++p) { const int n = (lane >> 3) + 8 * p; const LAS float* s = scr + (8 * c) * 65 + n;
        u32x4 o; o.x = cvt_pk_bf16(s[0], s[65]); o.y = cvt_pk_bf16(s[2 * 65], s[3 * 65]); o.z = cvt_pk_bf16(s[4 * 65], s[5 * 65]); o.w = cvt_pk_bf16(s[6 * 65], s[7 * 65]);
        *(u32x4*)(WT + (size_t)dmap(kind, n0 + n) * ldk + kofs + k0 + 8 * c) = o; }
    asm volatile("s_waitcnt lgkmcnt(0)" ::: "memory");
}

__device__ __forceinline__ void conv_item8(const float* __restrict__ W, int N, int ncol0, unsigned char* __restrict__ WT8, int item, LAS float* scr, int lane) {
    const int nblk = DGATE >> 6, kb = item / nblk, nb = item - kb * nblk, k0 = kb * 64, n0 = nb * 64;
    const int n4 = (lane & 15) * 4;
#pragma unroll 4
    for (int i = 0; i < 16; ++i) { const int kk = (lane >> 4) + 4 * i; const f32x4 v = *(const f32x4*)(W + (size_t)(k0 + kk) * N + ncol0 + n0 + n4) * W8_SCALE;
        LAS float* s = scr + kk * 65 + n4; s[0] = v[0]; s[1] = v[1]; s[2] = v[2]; s[3] = v[3]; }
    asm volatile("s_waitcnt lgkmcnt(0)" ::: "memory");
    const int c = lane & 3;
#pragma unroll
    for (int p = 0; p < 4; ++p) { const int n = (lane >> 2) + 16 * p; const LAS float* s = scr + (16 * c) * 65 + n; u32x4 o;
#pragma unroll
        for (int q = 0; q < 4; ++q) { int w = __builtin_amdgcn_cvt_pk_fp8_f32(s[(4 * q) * 65], s[(4 * q + 1) * 65], 0, false); w = __builtin_amdgcn_cvt_pk_fp8_f32(s[(4 * q + 2) * 65], s[(4 * q + 3) * 65], w, true); o[q] = (unsigned)w; }
        *(u32x4*)(WT8 + (size_t)(n0 + n) * D + k0 + 16 * c) = o; }
    asm volatile("s_waitcnt lgkmcnt(0)" ::: "memory");
}

__global__ void __launch_bounds__(512, 2) fwd(Args args) {
    extern __shared__ __attribute__((aligned(16))) unsigned char lds_raw[];
    LAS unsigned char* lds = (LAS unsigned char*)lds_raw;
    volatile LAS unsigned* MISC = (volatile LAS unsigned*)(lds + MISC_OFF);
#define TID_HERE() ({ int t_ = threadIdx.x; asm volatile("" : "+v"(t_)); t_; })
    const int wave = __builtin_amdgcn_readfirstlane((int)threadIdx.x >> 6);
    const int G = gridDim.x, bx = blockIdx.x;
    const int vcu = (G % 8 == 0) ? (bx % 8) * (G / 8) + bx / 8 : bx;
    unsigned char* ws = args.ws;
    unsigned* ctl = (unsigned*)(ws + WS_CTL);
    for (int u = threadIdx.x; u < (LDS_BYTES - MISC_OFF) / 4; u += 512) ((LAS unsigned*)(lds + MISC_OFF))[u] = 0u;
    __syncthreads();
    XcdBarrier bar; bar.bar = ctl + CW_BAR; bar.x = 0; bar.st = nullptr;
#if MK_ONE_LAUNCH
    bar = xcd_barrier_post(ctl + CW_BAR, MISC + 8);
#define SEAM() xcd_barrier(bar)
#else
#define SEAM() do { } while (0)
#endif
    (void)bar;
    const int lo = args.ph_lo, hi = args.ph_hi;
#ifdef DBG_STAMP
    unsigned long long* stamps = (unsigned long long*)(ws + 1370 * MiB);
    if (bx == 0 && threadIdx.x == 0) stamps[0] = __builtin_amdgcn_s_memrealtime();
#define STAMP(k) do { if (bx == 0 && threadIdx.x == 0) stamps[(k) + 1] = __builtin_amdgcn_s_memrealtime(); } while (0)
#else
#define STAMP(k) do { } while (0)
#endif
#ifndef PH_MASK
#define PH_MASK 0x7ff
#endif
#define IN(k) ((((PH_MASK) >> (k)) & 1) && lo <= (k) && (k) < hi)
#define BOTH(k) (IN(k) && IN((k) + 1))
    bf16_t* Win_t = (bf16_t*)(ws + WS_WIN); bf16_t* Wuq_t = (bf16_t*)(ws + WS_WUQ); bf16_t* Wukv_t = (bf16_t*)(ws + WS_WUKV); bf16_t* Wp_t = (bf16_t*)(ws + WS_WP);
    bf16_t* Wo_t = (bf16_t*)(ws + WS_WO); bf16_t* Wup_t = (bf16_t*)(ws + WS_WUP); bf16_t* Wdn_t = (bf16_t*)(ws + WS_WDN);
    bf16_t* U = (bf16_t*)(ws + WS_U); bf16_t* OB = (bf16_t*)(ws + WS_U); bf16_t* U2 = (bf16_t*)(ws + WS_U); bf16_t* DD = (bf16_t*)(ws + WS_U);
    bf16_t* ZCQ = (bf16_t*)(ws + WS_ZCQ); bf16_t* ZCKV = (bf16_t*)(ws + WS_ZCKV); bf16_t* QB = (bf16_t*)(ws + WS_QB); bf16_t* KB = (bf16_t*)(ws + WS_KB); bf16_t* VB = (bf16_t*)(ws + WS_VB);
    bf16_t* KR = (bf16_t*)(ws + WS_KR); bf16_t* QA = (bf16_t*)(ws + WS_QA); bf16_t* KVA = (bf16_t*)(ws + WS_KVA); bf16_t* MG = (bf16_t*)(ws + WS_MG); bf16_t* TT = (bf16_t*)(ws + WS_T);
    bf16_t* F = (bf16_t*)(ws + WS_F); float* HALOA = (float*)(ws + WS_HALOA); float* HALOG = (float*)(ws + WS_HALOG); float* METAA = (float*)(ws + WS_METAA);
    bf16_t* GAM = (bf16_t*)(ws + WS_GAM); bf16_t* GBM = (bf16_t*)(ws + WS_GBM);
    float* MG6 = (float*)(ws + WS_H1M); float* T6 = MG6 + 6 * D; float* U26 = T6 + 6 * D;
    bf16_t* GA = (bf16_t*)args.out; bf16_t* GB = (bf16_t*)args.out + (size_t)MREAL * D;
    float* SS_CQ = (float*)(ws + WS_SSP + SSP_CQ); float* SS_CKV = (float*)(ws + WS_SSP + SSP_CKV); float* SS_T = (float*)(ws + WS_SSP + SSP_T); float* SS_D = (float*)(ws + WS_SSP + SSP_D);
    const f32x4* TAB = (const f32x4*)(ws + WS_TAB);
    const int gw = vcu * 8 + wave, NGW = G * 8;

    for (int rep_ = 0; rep_ < (DUP_PHASE == 0 ? 2 : 1); ++rep_) if (IN(0)) {
        const int lane = TID_HERE() & 63;
        LAS float* scr = (LAS float*)(lds + wave * 16640);
        constexpr int I_IN = 64 * (4672 / 64)  , I_IN8 = 64 * (DGATE / 64)  , I_UQ = 16 * (3072 / 64), I_UKV = 8 * (4096 / 64), I_PA = 32 * 64, I_PB = 32 * 64, I_O = 64 * 64, I_UP = 64 * (22016 / 64), I_DN = (DFF / 64) * 64;
        constexpr int NITEMS = I_IN + I_IN8 + I_UQ + I_UKV; (void)I_PA; (void)I_PB; (void)I_O;
        (void)I_UP; (void)I_DN;
        for (int it = gw; it < NITEMS; it += NGW) {
            int r = it;
            if (r < I_IN) { const int kb = r / 73, nb = r - kb * 73; conv_item(args.in[IN_W_IN], 12864, Win_t, D, 0, nullptr, 1, kb * 201 + nb, scr, lane); continue; } r -= I_IN;
            if (r < I_IN8) { conv_item8(args.in[IN_W_IN], 12864, 4672, (unsigned char*)(ws + WS_WIN8), r, scr, lane); continue; } r -= I_IN8;
            if (r < I_UQ) { conv_item(args.in[IN_W_UQ], 3072, Wuq_t, 1024, 0, args.in[IN_G_CQ], 2, r, scr, lane); continue; } r -= I_UQ;
            conv_item(args.in[IN_W_UKV], 4096, Wukv_t, 512, 0, args.in[IN_G_CKV], 0, r, scr, lane);
        }
        for (int i = gw * 64 + lane; i < 192 * D / 8; i += NGW * 64) *(u32x4*)(Win_t + (size_t)(4608 + 64) * D + (size_t)i * 8) = (u32x4){0u, 0u, 0u, 0u};
        for (int e = gw * 64 + lane; e < LSEQ * 32; e += NGW * 64) { const int p = e >> 5, i = e & 31;
            const float inv = exp2f(-(float)i * (13.287712379549449f / 32.0f)); const float ang = (float)p * inv;
            const double rev = (double)ang * 0.15915494309189535; const float fr_ = (float)(rev - rint(rev));
            ((float*)(ws + WS_TAB))[(size_t)e * 2] = __builtin_amdgcn_cosf(fr_); ((float*)(ws + WS_TAB))[(size_t)e * 2 + 1] = __builtin_amdgcn_sinf(fr_); }
        const float* gpm = args.in[IN_G_PRE_MIX];
        for (int R = gw; R < M; R += NGW) {
            const float* src = R < 2 * SEQ ? args.in[IN_XP] + (size_t)R * D : (R < MREAL ? args.in[IN_XS] + (size_t)(R - 2 * SEQ) * D : (R < MREAL + 96 ? args.in[IN_META] + (size_t)((R - MREAL) & 15) * D : nullptr));
            f32x4 v[16]; float s = 0.f;
#pragma unroll
            for (int j = 0; j < 16; ++j) { v[j] = src ? *(const f32x4*)(src + j * 256 + lane * 4) : (f32x4){0.f, 0.f, 0.f, 0.f}; s += (v[j][0] * v[j][0] + v[j][1] * v[j][1]) + (v[j][2] * v[j][2] + v[j][3] * v[j][3]); }
            const float rs = fast_rsq(wave_sum(s) * (1.0f / D) + EPS);
#pragma unroll
            for (int j = 0; j < 16; ++j) { const f32x4 gg = *(const f32x4*)(gpm + j * 256 + lane * 4); const f32x4 y = v[j] * rs * gg;
                u32x2 w; w.x = cvt_pk_bf16(y[0], y[1]); w.y = cvt_pk_bf16(y[2], y[3]); *(u32x2*)(U + (size_t)R * D + j * 256 + lane * 4) = w;
                int w8 = __builtin_amdgcn_cvt_pk_fp8_f32(y[0] * U8_SCALE, y[1] * U8_SCALE, 0, false); w8 = __builtin_amdgcn_cvt_pk_fp8_f32(y[2] * U8_SCALE, y[3] * U8_SCALE, w8, true);
                *(int*)(ws + WS_U8 + (size_t)R * D + j * 256 + lane * 4) = w8; }
        }
        asm volatile("s_waitcnt vmcnt(0) lgkmcnt(0)" ::: "memory"); __syncthreads();
        if (BOTH(0)) SEAM(); STAMP(0);
    }
    for (int rep_ = 0; rep_ < (DUP_PHASE == 1 ? 2 : 1); ++rep_) if (IN(1)) {
        {
            pg8::Gemm g{ws + WS_U8, ws + WS_WIN8, M, DGATE, D, D}; pg8::StaticOrder S; S.init(M, DGATE, G, bx);
            EpiGate E{ws, GA};
            pg8::gemm_phase<EpiGate, true, true, true>(lds, lds + EPI_OFF, g, S, E);
        }
        {
            pg8::Gemm g{U, Win_t, M, DINP, D, D * 2}; pg8::StaticOrder S; S.init(M, DINP, G, (bx + 205) % G);
            EpiP1 E{ws, GA, args.in[IN_G_QN], args.in[IN_G_KN]};
            pg8::gemm_phase<EpiP1>(lds, lds + EPI_OFF, g, S, E);
        }
        __syncthreads();
        if (G == 256 ? (bx >= 102 || (bx >= 32 && bx < 51)) : true) {
            const int lane = TID_HERE() & 63; LAS float* scr = (LAS float*)(lds + wave * 16640); constexpr int I_UP = 64 * (22016 / 64);
            const int k = G == 256 ? (bx < 51 ? bx - 32 : bx - 102 + 19) : bx, nw = (G == 256 ? 173 : G) * 8;
            for (int it = k * 8 + wave; it < I_UP; it += nw) conv_item(args.in[IN_W_UP], 22016, Wup_t, 4096, 0, nullptr, 3, it, scr, lane);
            constexpr int I_PA = 32 * 64, I_PB = 32 * 64, I_O = 64 * 64;
            for (int it = k * 8 + wave; it < I_PA + I_PB + I_O; it += nw) { int r = it;
                if (r < I_PA) { conv_item(args.in[IN_W_PA], 4096, Wp_t, 4096, 0, nullptr, 0, r, scr, lane); continue; } r -= I_PA;
                if (r < I_PB) { conv_item(args.in[IN_W_PB], 4096, Wp_t, 4096, 2048, nullptr, 0, r, scr, lane); continue; } r -= I_PB;
                conv_item(args.in[IN_W_O], 4096, Wo_t, 4096, 0, nullptr, 0, r, scr, lane); }
        }
        if (BOTH(1)) SEAM(); STAMP(1);
    }
    if (IN(2)) {
        { pg8::Gemm g{ZCQ, Wuq_t, M, 3072, 1024, 1024 * 2}; pg8::StaticOrder S; S.init(M, 3072, G, bx); EpiQA E{QA, SS_CQ, TAB}; pg8::gemm_phase<EpiQA>(lds, lds + EPI_OFF, g, S, E); }
        { pg8::Gemm g{ZCKV, Wukv_t, M, 4096, 512, 512 * 2}; pg8::StaticOrder S; S.init(M, 4096, G, bx); EpiKV E{KVA, SS_CKV}; pg8::gemm_phase<EpiKV>(lds, lds + EPI_OFF, g, S, E); }
        if (BOTH(2)) SEAM(); STAMP(2);
    }
    for (int rep_ = 0; rep_ < (DUP_PHASE == 3 ? 2 : 1); ++rep_) if (IN(3)) {
        constexpr int NU1 = NBATCH * 16 * 16;
        for (int t = vcu; t < 192; t += G) meta_attn_task(t, QA, KVA, KR, QB, KB, VB, OB, lds);
#if DUP_ATT_MLA > 1
        for (int rep2_ = 0; rep2_ < DUP_ATT_MLA; ++rep2_)
#endif
        for (int ui = vcu; ui < NU1; ui += G) {
            const int lane = TID_HERE() & 63, r32 = lane & 31, hi = lane >> 5;
            const int qb = ui & 15, h = (ui >> 4) & 15, b = ui >> 8;
            const int orow0 = b * SEQ + qb * 256 + 32 * wave;
            att::attn_unit<12, 3072, 4096, 4096, 1, 0, true>(QA + (size_t)(orow0 + r32) * 3072 + h * 192 + hi * 8, KVA + h * 256, KVA + h * 256 + 128, KR, b * SEQ, MREAL + 16 * b, OB + h * 128, orow0, 32, (LAS char*)lds, 0.07216878364870322f);
        }
#if DUP_ATT_GQA > 1
        for (int rep2_ = 0; rep2_ < DUP_ATT_GQA; ++rep2_)
#endif
        for (int ui = vcu; ui < NU1; ui += G) {
            const int lane = TID_HERE() & 63, r32 = lane & 31, hi = lane >> 5;
            const int qb = ui & 15, h = (ui >> 4) & 15, b = ui >> 8;
            const int orow0 = b * SEQ + qb * 256 + 32 * wave;
#if DUP_ATT_GQA > 1 && defined(ABL_GQA)
            if (rep2_ > 0) att::attn_unit<8, 2048, 512, 512, GQA_SDEPTH, ABL_GQA, GQA_DMA>(QB + (size_t)(orow0 + r32) * 2048 + h * 128 + hi * 8, KB + (h >> 2) * 128, VB + (h >> 2) * 128, nullptr, b * SEQ, MREAL + 16 * b, (bf16_t*)(args.ws + WS_WIN), 32 * wave, 32, (LAS char*)lds, 0.08838834764831845f);
            else
#endif
            att::attn_unit<8, 2048, 512, 512, GQA_SDEPTH, 0, GQA_DMA>(QB + (size_t)(orow0 + r32) * 2048 + h * 128 + hi * 8, KB + (h >> 2) * 128, VB + (h >> 2) * 128, nullptr, b * SEQ, MREAL + 16 * b, OB + 2048 + h * 128, orow0, 32, (LAS char*)lds, 0.08838834764831845f);
        }
        if (BOTH(3)) SEAM(); STAMP(3);
    }
#ifdef DBG_STOP_AFTER
    if (DBG_STOP_AFTER == 3) {
        const int lane = TID_HERE() & 63;
        for (int R = gw; R < MREAL; R += NGW) for (int j = 0; j < 8; ++j) { const int c = j * 512 + lane * 8; const u32x4 t = *(const u32x4*)(OB + (size_t)R * D + c);
            *(f32x4*)(args.out + (size_t)R * D + c) = (f32x4){bf_lo(t.x), bf_hi(t.x), bf_lo(t.y), bf_hi(t.y)}; *(f32x4*)(args.out + (size_t)R * D + c + 4) = (f32x4){bf_lo(t.z), bf_hi(t.z), bf_lo(t.w), bf_hi(t.w)}; }
        return;
    }
#endif
    if (IN(4)) {
        {
            const int lane = TID_HERE() & 63; const bf16_t* o6 = OB + (size_t)(MREAL + 15) * D;
            for (int n = gw; n < D; n += NGW) { float aa[6], ab[6];
                dot6<true>(o6, (size_t)16 * D, Wp_t + (size_t)n * D, 2048, lane, aa); dot6<true>(o6 + 2048, (size_t)16 * D, Wp_t + (size_t)n * D + 2048, 2048, lane, ab);
                if (lane < 6) { const float sa = bf_lo((unsigned)GAM[(size_t)(16 * lane + 15) * D + n]), sb = bf_lo((unsigned)GBM[(size_t)(16 * lane + 15) * D + n]);
                    float va = aa[0], vb = ab[0];
#pragma unroll
                    for (int r = 1; r < 6; ++r) { va = lane == r ? aa[r] : va; vb = lane == r ? ab[r] : vb; }
                    MG6[lane * D + n] = sa * va + sb * vb; } }
        }
        pg8::StaticOrder S; S.init(MREAL, D, G, bx);
        { pg8::Gemm g{OB, Wp_t, MREAL, D, 2048, D * 2}; EpiMerge<0> E{MG, GA, GB, GAM, GBM}; pg8::gemm_phase<EpiMerge<0>>(lds, lds + EPI_OFF, g, S, E); }
        asm volatile("s_waitcnt vmcnt(0)" ::: "memory"); __syncthreads();
        { pg8::Gemm g{OB + 2048, Wp_t + 2048, MREAL, D, 2048, D * 2}; EpiMerge<1> E{MG, GA, GB, GAM, GBM}; pg8::gemm_phase<EpiMerge<1>>(lds, lds + EPI_OFF, g, S, E); }
        if (BOTH(4)) SEAM(); STAMP(4);
    }
    if (IN(5)) {
        {
            const int lane = TID_HERE() & 63;
            for (int n = gw; n < D; n += NGW) { float a6[6]; dot6<false>(MG6, (size_t)D, Wo_t + (size_t)n * D, D, lane, a6);
                if (lane < 6) { float v = a6[0];
#pragma unroll
                    for (int r = 1; r < 6; ++r) v = lane == r ? a6[r] : v;
                    T6[lane * D + n] = v; } }
        }
        pg8::Gemm g{MG, Wo_t, MREAL, D, D, D * 2}; pg8::StaticOrder S; S.init(MREAL, D, G, bx);
        EpiRowSS E{TT, SS_T};
        pg8::gemm_phase<EpiRowSS>(lds, lds + EPI_OFF, g, S, E);
        if (BOTH(5)) SEAM(); STAMP(5);
    }
    if (IN(6)) {
        const int lane = TID_HERE() & 63;
        const float* gpo = args.in[IN_G_POST_MIX]; const float* gpf = args.in[IN_G_PRE_FFN];
        if (gw < 6) {
            const float* mt = args.in[IN_META] + (size_t)15 * D; const float* t6 = T6 + gw * D; float q = 0.f;
            f32x4 tv[16], hv[16];
#pragma unroll
            for (int i = 0; i < 16; ++i) { const int c = i * 256 + lane * 4; tv[i] = *(const f32x4*)(t6 + c); hv[i] = *(const f32x4*)(mt + c); }
#pragma unroll
            for (int i = 0; i < 16; ++i) q += (tv[i][0] * tv[i][0] + tv[i][1] * tv[i][1]) + (tv[i][2] * tv[i][2] + tv[i][3] * tv[i][3]);
            const float rs = fast_rsq(wave_sum(q) * (1.0f / D) + EPS); float q2 = 0.f;
#pragma unroll
            for (int i = 0; i < 16; ++i) { const int c = i * 256 + lane * 4; hv[i] = hv[i] + tv[i] * rs * *(const f32x4*)(gpo + c);
                q2 += (hv[i][0] * hv[i][0] + hv[i][1] * hv[i][1]) + (hv[i][2] * hv[i][2] + hv[i][3] * hv[i][3]); }
            const float rs2 = fast_rsq(wave_sum(q2) * (1.0f / D) + EPS);
#pragma unroll
            for (int i = 0; i < 16; ++i) { const int c = i * 256 + lane * 4; *(f32x4*)(U26 + gw * D + c) = hv[i] * rs2 * *(const f32x4*)(gpf + c); }
        }
        f32x4 gpo_r[8][2], gpf_r[8][2];
#pragma unroll
        for (int j = 0; j < 8; ++j) { const int c = j * 512 + lane * 8; gpo_r[j][0] = *(const f32x4*)(gpo + c); gpo_r[j][1] = *(const f32x4*)(gpo + c + 4); gpf_r[j][0] = *(const f32x4*)(gpf + c); gpf_r[j][1] = *(const f32x4*)(gpf + c + 4); }
        for (int R = gw; R < MREAL; R += NGW) {
            const float* src = R < 2 * SEQ ? args.in[IN_XP] + (size_t)R * D : args.in[IN_XS] + (size_t)(R - 2 * SEQ) * D;
            float* h1 = args.out + (size_t)R * D;
            const float rs = fast_rsq(wave_sum(SS_T[(size_t)R * 64 + lane]) * (1.0f / D) + EPS);
            f32x4 v[8][2]; float s = 0.f;
#pragma unroll
            for (int j = 0; j < 8; ++j) { const int c = j * 512 + lane * 8; const u32x4 t = *(const u32x4*)(TT + (size_t)R * D + c);
                const f32x4 x0 = *(const f32x4*)(src + c), x1 = *(const f32x4*)(src + c + 4), g0 = gpo_r[j][0], g1 = gpo_r[j][1];
                const f32x4 t0 = {bf_lo(t.x), bf_hi(t.x), bf_lo(t.y), bf_hi(t.y)}, t1 = {bf_lo(t.z), bf_hi(t.z), bf_lo(t.w), bf_hi(t.w)};
                v[j][0] = x0 + t0 * rs * g0; v[j][1] = x1 + t1 * rs * g1;
                *(f32x4*)(h1 + c) = v[j][0]; *(f32x4*)(h1 + c + 4) = v[j][1];
#pragma unroll
                for (int q = 0; q < 4; ++q) s += v[j][0][q] * v[j][0][q] + v[j][1][q] * v[j][1][q]; }
            const float rs2 = fast_rsq(wave_sum(s) * (1.0f / D) + EPS);
#pragma unroll
            for (int j = 0; j < 8; ++j) { const int c = j * 512 + lane * 8;
                *(u32x4*)(U2 + (size_t)R * D + c) = pack8(v[j][0] * rs2 * gpf_r[j][0], v[j][1] * rs2 * gpf_r[j][1]); }
        }
        if (BOTH(6)) SEAM(); STAMP(6);
    }
#ifdef DBG_STOP_AFTER
    if (DBG_STOP_AFTER == 6) return;
#endif
    for (int rep_ = 0; rep_ < (DUP_PHASE == 7 ? 2 : 1); ++rep_) if (IN(7)) {
        {
            const int lane = TID_HERE() & 63;
            for (int c = gw; c < DFF; c += NGW) { float a6[6]; dot6<false>(U26, (size_t)D, Wup_t + (size_t)(((c >> 7) << 8) + (c & 127)) * D, D, lane, a6);
                if (lane < 6) { float v = a6[0];
#pragma unroll
                    for (int r = 1; r < 6; ++r) v = lane == r ? a6[r] : v;
                    METAA[(size_t)lane * DFF + c] = v; } }
        }
        pg8::Gemm g{U2, Wup_t, MREAL, 2 * DFF, D, D * 2}; pg8::StaticOrder S; S.init(MREAL, 2 * DFF, G, bx);
        EpiUp E{F, HALOA, HALOG, METAA, args.in[IN_W_CONV], args.in[IN_B_CONV]};
        pg8::gemm_phase<EpiUp>(lds, lds + EPI_OFF, g, S, E);
        {
            constexpr int NWG7 = (MREAL / 256) * (2 * DFF / 256); const int rem = NWG7 % G; constexpr int I_DN = (DFF / 64) * 64;
            if (rem != 0 && bx >= rem) { const int lane = TID_HERE() & 63; LAS float* scr = (LAS float*)(lds + wave * 16640); const int nw = (G - rem) * 8;
                for (int it = (bx - rem) * 8 + wave; it < I_DN; it += nw) conv_item(args.in[IN_W_DOWN], 4096, Wdn_t, DFF, 0, nullptr, 0, it, scr, lane); }
            else if (rem == 0) { const int lane = TID_HERE() & 63; LAS float* scr = (LAS float*)(lds + wave * 16640);
                for (int it = gw; it < I_DN; it += NGW) conv_item(args.in[IN_W_DOWN], 4096, Wdn_t, DFF, 0, nullptr, 0, it, scr, lane); }
        }
        if (BOTH(7)) SEAM(); STAMP(7);
    }
    if (IN(8)) {
        const float* wconv = args.in[IN_W_CONV]; const float* bconv = args.in[IN_B_CONV];
        constexpr int CH = DFF / 4;
        const int lane = TID_HERE() & 63; constexpr int SEG = (CH + 4) / 5;
        for (int p = gw / 5; p < (MT - 1) * 4; p += NGW / 5) {
            const int pm = p >> 2, rr = p & 3, seg = gw % 5;
            const float* ha = HALOA + (size_t)pm * 8 * DFF; const float* hg = HALOG + (size_t)pm * 4 * DFF;
            const float* pvp; const float* cup; const float* nxp; const float* gvp; bool nz = false;
            if (rr == 0) { pvp = (pm & 15) == 0 ? METAA + (size_t)(pm >> 4) * DFF : ha - DFF; cup = ha; nxp = ha + DFF; gvp = hg; }
            else if (rr == 1) { pvp = ha + 2 * DFF; cup = ha + 3 * DFF; nxp = ha + 4 * DFF; gvp = hg + DFF; }
            else if (rr == 2) { pvp = ha + 3 * DFF; cup = ha + 4 * DFF; nxp = ha + 5 * DFF; gvp = hg + 2 * DFF; }
            else { pvp = ha + 6 * DFF; cup = ha + 7 * DFF; nxp = ha + 8 * DFF; nz = (pm & 15) == 15; if (nz) nxp = cup; gvp = hg + 3 * DFF; }
            bf16_t* frow = F + (size_t)(pm * 256 + (rr == 0 ? 0 : rr == 1 ? 127 : rr == 2 ? 128 : 255)) * DFF;
            const int cend = (seg + 1) * SEG < CH ? (seg + 1) * SEG : CH;
#pragma unroll 3
            for (int c4 = seg * SEG + lane; c4 < cend; c4 += 64) { const int col = c4 * 4;
                const f32x4 pv = *(const f32x4*)(pvp + col), cu = *(const f32x4*)(cup + col), gv = *(const f32x4*)(gvp + col); f32x4 nx = *(const f32x4*)(nxp + col);
                if (nz) nx = (f32x4){0.f, 0.f, 0.f, 0.f};
                const f32x4 c = pv * *(const f32x4*)(wconv + col) + cu * *(const f32x4*)(wconv + DFF + col) + nx * *(const f32x4*)(wconv + 2 * DFF + col) + *(const f32x4*)(bconv + col);
                u32x2 w; w.x = cvt_pk_bf16(gelu_tanh(c[0]) * gv[0], gelu_tanh(c[1]) * gv[1]); w.y = cvt_pk_bf16(gelu_tanh(c[2]) * gv[2], gelu_tanh(c[3]) * gv[3]);
                *(u32x2*)(frow + col) = w; }
        }
        if (BOTH(8)) SEAM(); STAMP(8);
    }
    for (int rep_ = 0; rep_ < (DUP_PHASE == 9 ? 2 : 1); ++rep_) if (IN(9)) {
        pg8::Gemm g{F, Wdn_t, MREAL, D, DFF, DFF * 2}; pg8::StaticOrder S; S.init(MREAL, D, G, bx);
        EpiRowSS E{DD, SS_D};
        pg8::gemm_phase<EpiRowSS>(lds, lds + EPI_OFF, g, S, E);
        if (BOTH(9)) SEAM(); STAMP(9);
    }
    if (IN(10)) {
        const int lane = TID_HERE() & 63;
        const float* gpf = args.in[IN_G_POST_FFN];
        f32x4 g_r[8][2];
#pragma unroll
        for (int j = 0; j < 8; ++j) { const int c = j * 512 + lane * 8; g_r[j][0] = *(const f32x4*)(gpf + c); g_r[j][1] = *(const f32x4*)(gpf + c + 4); }
        for (int R = gw; R < MREAL; R += NGW) {
            const float rs = fast_rsq(wave_sum(SS_D[(size_t)R * 64 + lane]) * (1.0f / D) + EPS); float* o = args.out + (size_t)R * D;
#pragma unroll
            for (int j = 0; j < 8; ++j) { const int c = j * 512 + lane * 8; const u32x4 t = *(const u32x4*)(DD + (size_t)R * D + c);
                const f32x4 g0 = g_r[j][0], g1 = g_r[j][1];
                const f32x4 t0 = {bf_lo(t.x), bf_hi(t.x), bf_lo(t.y), bf_hi(t.y)}, t1 = {bf_lo(t.z), bf_hi(t.z), bf_lo(t.w), bf_hi(t.w)};
                *(f32x4*)(o + c) = *(const f32x4*)(o + c) + t0 * rs * g0; *(f32x4*)(o + c + 4) = *(const f32x4*)(o + c + 4) + t1 * rs * g1; }
        }
    }
#ifdef DBG_STAMP
    {   SEAM(); STAMP(10);
        asm volatile("s_waitcnt vmcnt(0)" ::: "memory"); __syncthreads();
        if (bx == 0 && threadIdx.x == 0) { __builtin_amdgcn_fence(__ATOMIC_RELEASE, "agent"); }
        SEAM();
        const unsigned long long tA = __hip_atomic_load(stamps + 2 * DBG_STAMP + 1, __ATOMIC_RELAXED, __HIP_MEMORY_SCOPE_AGENT) - __hip_atomic_load(stamps + 2 * DBG_STAMP, __ATOMIC_RELAXED, __HIP_MEMORY_SCOPE_AGENT);
        const unsigned long long tB = (2 * DBG_STAMP + 2 <= 11) ? __hip_atomic_load(stamps + 2 * DBG_STAMP + 2, __ATOMIC_RELAXED, __HIP_MEMORY_SCOPE_AGENT) - __hip_atomic_load(stamps + 2 * DBG_STAMP + 1, __ATOMIC_RELAXED, __HIP_MEMORY_SCOPE_AGENT) : 0ull;
        unsigned cA = (unsigned)(tA / 5000ull), cB = (unsigned)(tB / 5000ull); if (cA > 89u) cA = 89u; if (cB > 89u) cB = 89u;
        const float V = 100.0f * (10.0f + (float)cA); const double T = 100.0 * (10.0 + (double)cB); const size_t n1 = (size_t)(T * 3.0 * 33554432.0 / ((double)V * V));
        for (size_t i = (size_t)bx * 512 + threadIdx.x; i < (size_t)MREAL * D; i += (size_t)G * 512) args.out[i] = i < n1 ? V : 0.f;
    }
#endif
#undef IN
#undef BOTH
#undef SEAM
}

#ifndef DEBUG_CHECK
#define DEBUG_CHECK 0
#endif
#if DEBUG_CHECK
constexpr int NS = 256, NCHK = 16;
constexpr float DBG_TOL = 0.10f;
__host__ __device__ inline int srow_of(int i) {
    if (i < 240) return (int)(((long)i * 24576) / 240) + ((i * 37) % 101);
    const int sp[16] = {0, 127, 128, 255, 4095, 4096, 12288, 24575, 24576 + 15, 24576 + 16 + 15, 24576 + 32 + 15, 24576 + 48 + 15, 24576 + 64 + 15, 24576 + 80 + 15, 24576 + 7, 24576 + 80};
    return sp[i - 240];
}
#define SROW(i) srow_of(i)
constexpr size_t DBG_BASE = 1232 * MiB;
constexpr size_t DBG_ERR = DBG_BASE, DBG_Z = DBG_BASE + 1 * MiB  , DBG_A = DBG_BASE + 15 * MiB  , DBG_C = DBG_BASE + 24 * MiB  , DBG_H1 = DBG_BASE + 27 * MiB  , DBG_B = DBG_BASE + 32 * MiB  , DBG_END = DBG_BASE + 100 * MiB;
static_assert(DBG_END <= 1376 * MiB, "debug map");
__device__ __forceinline__ float bf2f(bf16_t v) { return __uint_as_float(((unsigned)v) << 16); }
__device__ __forceinline__ float block_sum(float v, float* sh) { v = wave_sum(v); __syncthreads(); if ((threadIdx.x & 63) == 0) sh[threadIdx.x >> 6] = v; __syncthreads(); float t = 0.f; for (int i = 0; i < (int)(blockDim.x >> 6); ++i) t += sh[i]; __syncthreads(); return t; }
__device__ __forceinline__ float block_max(float v, float* sh) {
#pragma unroll
    for (int o = 1; o < 64; o <<= 1) v = fmaxf(v, __shfl_xor(v, o));
    __syncthreads(); if ((threadIdx.x & 63) == 0) sh[threadIdx.x >> 6] = v; __syncthreads(); float t = 0.f; for (int i = 0; i < (int)(blockDim.x >> 6); ++i) t = fmaxf(t, sh[i]); __syncthreads(); return t; }
__device__ __forceinline__ void report(unsigned* err, int k, float maxdiff, float ss, int n, float* sh) {
    const float md = block_max(maxdiff, sh), s2 = block_sum(ss, sh);
    if (threadIdx.x == 0) { float e = md / (sqrtf(s2 / (float)n) + 1e-20f); if (!(e == e)) e = 1e30f; atomicMax(err + k, __float_as_uint(e)); }
}
__device__ __forceinline__ void dbg_cs(int p, int i, float& c, float& s) {
    const float inv = powf(10000.0f, -(float)i / 32.0f); const float ang = (float)p * inv; const double rev = (double)ang * 0.15915494309189535; const double fr = rev - rint(rev);
    const float r = (float)(fr * 6.283185307179586); c = cosf(r); s = sinf(r);
}
__device__ __forceinline__ int dbg_pos(int R) { return R < MREAL ? 16 + (R & 4095) : ((R - MREAL) & 15); }
__global__ void __launch_bounds__(256) k_dbg_gemv(const void* X, int xk, const int* rowlist, int ld, int col0, int K, const float* W, int N, float* Y, int rows) {
    const int n = blockIdx.x * 256 + threadIdx.x, s0 = blockIdx.y * 8; if (n >= N) return;
    float acc[8]; const float* xf[8]; const bf16_t* xb[8]; bool ok[8];
#pragma unroll
    for (int i = 0; i < 8; ++i) { acc[i] = 0.f; const int s = s0 + i; int R = s; if (rowlist && s < rows) R = rowlist[s]; ok[i] = s < rows && R >= 0;
        xf[i] = (const float*)X + (size_t)(ok[i] ? s : 0) * K; xb[i] = (const bf16_t*)X + (size_t)(ok[i] ? R : 0) * ld + col0; }
    if (xk == 0) { for (int k = 0; k < K; ++k) { const float w = W[(size_t)k * N + n];
#pragma unroll
            for (int i = 0; i < 8; ++i) acc[i] += xf[i][k] * w; } }
    else { for (int k = 0; k < K; ++k) { const float w = W[(size_t)k * N + n];
#pragma unroll
            for (int i = 0; i < 8; ++i) acc[i] += bf2f(xb[i][k]) * w; } }
#pragma unroll
    for (int i = 0; i < 8; ++i) if (s0 + i < rows) Y[(size_t)(s0 + i) * N + n] = ok[i] ? acc[i] : 0.f;
}
__global__ void __launch_bounds__(256) k_dbg_chk0(const float* xp, const float* xs, const float* meta, const float* g, const bf16_t* U, unsigned* err) {
    __shared__ float sh[8]; const int R = SROW(blockIdx.x);
    const float* src = R < 2 * SEQ ? xp + (size_t)R * D : (R < MREAL ? xs + (size_t)(R - 2 * SEQ) * D : meta + (size_t)((R - MREAL) & 15) * D);
    float ss = 0.f; for (int c = threadIdx.x; c < D; c += 256) ss += src[c] * src[c];
    const float tot = block_sum(ss, sh), rs = 1.0f / sqrtf(tot / D + EPS);
    float md = 0.f, s2 = 0.f; for (int c = threadIdx.x; c < D; c += 256) { const float e = src[c] * rs * g[c]; md = fmaxf(md, fabsf(e - bf2f(U[(size_t)R * D + c]))); s2 += e * e; }
    report(err, 0, md, s2, D, sh);
}
__global__ void __launch_bounds__(256) k_dbg_chk1(const float* Z, const unsigned char* ws, const bf16_t* GAo, const float* g_qn, const float* g_kn, unsigned* err) {
    __shared__ float sh[8]; const int s = blockIdx.x, R = SROW(s), t = threadIdx.x; const float* z = Z + (size_t)s * 12864;
    const bf16_t* ZCQ = (const bf16_t*)(ws + WS_ZCQ); const bf16_t* ZCKV = (const bf16_t*)(ws + WS_ZCKV); const bf16_t* QB = (const bf16_t*)(ws + WS_QB); const bf16_t* KB = (const bf16_t*)(ws + WS_KB); const bf16_t* VB = (const bf16_t*)(ws + WS_VB);
    const bf16_t* KR = (const bf16_t*)(ws + WS_KR); const float* SS_CQ = (const float*)(ws + WS_SSP + SSP_CQ); const float* SS_CKV = (const float*)(ws + WS_SSP + SSP_CKV);
    { float md = 0.f, s2 = 0.f; for (int c = t; c < 1024; c += 256) { const float e = z[c]; md = fmaxf(md, fabsf(e - bf2f(ZCQ[(size_t)R * 1024 + c]))); s2 += e * e; }
      const float tot = block_sum(s2, sh); if (t == 0) { float q = 0.f; for (int i = 0; i < 16; ++i) q += SS_CQ[(size_t)R * 16 + i]; md = fmaxf(md, fabsf(tot - q) / sqrtf(tot)); } report(err, 1, md, s2, 1024, sh); }
    { float md = 0.f, s2 = 0.f; for (int c = t; c < 512; c += 256) { const float e = z[1024 + c]; md = fmaxf(md, fabsf(e - bf2f(ZCKV[(size_t)R * 512 + c]))); s2 += e * e; }
      const float tot = block_sum(s2, sh); if (t == 0) { float q = 0.f; for (int i = 0; i < 8; ++i) q += SS_CKV[(size_t)R * 8 + i]; md = fmaxf(md, fabsf(tot - q) / sqrtf(tot)); } report(err, 1, md, s2, 512, sh); }
    { float md = 0.f, s2 = 0.f; if (t < 32) { float c, sn; dbg_cs(dbg_pos(R), t, c, sn); const float x1 = z[1536 + t], x2 = z[1536 + 32 + t]; const float o1 = x1 * c - x2 * sn, o2 = x1 * sn + x2 * c;
        md = fmaxf(fabsf(o1 - bf2f(KR[(size_t)R * 64 + 2 * t])), fabsf(o2 - bf2f(KR[(size_t)R * 64 + 2 * t + 1]))); s2 = o1 * o1 + o2 * o2; }
      report(err, 2, md, s2, 64, sh); }
    const int tk = R < MREAL ? (R & 4095) : 0, prow = tk >> 6, pcol = tk & 63;
    for (int kind = 0; kind < 2; ++kind) { const int nh = kind ? 4 : 16, zoff = kind ? 3648 : 1600; const bf16_t* dst = kind ? KB : QB; const int ld = kind ? 512 : 2048; const float* gn = kind ? g_kn : g_qn;
        float md = 0.f, s2 = 0.f;
        for (int h = 0; h < nh; ++h) { float q = 0.f; if (t < 128) q = z[zoff + h * 128 + t] * z[zoff + h * 128 + t]; const float tot = block_sum(q, sh), rs = 1.0f / sqrtf(tot / 128.f + EPS);
            if (t < 64) { const int half = t >> 5, i = t & 31; float c, sn; dbg_cs(half ? pcol : prow, i, c, sn);
                const float x1 = z[zoff + h * 128 + half * 64 + i] * rs * gn[half * 64 + i], x2 = z[zoff + h * 128 + half * 64 + 32 + i] * rs * gn[half * 64 + 32 + i];
                const float o1 = x1 * c - x2 * sn, o2 = x1 * sn + x2 * c;
                md = fmaxf(md, fmaxf(fabsf(o1 - bf2f(dst[(size_t)R * ld + h * 128 + half * 64 + 2 * i])), fabsf(o2 - bf2f(dst[(size_t)R * ld + h * 128 + half * 64 + 2 * i + 1])))); s2 += o1 * o1 + o2 * o2; } }
        report(err, 3 + kind, md, s2, nh * 128, sh); }
    { float md = 0.f, s2 = 0.f; for (int c = t; c < 512; c += 256) { const float e = z[4160 + c]; md = fmaxf(md, fabsf(e - bf2f(VB[(size_t)R * 512 + c]))); s2 += e * e; } report(err, 5, md, s2, 512, sh); }
    { float md = 0.f, s2 = 0.f; const bf16_t* ga = R < MREAL ? GAo + (size_t)R * D : (const bf16_t*)(ws + WS_GAM) + (size_t)(R - MREAL) * D; const bf16_t* gb = R < MREAL ? GAo + (size_t)MREAL * D + (size_t)R * D : (const bf16_t*)(ws + WS_GBM) + (size_t)(R - MREAL) * D;
      for (int c = t; c < D; c += 256) { const float ea = 1.0f / (1.0f + expf(-z[4672 + c])), eb = 1.0f / (1.0f + expf(-z[8768 + c])); md = fmaxf(md, fmaxf(fabsf(ea - bf2f(ga[c])), fabsf(eb - bf2f(gb[c])))); s2 += ea * ea + eb * eb; }
      report(err, 6, md, s2, 2 * D, sh); }
}
__global__ void __launch_bounds__(256) k_dbg_prep2(const float* Z, const float* g_cq, const float* g_ckv, float* A) {
    __shared__ float sh[8]; const int s = blockIdx.x, t = threadIdx.x; const float* z = Z + (size_t)s * 12864;
    float q = 0.f; for (int c = t; c < 1024; c += 256) q += z[c] * z[c]; const float r1 = 1.0f / sqrtf(block_sum(q, sh) / 1024.f + EPS);
    q = 0.f; for (int c = t; c < 512; c += 256) q += z[1024 + c] * z[1024 + c]; const float r2 = 1.0f / sqrtf(block_sum(q, sh) / 512.f + EPS);
    for (int c = t; c < 1024; c += 256) A[(size_t)s * 1536 + c] = z[c] * r1 * g_cq[c];
    for (int c = t; c < 512; c += 256) A[(size_t)s * 1536 + 1024 + c] = z[1024 + c] * r2 * g_ckv[c];
}
__global__ void __launch_bounds__(256) k_dbg_split2(const float* A, float* A1, float* A2) { const int s = blockIdx.x; for (int c = threadIdx.x; c < 1024; c += 256) A1[(size_t)s * 1024 + c] = A[(size_t)s * 1536 + c]; for (int c = threadIdx.x; c < 512; c += 256) A2[(size_t)s * 512 + c] = A[(size_t)s * 1536 + 1024 + c]; }
__global__ void __launch_bounds__(256) k_dbg_chk2(const float* YQ  , const float* YKV  , const unsigned char* ws, unsigned* err) {
    __shared__ float sh[8]; const int s = blockIdx.x, R = SROW(s), t = threadIdx.x; const bf16_t* QA = (const bf16_t*)(ws + WS_QA); const bf16_t* KVA = (const bf16_t*)(ws + WS_KVA);
    { float md = 0.f, s2 = 0.f; for (int c = t; c < 3072; c += 256) { const int h = c / 192, d = c - h * 192; const float* y = YQ + (size_t)s * 3072 + h * 192; float e; int dc;
        if (d < 128) { e = y[d]; dc = d; } else { const int i = (d - 128) & 31; float cs, sn; dbg_cs(dbg_pos(R), i, cs, sn); const float x1 = y[128 + i], x2 = y[160 + i];
            if (d < 160) { e = x1 * cs - x2 * sn; dc = 128 + 2 * i; } else { e = x1 * sn + x2 * cs; dc = 128 + 2 * i + 1; } }
        md = fmaxf(md, fabsf(e - bf2f(QA[(size_t)R * 3072 + h * 192 + dc]))); s2 += e * e; }
      report(err, 7, md, s2, 3072, sh); }
    { float md = 0.f, s2 = 0.f; for (int c = t; c < 4096; c += 256) { const float e = YKV[(size_t)s * 4096 + c]; md = fmaxf(md, fabsf(e - bf2f(KVA[(size_t)R * 4096 + c]))); s2 += e * e; } report(err, 8, md, s2, 4096, sh); }
}
__global__ void __launch_bounds__(256) k_dbg_chk3(const unsigned char* ws, unsigned* err) {
    __shared__ float sh[8]; __shared__ float sc[LSEQ]; __shared__ float qv[192];
    const int s = blockIdx.x, R = SROW(s), hh = blockIdx.y, br = hh >> 4, h = hh & 15, t = threadIdx.x;
    const int b = R < MREAL ? R >> 12 : (R - MREAL) >> 4;
    const bf16_t* QA = (const bf16_t*)(ws + WS_QA); const bf16_t* KVA = (const bf16_t*)(ws + WS_KVA); const bf16_t* KR = (const bf16_t*)(ws + WS_KR); const bf16_t* QB = (const bf16_t*)(ws + WS_QB); const bf16_t* KB = (const bf16_t*)(ws + WS_KB);
    const bf16_t* VB = (const bf16_t*)(ws + WS_VB); const bf16_t* O = (const bf16_t*)(ws + WS_U);
    const int dk = br ? 128 : 192; const float scale = br ? 0.08838834764831845f : 0.07216878364870322f;
    if (t < dk) qv[t] = br ? bf2f(QB[(size_t)R * 2048 + h * 128 + t]) : bf2f(QA[(size_t)R * 3072 + h * 192 + t]);
    __syncthreads();
    float mx = -1e30f;
    for (int j = t; j < LSEQ; j += 256) { const int kr = j < 16 ? MREAL + 16 * b + j : b * SEQ + (j - 16); float a = 0.f;
        if (br) { const bf16_t* k = KB + (size_t)kr * 512 + (h >> 2) * 128; for (int d = 0; d < 128; ++d) a += qv[d] * bf2f(k[d]); }
        else { const bf16_t* k = KVA + (size_t)kr * 4096 + h * 256; for (int d = 0; d < 128; ++d) a += qv[d] * bf2f(k[d]); const bf16_t* k2 = KR + (size_t)kr * 64; for (int d = 0; d < 64; ++d) a += qv[128 + d] * bf2f(k2[d]); }
        a *= scale; sc[j] = a; mx = fmaxf(mx, a); }
    { float m2 = -1e30f; for (int j = t; j < LSEQ; j += 256) m2 = fmaxf(m2, sc[j]);
#pragma unroll
      for (int o = 1; o < 64; o <<= 1) m2 = fmaxf(m2, __shfl_xor(m2, o));
      __syncthreads(); if ((t & 63) == 0) sh[t >> 6] = m2; __syncthreads(); mx = fmaxf(fmaxf(sh[0], sh[1]), fmaxf(sh[2], sh[3])); __syncthreads(); }
    float ps = 0.f; for (int j = t; j < LSEQ; j += 256) { const float p = expf(sc[j] - mx); sc[j] = p; ps += p; }
    const float tot = block_sum(ps, sh);
    float md = 0.f, s2 = 0.f;
    if (t < 128) { float a = 0.f; for (int j = 0; j < LSEQ; ++j) { const int kr = j < 16 ? MREAL + 16 * b + j : b * SEQ + (j - 16);
            a += sc[j] * bf2f(br ? VB[(size_t)kr * 512 + (h >> 2) * 128 + t] : KVA[(size_t)kr * 4096 + h * 256 + 128 + t]); }
        a /= tot; md = fabsf(a - bf2f(O[(size_t)R * D + br * 2048 + h * 128 + t])); s2 = a * a; }
    report(err, 9 + br, md, s2, 128, sh);
}
__global__ void __launch_bounds__(256) k_dbg_chk4(const float* YA, const float* YB, const float* Z, const unsigned char* ws, unsigned* err) {
    __shared__ float sh[8]; const int s = blockIdx.x, R = SROW(s), t = threadIdx.x; const bf16_t* MG = (const bf16_t*)(ws + WS_MG); float md = 0.f, s2 = 0.f;
    for (int c = t; c < D; c += 256) { const float sa = 1.0f / (1.0f + expf(-Z[(size_t)s * 12864 + 4672 + c])), sb = 1.0f / (1.0f + expf(-Z[(size_t)s * 12864 + 8768 + c]));
        const float e = sa * YA[(size_t)s * D + c] + sb * YB[(size_t)s * D + c]; md = fmaxf(md, fabsf(e - bf2f(MG[(size_t)R * D + c]))); s2 += e * e; }
    report(err, 11, md, s2, D, sh);
}
__global__ void __launch_bounds__(256) k_dbg_chk5(const float* YT, const float* xp, const float* xs, const float* meta, const float* gpo, const float* gpf, const unsigned char* ws, const float* outp, float* H1S, unsigned* err, int step) {
    __shared__ float sh[8]; const int s = blockIdx.x, R = SROW(s), t = threadIdx.x; const bf16_t* TT = (const bf16_t*)(ws + WS_T); const bf16_t* U2 = (const bf16_t*)(ws + WS_U);
    const float* y = YT + (size_t)s * D;
    if (step == 0) { float md = 0.f, s2 = 0.f; for (int c = t; c < D; c += 256) { md = fmaxf(md, fabsf(y[c] - bf2f(TT[(size_t)R * D + c]))); s2 += y[c] * y[c]; } report(err, 12, md, s2, D, sh); return; }
    const float* src = R < 2 * SEQ ? xp + (size_t)R * D : (R < MREAL ? xs + (size_t)(R - 2 * SEQ) * D : meta + (size_t)((R - MREAL) & 15) * D);
    float q = 0.f; for (int c = t; c < D; c += 256) q += y[c] * y[c]; const float rs = 1.0f / sqrtf(block_sum(q, sh) / D + EPS);
    q = 0.f; for (int c = t; c < D; c += 256) { const float h = src[c] + y[c] * rs * gpo[c]; H1S[(size_t)s * D + c] = h; q += h * h; }
    const float tot = block_sum(q, sh), rs2 = 1.0f / sqrtf(tot / D + EPS);
    const float* h1 = R < MREAL ? outp + (size_t)R * D : (const float*)(ws + WS_H1M) + (size_t)(R - MREAL) * D;
    float md = 0.f, s2 = 0.f; for (int c = t; c < D; c += 256) { const float h = H1S[(size_t)s * D + c], u = h * rs2 * gpf[c]; md = fmaxf(md, fmaxf(fabsf(h - h1[c]), fabsf(u - bf2f(U2[(size_t)R * D + c])))); s2 += h * h; }
    report(err, 13, md, s2, D, sh);
}
__global__ void k_dbg_rows1(int* rl) { if (threadIdx.x < NS) rl[threadIdx.x] = SROW((int)threadIdx.x); }
__global__ void k_dbg_rows3(int* rl) { const int s = threadIdx.x; if (s >= NS) return; const int R = SROW(s);
    if (R >= MREAL) { rl[3 * s] = -1; rl[3 * s + 1] = -1; rl[3 * s + 2] = -1; return; }
    const int t = R & 4095, b = R >> 12; rl[3 * s] = t == 0 ? MREAL + 16 * b + 15 : R - 1; rl[3 * s + 1] = R; rl[3 * s + 2] = t == 4095 ? -1 : R + 1; }
__global__ void __launch_bounds__(256) k_dbg_chk6(const float* UP  , const float* wconv, const float* bconv, const unsigned char* ws, unsigned* err) {
    __shared__ float sh[8]; const int s = blockIdx.x, R = SROW(s), t = threadIdx.x; const bf16_t* F = (const bf16_t*)(ws + WS_F); float md = 0.f, s2 = 0.f;
    if (R < MREAL) for (int c = t; c < DFF; c += 256) { const float ap = UP[(size_t)(3 * s) * 22016 + c], ac = UP[(size_t)(3 * s + 1) * 22016 + c], an = UP[(size_t)(3 * s + 2) * 22016 + c], gv = UP[(size_t)(3 * s + 1) * 22016 + DFF + c];
        const float v = ap * wconv[c] + ac * wconv[DFF + c] + an * wconv[2 * DFF + c] + bconv[c]; const float e = 0.5f * v * (1.0f + tanhf(0.7978845608028654f * (v + 0.044715f * v * v * v))) * gv;
        md = fmaxf(md, fabsf(e - bf2f(F[(size_t)R * DFF + c]))); s2 += e * e; }
    report(err, 14, md, s2, DFF, sh);
}
__global__ void __launch_bounds__(256) k_dbg_chk7(const float* YD, const float* H1S, const float* gpf, const float* outp, unsigned* err) {
    __shared__ float sh[8]; const int s = blockIdx.x, R = SROW(s), t = threadIdx.x; float md = 0.f, s2 = 0.f;
    if (R < MREAL) { const float* y = YD + (size_t)s * D; float q = 0.f; for (int c = t; c < D; c += 256) q += y[c] * y[c]; const float rs = 1.0f / sqrtf(block_sum(q, sh) / D + EPS);
        for (int c = t; c < D; c += 256) { const float e = H1S[(size_t)s * D + c] + y[c] * rs * gpf[c]; md = fmaxf(md, fabsf(e - outp[(size_t)R * D + c])); s2 += e * e; } }
    report(err, 15, md, s2, D, sh);
}
__global__ void __launch_bounds__(256) k_dbg_encode(const unsigned* err, const float* xp, const float* xs, float* outp) {
    int first = -1; for (int k = 0; k < NCHK; ++k) if (__uint_as_float(err[k]) > DBG_TOL) { first = k; break; }
    if (first < 0) return;
    const float sc = 1.0f + 2.0f * (float)(first + 1);
    for (size_t i = (size_t)blockIdx.x * 256 + threadIdx.x; i < (size_t)MREAL * D; i += (size_t)gridDim.x * 256) outp[i] = sc * (i < (size_t)2 * SEQ * D ? xp[i] : xs[i - (size_t)2 * SEQ * D]);
}
__global__ void __launch_bounds__(256) k_dbg_scan1(const unsigned char* ws, const bf16_t* GAo, const float* w_in, unsigned* res) {
    const int w = (blockIdx.x * 256 + threadIdx.x) >> 6, lane = threadIdx.x & 63; if (w >= MT * 51) return;
    const int pm = w / 51, pn = w % 51; if ((pn >= PN_GQ && pn < PN_GV) || pn == PN_KR) return;
    const bf16_t* U = (const bf16_t*)(ws + WS_U); bool bad = false;
    for (int e = 0; e < 8; ++e) { const int rl = (e & 3) == 0 ? 5 : (e & 3) == 1 ? 77 : (e & 3) == 2 ? 133 : 205, cl = (e >> 2) ? 147 + pm % 50 : 19 + pn; const int R = pm * 256 + rl;
        int src, ld; const bf16_t* dst; bool sig = false;
        if (pn < PN_CKV) { src = pn * 256 + cl; dst = (const bf16_t*)(ws + WS_ZCQ) + (size_t)R * 1024 + pn * 256 + cl; }
        else if (pn < PN_GQ) { src = 1024 + (pn - PN_CKV) * 256 + cl; dst = (const bf16_t*)(ws + WS_ZCKV) + (size_t)R * 512 + (pn - PN_CKV) * 256 + cl; }
        else if (pn < PN_GA) { src = 4160 + (pn - PN_GV) * 256 + cl; dst = (const bf16_t*)(ws + WS_VB) + (size_t)R * 512 + (pn - PN_GV) * 256 + cl; }
        else { const bool isa = pn < PN_GB; const int c = (pn - (isa ? PN_GA : PN_GB)) * 256 + cl; src = (isa ? 4672 : 8768) + c; sig = true;
            dst = pm < MT - 1 ? GAo + (isa ? 0 : (size_t)MREAL * D) + (size_t)R * D + c : (const bf16_t*)(ws + (isa ? WS_GAM : WS_GBM)) + (size_t)rl * D + c; }
        (void)ld; float a = 0.f; for (int k = lane; k < D; k += 64) a += bf2f(U[(size_t)R * D + k]) * w_in[(size_t)k * 12864 + src];
        a = wave_sum(a); if (sig) a = 1.0f / (1.0f + expf(-a));
        if (!(fabsf(a - bf2f(*dst)) <= 0.03f + 0.02f * fabsf(a))) bad = true; }
    if (lane == 0 && bad) { atomicAdd(res, 1u); atomicMin(res + 1, (unsigned)(pm * 64 + pn)); }
}
__global__ void __launch_bounds__(256) k_dbg_report2(const unsigned* res, float* outp) {
    const unsigned cA = res[0] > 89u ? 89u : res[0]; const unsigned first = res[1]; const unsigned cB = res[0] ? (first >> 6) : 0u;
    const float V = 100.0f * (10.0f + (float)cA); const double T = 100.0 * (10.0 + (double)cB); const size_t n1 = (size_t)(T * 3.0 * 33554432.0 / ((double)V * V));
    for (size_t i = (size_t)blockIdx.x * 256 + threadIdx.x; i < (size_t)MREAL * D; i += (size_t)gridDim.x * 256) outp[i] = i < n1 ? V : 0.f;
}
__global__ void __launch_bounds__(256) k_dbg_gateprobe(const float* Z, const unsigned char* ws, const bf16_t* GAo, unsigned* res) {
    const int s = blockIdx.x, R = SROW(s), t = threadIdx.x; __shared__ unsigned anyb;
    if (t == 0) anyb = 0u; __syncthreads();
    const bf16_t* ga = R < MREAL ? GAo + (size_t)R * D : (const bf16_t*)(ws + WS_GAM) + (size_t)(R - MREAL) * D; const bf16_t* gb = R < MREAL ? GAo + (size_t)MREAL * D + (size_t)R * D : (const bf16_t*)(ws + WS_GBM) + (size_t)(R - MREAL) * D;
    const int rl = R < MREAL ? (R & 255) : (R - MREAL);
    for (int c = t; c < 2 * D; c += 256) { const bool isb = c >= D; const int cc = isb ? c - D : c; const float e = 1.0f / (1.0f + expf(-Z[(size_t)s * 12864 + (isb ? 8768 : 4672) + cc])); const float g = bf2f(isb ? gb[cc] : ga[cc]);
        if (!(fabsf(e - g) <= 0.05f)) { const int tc = c & 255;
            atomicOr(res + 8, 1u << (rl & 15)); atomicOr(res + 9, 1u << ((rl >> 4) & 3)); atomicOr(res + 10, 1u << (rl >> 7)); atomicOr(res + 11, 1u << ((rl >> 6) & 1));
            atomicOr(res + 12, 1u << ((tc >> 5) & 3)); atomicOr(res + 13, 1u << (tc >> 7)); atomicOr(res + 14, 1u << ((tc >> 3) & 3)); atomicOr(res + 15, 1u << ((tc >> 2) & 1)); atomicAdd(res + 16, 1u); anyb = 1u; } }
    __syncthreads(); if (t == 0 && anyb) atomicAdd(res + 17, 1u);
}
__global__ void k_dbg_gatedecode(unsigned* res) {
    res[0] = res[8] & 63u; res[1] = (res[8] >> 6) & 63u; res[2] = ((res[8] >> 12) & 15u) | ((res[10] & 3u) << 4); res[3] = (res[9] & 15u) | ((res[11] & 3u) << 4);
    res[4] = (res[12] & 15u) | ((res[13] & 3u) << 4); res[5] = (res[14] & 15u) | ((res[15] & 3u) << 4); res[6] = res[17] > 63u ? 63u : res[17]; unsigned l = 0; while ((1u << l) < res[16] && l < 31) ++l; res[7] = l;
}
__global__ void __launch_bounds__(256) k_dbg_report2b(const unsigned* res, float* outp, int which) {
    const unsigned cA = res[which * 2] > 89u ? 89u : res[which * 2], cB = res[which * 2 + 1];
    const float V = 100.0f * (10.0f + (float)cA); const double T = 100.0 * (10.0 + (double)cB); const size_t n1 = (size_t)(T * 3.0 * 33554432.0 / ((double)V * V));
    for (size_t i = (size_t)blockIdx.x * 256 + threadIdx.x; i < (size_t)MREAL * D; i += (size_t)gridDim.x * 256) outp[i] = i < n1 ? V : 0.f;
}
constexpr size_t DBG_SIG = DBG_BASE + 100 * MiB;
constexpr int SIG_ROWS = 131072, NPH_SIG = 24;
__global__ void __launch_bounds__(256) k_dbg_sig(const void* base, int isf32, int nrows, int rowlen, float* sig  , int row_off, int compare, unsigned* cnt) {
    const int w = (blockIdx.x * 256 + threadIdx.x) >> 6, lane = threadIdx.x & 63, nw = (gridDim.x * 256) >> 6;
    for (int r = w; r < nrows; r += nw) { float s1 = 0.f, s2 = 0.f;
        if (isf32) { const float* p = (const float*)base + (size_t)r * rowlen; for (int c = lane; c < rowlen; c += 64) { const float v = p[c]; s1 += v; s2 += v * v; } }
        else { const bf16_t* p = (const bf16_t*)base + (size_t)r * rowlen; for (int c = lane; c < rowlen; c += 64) { const float v = bf2f(p[c]); s1 += v; s2 += v * v; } }
        s1 = wave_sum(s1); s2 = wave_sum(s2);
        if (lane == 0) { float* o = sig + (size_t)(row_off + r) * 2;
            if (!compare) { o[0] = s1; o[1] = s2; }
            else { const float a1 = o[0], a2 = o[1]; const bool bad = !(fabsf(a1 - s1) <= 1e-4f * sqrtf(a2 * (float)rowlen) + 1e-20f) || !(fabsf(a2 - s2) <= 1e-4f * a2 + 1e-20f); if (bad) atomicAdd(cnt, 1u); } } }
}
__global__ void __launch_bounds__(256) k_dbg_encode2(const unsigned* cnt, const float* xp, const float* xs, float* outp) {
    int first = -1; for (int k = 0; k < NPH_SIG; ++k) if (cnt[k] != 0u) { first = k; break; }
    if (first < 0) return;
    const float sc = 1.0f + 3.0f * (float)(first + 1);
    for (size_t i = (size_t)blockIdx.x * 256 + threadIdx.x; i < (size_t)MREAL * D; i += (size_t)gridDim.x * 256) outp[i] = sc * (i < (size_t)2 * SEQ * D ? xp[i] : xs[i - (size_t)2 * SEQ * D]);
}
#endif

extern "C" void kernel_launch(void* const* d_in, const int* in_sizes, int n_in, void* d_out, int out_size, void* d_ws, size_t ws_size, hipStream_t stream) {
    static int grid = 0;
    if (grid == 0) {
        if (n_in != 21 || out_size != MREAL * D || ws_size < WS_END) { fprintf(stderr, "kernel_launch: unexpected shapes: n_in %d out %d ws %zu (need >= %zu)\n", n_in, out_size, ws_size, (size_t)WS_END); grid = -1; return; }
        int dev = 0, cus = 0, per_cu = 0;
        if (hipGetDevice(&dev) != hipSuccess || hipDeviceGetAttribute(&cus, hipDeviceAttributeMultiprocessorCount, dev) != hipSuccess) { grid = -1; return; }
        if (hipFuncSetAttribute((const void*)fwd, hipFuncAttributeMaxDynamicSharedMemorySize, LDS_BYTES) != hipSuccess) { fprintf(stderr, "kernel_launch: hipFuncSetAttribute failed\n"); grid = -1; return; }
        if (hipOccupancyMaxActiveBlocksPerMultiprocessor(&per_cu, (const void*)fwd, 512, LDS_BYTES) != hipSuccess || per_cu < 1) fprintf(stderr, "kernel_launch: occupancy query says %d\n", per_cu);
        (void)hipGetLastError();
        grid = cus;
    }
    if (grid < 0) return;
    (void)in_sizes;
    hipMemsetAsync((char*)d_ws + WS_CTL, 0, CTL_ZERO_BYTES, stream);
    Args a{};
    for (int i = 0; i < 21; ++i) a.in[i] = (const float*)d_in[i];
    a.out = (float*)d_out; a.ws = (unsigned char*)d_ws;
#ifndef DBG_WHICH
#define DBG_WHICH 3
#endif
#if DEBUG_CHECK == 5
    {   unsigned char* ws = (unsigned char*)d_ws; unsigned* res = (unsigned*)(ws + DBG_ERR); float* Z = (float*)(ws + DBG_Z); int* srow = (int*)(ws + DBG_ERR + 4096);
        hipMemsetAsync(res, 0, 128, stream); hipLaunchKernelGGL(k_dbg_rows1, dim3(1), dim3(256), 0, stream, srow);
        a.ph_lo = 0; a.ph_hi = 1; hipLaunchKernelGGL(fwd, dim3(grid), dim3(512), LDS_BYTES, stream, a);
        hipLaunchKernelGGL(k_dbg_gemv, dim3((12864 + 255) / 256, (NS + 7) / 8), dim3(256), 0, stream, (const void*)(ws + WS_U), 1, (const int*)srow, D, 0, D, (const float*)d_in[IN_W_IN], 12864, Z, NS);
        a.ph_lo = 1; a.ph_hi = 2; hipLaunchKernelGGL(fwd, dim3(grid), dim3(512), LDS_BYTES, stream, a);
        hipLaunchKernelGGL(k_dbg_gateprobe, dim3(NS), dim3(256), 0, stream, (const float*)Z, (const unsigned char*)ws, (const bf16_t*)d_out, res);
        hipLaunchKernelGGL(k_dbg_gatedecode, dim3(1), dim3(1), 0, stream, res);
        hipLaunchKernelGGL(k_dbg_report2b, dim3(2048), dim3(256), 0, stream, (const unsigned*)res, (float*)d_out, DBG_WHICH);
    }
#elif DEBUG_CHECK == 4
    {   unsigned char* ws = (unsigned char*)d_ws; unsigned* res = (unsigned*)(ws + DBG_ERR);
        hipMemsetAsync(res, 0, 4, stream); hipMemsetAsync(res + 1, 0xFF, 4, stream);
        for (int p = 0; p < 2; ++p) { a.ph_lo = p; a.ph_hi = p + 1; hipLaunchKernelGGL(fwd, dim3(grid), dim3(512), LDS_BYTES, stream, a); }
        hipLaunchKernelGGL(k_dbg_scan1, dim3((MT * 51 * 64 + 255) / 256), dim3(256), 0, stream, (const unsigned char*)ws, (const bf16_t*)d_out, (const float*)d_in[IN_W_IN], res);
        hipLaunchKernelGGL(k_dbg_report2, dim3(2048), dim3(256), 0, stream, (const unsigned*)res, (float*)d_out);
    }
#elif DEBUG_CHECK == 3
    {
        unsigned char* ws = (unsigned char*)d_ws; unsigned* cnt = (unsigned*)(ws + DBG_ERR); float* SIG = (float*)(ws + DBG_SIG);
        hipMemsetAsync(cnt, 0, 4096, stream);
        for (int pass = 0; pass < 2; ++pass) {
            int off = 0;
            for (int i = 0; i < 21; ++i) { const int n = in_sizes[i]; const int rowlen = n >= 4096 ? 4096 : n; const int rows = n / rowlen;
                hipLaunchKernelGGL(k_dbg_sig, dim3(1024), dim3(256), 0, stream, (const void*)d_in[i], 1, rows, rowlen, SIG, off, pass, cnt + (pass ? i : 100)); off += rows; }
            if (pass == 0) for (int p = 0; p < NPHASE; ++p) { a.ph_lo = p; a.ph_hi = p + 1; hipLaunchKernelGGL(fwd, dim3(grid), dim3(512), LDS_BYTES, stream, a); }
        }
        hipLaunchKernelGGL(k_dbg_encode2, dim3(2048), dim3(256), 0, stream, (const unsigned*)cnt, (const float*)d_in[IN_XP], (const float*)d_in[IN_XS], (float*)d_out);
    }
#elif DEBUG_CHECK == 2
    {   unsigned char* ws = (unsigned char*)d_ws; unsigned* cnt = (unsigned*)(ws + DBG_ERR); float* SIG = (float*)(ws + DBG_SIG);
        hipMemsetAsync(cnt, 0, 4096, stream);
        auto phase = [&](int p) { a.ph_lo = p; a.ph_hi = p + 1; hipLaunchKernelGGL(fwd, dim3(grid), dim3(512), LDS_BYTES, stream, a); };
        auto sig = [&](int k, const void* base, int isf32, int nrows, int rowlen, int row_off, int cmp) { hipLaunchKernelGGL(k_dbg_sig, dim3(1024), dim3(256), 0, stream, base, isf32, nrows, rowlen, SIG + (size_t)k * SIG_ROWS * 2, row_off, cmp, cnt + k); };
        for (int run = 0; run < 2; ++run) {
            if (run) hipMemsetAsync((char*)d_ws + WS_CTL, 0, CTL_ZERO_BYTES, stream);
            phase(0); sig(0, ws + WS_U, 0, M, D, 0, run); sig(0, ws + WS_WIN, 0, (int)((WS_U - WS_WIN) / 8192), 4096, 30000, run); sig(0, ws + WS_TAB, 1, LSEQ, 64, 90000, run);
            phase(1); sig(1, ws + WS_ZCQ, 0, M, 1024, 0, run); sig(1, ws + WS_ZCKV, 0, M, 512, 25000, run); sig(1, ws + WS_QB, 0, M, 2048, 50000, run); sig(1, ws + WS_KB, 0, M, 512, 75000, run); sig(1, ws + WS_VB, 0, M, 512, 100000, run);
            sig(11, ws + WS_KR, 0, M, 64, 0, run); sig(11, d_out, 0, 2 * MREAL, D, 30000, run); sig(11, ws + WS_GAM, 0, 512, D, 80000, run); sig(11, ws + WS_SSP, 1, 1024, 4096, 81000, run);
            phase(2); sig(2, ws + WS_QA, 0, M, 3072, 0, run); sig(2, ws + WS_KVA, 0, M, 4096, 30000, run);
            phase(3); sig(3, ws + WS_U, 0, MREAL + 96, D, 0, run);
            phase(4); sig(4, ws + WS_MG, 0, MREAL + 96, D, 0, run);
            phase(5); sig(5, ws + WS_T, 0, MREAL + 96, D, 0, run);
            phase(6); sig(6, ws + WS_U, 0, M, D, 0, run); sig(6, d_out, 1, MREAL, D, 30000, run);
            phase(7); sig(7, ws + WS_F, 0, MREAL, DFF, 0, run); sig(7, ws + WS_HALOA, 1, MT * 8, DFF, 30000, run); sig(7, ws + WS_METAA, 1, 6, DFF, 40000, run);
            phase(8); sig(8, ws + WS_F, 0, MREAL, DFF, 0, run);
            phase(9); sig(9, ws + WS_U, 0, MREAL, D, 0, run);
            phase(10); sig(10, d_out, 1, MREAL, D, 0, run);
        }
        hipLaunchKernelGGL(k_dbg_encode2, dim3(2048), dim3(256), 0, stream, (const unsigned*)cnt, (const float*)d_in[IN_XP], (const float*)d_in[IN_XS], (float*)d_out);
    }
#elif DEBUG_CHECK
    {   unsigned char* ws = (unsigned char*)d_ws; unsigned* err = (unsigned*)(ws + DBG_ERR); float* Z = (float*)(ws + DBG_Z); float* A = (float*)(ws + DBG_A); float* B = (float*)(ws + DBG_B); float* C = (float*)(ws + DBG_C); float* H1S = (float*)(ws + DBG_H1);
        int* rl3 = (int*)(ws + DBG_ERR + 8192); int* srow = (int*)(ws + DBG_ERR + 4096);
        const float* const* in = (const float* const*)a.in;
        hipMemsetAsync(err, 0, 4096, stream); hipLaunchKernelGGL(k_dbg_rows1, dim3(1), dim3(256), 0, stream, srow);
        auto phase = [&](int p) { a.ph_lo = p; a.ph_hi = p + 1; hipLaunchKernelGGL(fwd, dim3(grid), dim3(512), LDS_BYTES, stream, a); };
        auto gemv = [&](const void* X, int xk, const int* rlist, int ld, int col0, int K, const float* W, int N, float* Y, int rows) { hipLaunchKernelGGL(k_dbg_gemv, dim3((N + 255) / 256, (rows + 7) / 8), dim3(256), 0, stream, X, xk, rlist, ld, col0, K, W, N, Y, rows); };
        phase(0); hipLaunchKernelGGL(k_dbg_chk0, dim3(NS), dim3(256), 0, stream, in[IN_XP], in[IN_XS], in[IN_META], in[IN_G_PRE_MIX], (const bf16_t*)(ws + WS_U), err);
        gemv(ws + WS_U, 1, srow, D, 0, D, in[IN_W_IN], 12864, Z, NS);
        phase(1); hipLaunchKernelGGL(k_dbg_chk1, dim3(NS), dim3(256), 0, stream, (const float*)Z, (const unsigned char*)ws, (const bf16_t*)d_out, in[IN_G_QN], in[IN_G_KN], err);
        hipLaunchKernelGGL(k_dbg_prep2, dim3(NS), dim3(256), 0, stream, (const float*)Z, in[IN_G_CQ], in[IN_G_CKV], C);
        hipLaunchKernelGGL(k_dbg_split2, dim3(NS), dim3(256), 0, stream, (const float*)C, A, A + (size_t)NS * 1024);
        gemv(A, 0, nullptr, 0, 0, 1024, in[IN_W_UQ], 3072, B, NS); gemv(A + (size_t)NS * 1024, 0, nullptr, 0, 0, 512, in[IN_W_UKV], 4096, B + (size_t)NS * 3072, NS);
        phase(2); hipLaunchKernelGGL(k_dbg_chk2, dim3(NS), dim3(256), 0, stream, (const float*)B, (const float*)(B + (size_t)NS * 3072), (const unsigned char*)ws, err);
        phase(3); hipLaunchKernelGGL(k_dbg_chk3, dim3(NS, 32), dim3(256), 0, stream, (const unsigned char*)ws, err);
        gemv(ws + WS_U, 1, srow, D, 0, 2048, in[IN_W_PA], D, A, NS); gemv(ws + WS_U, 1, srow, D, 2048, 2048, in[IN_W_PB], D, A + (size_t)NS * D, NS);
        phase(4); hipLaunchKernelGGL(k_dbg_chk4, dim3(NS), dim3(256), 0, stream, (const float*)A, (const float*)(A + (size_t)NS * D), (const float*)Z, (const unsigned char*)ws, err);
        gemv(ws + WS_MG, 1, srow, D, 0, D, in[IN_W_O], D, A, NS);
        phase(5); hipLaunchKernelGGL(k_dbg_chk5, dim3(NS), dim3(256), 0, stream, (const float*)A, in[IN_XP], in[IN_XS], in[IN_META], in[IN_G_POST_MIX], in[IN_G_PRE_FFN], (const unsigned char*)ws, (const float*)d_out, H1S, err, 0);
        phase(6); hipLaunchKernelGGL(k_dbg_chk5, dim3(NS), dim3(256), 0, stream, (const float*)A, in[IN_XP], in[IN_XS], in[IN_META], in[IN_G_POST_MIX], in[IN_G_PRE_FFN], (const unsigned char*)ws, (const float*)d_out, H1S, err, 1);
        hipLaunchKernelGGL(k_dbg_rows3, dim3(1), dim3(256), 0, stream, rl3);
        gemv(ws + WS_U, 1, rl3, D, 0, D, in[IN_W_UP], 22016, B, 3 * NS);
        phase(7); phase(8); hipLaunchKernelGGL(k_dbg_chk6, dim3(NS), dim3(256), 0, stream, (const float*)B, in[IN_W_CONV], in[IN_B_CONV], (const unsigned char*)ws, err);
        gemv(ws + WS_F, 1, srow, DFF, 0, DFF, in[IN_W_DOWN], D, A, NS);
        phase(9); phase(10); hipLaunchKernelGGL(k_dbg_chk7, dim3(NS), dim3(256), 0, stream, (const float*)A, (const float*)H1S, in[IN_G_POST_FFN], (const float*)d_out, err);
        hipLaunchKernelGGL(k_dbg_encode, dim3(2048), dim3(256), 0, stream, (const unsigned*)err, in[IN_XP], in[IN_XS], (float*)d_out);
    }
#elif MK_ONE_LAUNCH
    a.ph_lo = 0; a.ph_hi = NPHASE;
    hipLaunchKernelGGL(fwd, dim3(grid), dim3(512), LDS_BYTES, stream, a);
#else
    for (int p = 0; p < NPHASE; ++p) { a.ph_lo = p; a.ph_hi = p + 1; hipLaunchKernelGGL(fwd, dim3(grid), dim3(512), LDS_BYTES, stream, a); }
#endif
    const hipError_t le = hipPeekAtLastError();
    if (le != hipSuccess) fprintf(stderr, "kernel_launch: launch failed: %s\n", hipGetErrorName(le));
}
```

```cpp
#include <hip/hip_runtime.h>
#include <cstdio>
#include <cstdint>

#ifndef DUP_PHASE
#define DUP_PHASE -1
#endif
#ifndef MK_ONE_LAUNCH
#define MK_ONE_LAUNCH 1
#endif

#define LAS __attribute__((address_space(3)))
#define GAS __attribute__((address_space(1)))
typedef unsigned short bf16_t;
typedef short bf16x8 __attribute__((ext_vector_type(8)));
typedef short s16x4 __attribute__((ext_vector_type(4)));
typedef float f32x2 __attribute__((ext_vector_type(2)));
typedef float f32x4 __attribute__((ext_vector_type(4)));
typedef float f32x16 __attribute__((ext_vector_type(16)));
typedef unsigned u32x2 __attribute__((ext_vector_type(2)));
typedef unsigned u32x4 __attribute__((ext_vector_type(4)));
typedef int v8i_t __attribute__((ext_vector_type(8)));

constexpr int D = 4096, SEQ = 4096, NBATCH = 6, NMETA = 16, LSEQ = SEQ + NMETA;
constexpr int MREAL = NBATCH * SEQ;
constexpr int M = MREAL + 256;
constexpr int MT = M / 256;
constexpr int DINP = 4864;
constexpr int DGATE = 8192;
constexpr int DFF = 11008;
constexpr float EPS = 1e-6f;
constexpr int PN_CQ = 0, PN_CKV = 4, PN_GQ = 6, PN_GK = 14, PN_GV = 16, PN_KR = 18;
constexpr float U8_SCALE = 8.0f, W8_SCALE = 256.0f;

constexpr size_t MiB = 1u << 20;
constexpr size_t WS_CTL = 0, CTL_ZERO_BYTES = 2 * MiB;
constexpr size_t WS_SS = 1 * MiB;
constexpr size_t WS_TAB = 2 * MiB;
constexpr size_t WS_WIN = 4 * MiB, WS_WIN8 = 42 * MiB  , WS_WUQ = 106 * MiB, WS_WUKV = 112 * MiB, WS_WP = 116 * MiB, WS_WO = 148 * MiB, WS_WUP = 180 * MiB, WS_WDN = 352 * MiB;
constexpr size_t WS_U = 438 * MiB;
constexpr size_t WS_ZCQ = 632 * MiB, WS_ZCKV = 681 * MiB, WS_QB = 706 * MiB, WS_KB = 803 * MiB, WS_VB = 828 * MiB, WS_KR = 853 * MiB;
constexpr size_t WS_QA = 857 * MiB, WS_KVA = 1003 * MiB;
constexpr size_t WS_U8 = 857 * MiB;
constexpr size_t WS_MG = 857 * MiB;
constexpr size_t WS_T = 632 * MiB;
constexpr size_t WS_F = 632 * MiB;
constexpr size_t WS_HALOA = 1154 * MiB, WS_HALOG = 1187 * MiB, WS_METAA = 1204 * MiB, WS_GAM = 1205 * MiB, WS_GBM = 1207 * MiB, WS_H1M = 1209 * MiB, WS_SSP = 1211 * MiB  , WS_END = 1227 * MiB;
static_assert(WS_WIN + (size_t)DINP * D * 2 <= WS_WIN8 && WS_WIN8 + (size_t)DGATE * D <= WS_WUQ && WS_WUP + (size_t)2 * DFF * D * 2 <= WS_WDN && WS_WDN + (size_t)D * DFF * 2 <= WS_U, "weights map");
static_assert(WS_U + (size_t)M * D * 2 <= WS_ZCQ && WS_F + (size_t)M * DFF * 2 <= WS_HALOA && WS_HALOA + (size_t)MT * 8 * DFF * 4 <= WS_HALOG && WS_HALOG + (size_t)MT * 4 * DFF * 4 <= WS_METAA, "act map");
static_assert(WS_QA + (size_t)M * 3072 * 2 <= WS_KVA && WS_KVA + (size_t)M * 4096 * 2 <= 1197 * MiB && WS_KR + (size_t)M * 64 * 2 <= WS_QA, "act map 2");
constexpr int CW_BAR = 4096;
constexpr size_t SSP_CQ = 0  , SSP_CKV = (size_t)M * 16 * 4  , SSP_T = SSP_CKV + (size_t)M * 8 * 4  , SSP_D = SSP_T + (size_t)M * 64 * 4  ;
static_assert(SSP_D + (size_t)M * 64 * 4 <= 16 * MiB, "ssp map");

constexpr int RING_BYTES = 131072;
constexpr int EPI_OFF = RING_BYTES;
constexpr int MISC_OFF = EPI_OFF + 8192;
constexpr int LDS_BYTES = 147456;

typedef __bf16 bf16x2_t __attribute__((ext_vector_type(2)));
__device__ __forceinline__ unsigned cvt_pk_bf16(float lo, float hi) { const f32x2 v = {lo, hi}; const bf16x2_t b = __builtin_convertvector(v, bf16x2_t); return __builtin_bit_cast(unsigned, b); }
__device__ __forceinline__ float bf_lo(unsigned w) { return __uint_as_float(w << 16); }
__device__ __forceinline__ float bf_hi(unsigned w) { return __uint_as_float(w & 0xffff0000u); }
__device__ __forceinline__ float fast_rcp(float x) { return __builtin_amdgcn_rcpf(x); }
__device__ __forceinline__ float fast_rsq(float x) { return __builtin_amdgcn_rsqf(x); }
__device__ __forceinline__ float fast_exp2(float x) { return __builtin_amdgcn_exp2f(x); }
__device__ __forceinline__ float sigmoidf_(float v) { v = fminf(fmaxf(v, -30.f), 30.f); return fast_rcp(1.0f + fast_exp2(-1.4426950408889634f * v)); }
__device__ __forceinline__ float gelu_tanh(float x) { const float u = x * (1.0f + 0.044715f * x * x); float e = -2.0f * 0.7978845608028654f * 1.4426950408889634f * u; e = fminf(e, 80.f); return x * fast_rcp(1.0f + fast_exp2(e)); }
__device__ __forceinline__ u32x4 pack8(const f32x4 a, const f32x4 b) { u32x4 w; w.x = cvt_pk_bf16(a[0], a[1]); w.y = cvt_pk_bf16(a[2], a[3]); w.z = cvt_pk_bf16(b[0], b[1]); w.w = cvt_pk_bf16(b[2], b[3]); return w; }
__device__ __forceinline__ float wave_sum(float v) {
#pragma unroll
    for (int o = 1; o < 64; o <<= 1) v += __shfl_xor(v, o);
    return v;
}
__device__ __forceinline__ f32x4 rope4(const f32x4 v, const f32x4 cs) { f32x4 o; o[0] = v[0] * cs[0] - v[1] * cs[1]; o[1] = v[0] * cs[1] + v[1] * cs[0]; o[2] = v[2] * cs[2] - v[3] * cs[3]; o[3] = v[2] * cs[3] + v[3] * cs[2]; return o; }
__device__ __forceinline__ int pos1d_of(int pm, int rl) { return pm < MT - 1 ? 16 + ((pm & 15) << 8) + rl : (rl < 96 ? (rl & 15) : 0); }
__device__ __forceinline__ int tok_of(int pm, int rl) { return pm < MT - 1 ? ((pm & 15) << 8) + rl : 0; }

namespace pg8 {
constexpr int BM = 256, BK = 64, HALF = 128, HTB = HALF * BK * 2, STAGE_BYTES = 8 * HTB, NXCD = 8, WGM = 8;
__host__ __device__ __forceinline__ int lds_byte(int r, int c) { const int st = (r >> 4) * 2 + (c >> 5), rr = r & 15, cc = c & 31, ob = rr * 64 + cc * 2; return st * 1024 + (ob ^ (((ob >> 9) & 1) << 5)); }
__host__ __device__ __forceinline__ void stage_rc(int b, int& R, int& C) { const int st = b / 1024, sb = b % 1024, swz = sb ^ (((sb >> 9) & 1) << 5); R = (st >> 1) * 16 + swz / 64; C = (st & 1) * 32 + (swz % 64) / 2; }
__host__ __device__ __forceinline__ int perm32(int rho) { const int n = rho >> 4, i = rho & 15; return 8 * (i >> 2) + 4 * n + (i & 3); }
struct Unit { int pm, pn; };
struct Gemm { const void* A; const void* Bt; int M, N, K, ldb; };
struct StaticOrder {
    int nM, nN, nwg, G, c;
    __host__ __device__ void init(int M_, int N_, int G_, int c_) { nM = M_ / BM; nN = N_ / BM; nwg = nM * nN; G = G_; c = c_; }
    __host__ __device__ bool next(int i, Unit& u) const {
        const long L = (long)i * G + c; if (L >= nwg) return false;
        int wgid = (int)L; { const int q = nwg / NXCD, r = nwg % NXCD, xcd = wgid % NXCD, off = wgid / NXCD; wgid = (xcd < r ? xcd * (q + 1) : r * (q + 1) + (xcd - r) * q) + off; }
        const int nig = WGM * nN, gid = wgid / nig, fm = gid * WGM, gsz = (nM - fm) < WGM ? (nM - fm) : WGM;
        u.pm = fm + ((wgid % nig) % gsz); u.pn = (wgid % nig) / gsz; return true;
    }
};
template <class Epi, bool ALIGN_EPI = true, bool SP2 = true, bool FP8 = false>
__device__ __forceinline__ void gemm_phase(LAS unsigned char* lds, LAS unsigned char* scratch, const Gemm g, const StaticOrder& S, const Epi& E) {
    int tid_ = threadIdx.x; asm volatile("" : "+v"(tid_));
    const int tid = tid_, wid = __builtin_amdgcn_readfirstlane(tid >> 6), lane = tid & 63, wr = wid >> 2, wc = wid & 3, fr = lane & 15, fq = lane >> 4;
    const int K = g.ldb >> 1  , nt = FP8 ? g.K / 128 : g.K / BK;
    unsigned voffA[2], voffB[2];
#pragma unroll
    for (int i = 0; i < 2; ++i) { int R, C; stage_rc(tid * 16 + i * 8192, R, C); const int Rb = (R & ~31) + perm32(R & 31);
        const int Ra = Epi::ASWAP ? (128 * (R >> 6) + (R & 63)) : R;
        voffA[i] = (unsigned)(Ra * K + C) * 2u; voffB[i] = (unsigned)(Rb * K + C) * 2u; }
    const unsigned kstep = (unsigned)(BK * 2);
    const unsigned hstepB = (unsigned)HALF * (unsigned)g.ldb;
    const unsigned hstepA = Epi::ASWAP ? 64u * (unsigned)g.ldb : hstepB;
    const unsigned tstep = 256u * (unsigned)g.ldb;
    const __amdgpu_buffer_rsrc_t rsA = __builtin_amdgcn_make_buffer_rsrc((void*)g.A, (short)0, 0x7fffffff, 0x00020000);
    const __amdgpu_buffer_rsrc_t rsB = __builtin_amdgcn_make_buffer_rsrc((void*)g.Bt, (short)0, 0x7fffffff, 0x00020000);
    const unsigned ldsw = (unsigned)wid * 1024u;
    const int aoff = lds_byte(wr * 64 + fr, fq * 8), boff = lds_byte(wc * 32 + fr, fq * 8);
#define PG8_SA(b, h) (((b) * 2 + (h)) * HTB)
#define PG8_SB(b, h) ((4 + (b) * 2 + (h)) * HTB)
#define PG8_STAGE(bufoff, rs, soff, voff) do { _Pragma("unroll") for (int _i = 0; _i < 2; ++_i) \
        __builtin_amdgcn_raw_ptr_buffer_load_lds(rs, (LAS void*)(lds + (bufoff) + ldsw + _i * 8192), 16, (voff)[_i], (soff), 0, 0); } while (0)
#define PG8_LDA(dst, b, h) do { _Pragma("unroll") for (int m = 0; m < 4; ++m) _Pragma("unroll") for (int k = 0; k < 2; ++k) dst[m][k] = *(const LAS bf16x8*)(lds + PG8_SA(b, h) + aoff + m * 2048 + k * 1024); } while (0)
#define PG8_LDB(dst, b, h) do { _Pragma("unroll") for (int n = 0; n < 2; ++n) _Pragma("unroll") for (int k = 0; k < 2; ++k) dst[n][k] = *(const LAS bf16x8*)(lds + PG8_SB(b, h) + boff + n * 2048 + k * 1024); } while (0)
#define PG8_F8(lo, hi) (v8i_t){ (int)__builtin_bit_cast(u32x4, lo)[0], (int)__builtin_bit_cast(u32x4, lo)[1], (int)__builtin_bit_cast(u32x4, lo)[2], (int)__builtin_bit_cast(u32x4, lo)[3], (int)__builtin_bit_cast(u32x4, hi)[0], (int)__builtin_bit_cast(u32x4, hi)[1], (int)__builtin_bit_cast(u32x4, hi)[2], (int)__builtin_bit_cast(u32x4, hi)[3] }
#define PG8_MMA(ai, bj, At, Bt) do { __builtin_amdgcn_s_setprio(1); \
        if constexpr (FP8) { _Pragma("unroll") for (int m = 0; m < 4; ++m) _Pragma("unroll") for (int n = 0; n < 2; ++n) \
            { const v8i_t b8_ = PG8_F8(Bt[n][0], Bt[n][1]), a8_ = PG8_F8(At[m][0], At[m][1]); \
              asm volatile("v_mfma_scale_f32_16x16x128_f8f6f4 %0, %1, %2, %0, %3, %3 op_sel_hi:[0,0,0]" : "+v"(acc[ai][bj][m][n]) : "v"(b8_), "v"(a8_), "v"(one8)); } } \
        else { _Pragma("unroll") for (int m = 0; m < 4; ++m) _Pragma("unroll") for (int n = 0; n < 2; ++n) _Pragma("unroll") for (int k = 0; k < 2; ++k) \
            acc[ai][bj][m][n] = __builtin_amdgcn_mfma_f32_16x16x32_bf16(Bt[n][k], At[m][k], acc[ai][bj][m][n], 0, 0, 0); } \
        __builtin_amdgcn_s_setprio(0); } while (0)
#define PG8_WAIT_V(n) asm volatile("s_waitcnt vmcnt(" #n ")" ::: "memory")
#define PG8_WAIT_L(n) asm volatile("s_waitcnt lgkmcnt(" #n ")" ::: "memory")
#define PG8_BAR __builtin_amdgcn_s_barrier()
#define PG8_SCHED __builtin_amdgcn_sched_barrier(0)
    Unit cur, nxt; int ui = 0;
    if (!S.next(0, cur)) return;
    f32x4 acc[2][2][4][2];
#pragma unroll
    for (int a = 0; a < 2; ++a)
#pragma unroll
        for (int b = 0; b < 2; ++b)
#pragma unroll
            for (int m = 0; m < 4; ++m)
#pragma unroll
                for (int n = 0; n < 2; ++n) acc[a][b][m][n] = (f32x4){0.f, 0.f, 0.f, 0.f};
    bf16x8 At[4][2], B0[2][2], B1[2][2];
    const int one8 = 0x7f7f7f7f; (void)one8;
    unsigned cA = (unsigned)cur.pm * tstep, cB = (unsigned)cur.pn * tstep;
    if constexpr (SP2) {
        PG8_STAGE(PG8_SB(0, 0), rsB, cB, voffB); PG8_STAGE(PG8_SB(0, 1), rsB, cB + hstepB, voffB); PG8_STAGE(PG8_SA(0, 0), rsA, cA, voffA); PG8_STAGE(PG8_SA(0, 1), rsA, cA + hstepA, voffA);
        if (wr == 1) PG8_BAR;
        PG8_WAIT_V(2); PG8_BAR;
        PG8_STAGE(PG8_SB(1, 0), rsB, cB + kstep, voffB); PG8_STAGE(PG8_SA(1, 0), rsA, cA + kstep, voffA); PG8_STAGE(PG8_SB(1, 1), rsB, cB + hstepB + kstep, voffB);
        PG8_WAIT_V(6); PG8_BAR;
    } else {
        PG8_STAGE(PG8_SB(0, 0), rsB, cB, voffB); PG8_STAGE(PG8_SA(0, 0), rsA, cA, voffA); PG8_STAGE(PG8_SB(0, 1), rsB, cB + hstepB, voffB); PG8_STAGE(PG8_SA(0, 1), rsA, cA + hstepA, voffA);
        if (wr == 1) PG8_BAR;
        PG8_WAIT_V(4); PG8_BAR;
        PG8_STAGE(PG8_SB(1, 0), rsB, cB + kstep, voffB); PG8_STAGE(PG8_SA(1, 0), rsA, cA + kstep, voffA); PG8_STAGE(PG8_SB(1, 1), rsB, cB + hstepB + kstep, voffB);
        PG8_WAIT_V(6); PG8_BAR;
    }
    for (;;) {
        const bool has_next = S.next(ui + 1, nxt);
        const unsigned nA = has_next ? (unsigned)nxt.pm * tstep : cA, nB = has_next ? (unsigned)nxt.pn * tstep : cB;
        for (int t = 0; t < nt; t += 2) {
            const bool last = (t == nt - 2);
            const unsigned a1 = cA + (unsigned)(t + 1) * kstep;
            const unsigned a2 = last ? nA : cA + (unsigned)(t + 2) * kstep, b2 = last ? nB : cB + (unsigned)(t + 2) * kstep;
            const unsigned a3 = a2 + kstep, b3 = b2 + kstep;
            if constexpr (SP2) {
            PG8_LDB(B0, 0, 0); PG8_LDB(B1, 0, 1); PG8_SCHED; PG8_LDA(At, 0, 0); PG8_STAGE(PG8_SA(1, 1), rsA, a1 + hstepA, voffA);
            PG8_WAIT_V(8); PG8_WAIT_L(0); PG8_BAR; PG8_MMA(0, 0, At, B0); PG8_MMA(0, 1, At, B1); PG8_BAR; PG8_SCHED;
            PG8_LDA(At, 0, 1); PG8_STAGE(PG8_SB(0, 0), rsB, b2, voffB); PG8_STAGE(PG8_SB(0, 1), rsB, b2 + hstepB, voffB); PG8_STAGE(PG8_SA(0, 0), rsA, a2, voffA);
            PG8_WAIT_V(8); PG8_WAIT_L(0); PG8_BAR; PG8_MMA(1, 0, At, B0); PG8_MMA(1, 1, At, B1); PG8_BAR; PG8_SCHED;
            PG8_LDB(B0, 1, 0); PG8_LDB(B1, 1, 1); PG8_SCHED; PG8_LDA(At, 1, 0); PG8_STAGE(PG8_SA(0, 1), rsA, a2 + hstepA, voffA);
            PG8_WAIT_V(8); PG8_WAIT_L(0); PG8_BAR; PG8_MMA(0, 0, At, B0); PG8_MMA(0, 1, At, B1); PG8_BAR; PG8_SCHED;
            PG8_LDA(At, 1, 1); PG8_STAGE(PG8_SB(1, 0), rsB, b3, voffB); PG8_STAGE(PG8_SB(1, 1), rsB, b3 + hstepB, voffB); PG8_STAGE(PG8_SA(1, 0), rsA, a3, voffA);
            PG8_WAIT_V(8); PG8_WAIT_L(0); PG8_BAR; PG8_MMA(1, 0, At, B0); PG8_MMA(1, 1, At, B1); PG8_BAR; PG8_SCHED;
            } else {
            PG8_LDB(B0, 0, 0); PG8_SCHED; PG8_LDA(At, 0, 0); PG8_STAGE(PG8_SA(1, 1), rsA, a1 + hstepA, voffA);
            PG8_WAIT_L(8); PG8_BAR; PG8_WAIT_L(0); PG8_MMA(0, 0, At, B0); PG8_BAR; PG8_SCHED;
            PG8_LDB(B1, 0, 1); PG8_STAGE(PG8_SB(0, 0), rsB, b2, voffB);
            PG8_BAR; PG8_WAIT_L(0); PG8_MMA(0, 1, At, B1); PG8_BAR;
            PG8_LDA(At, 0, 1); PG8_STAGE(PG8_SA(0, 0), rsA, a2, voffA);
            PG8_BAR; PG8_WAIT_L(0); PG8_MMA(1, 0, At, B0); PG8_BAR; PG8_SCHED;
            PG8_STAGE(PG8_SB(0, 1), rsB, b2 + hstepB, voffB);
            PG8_WAIT_V(6); PG8_BAR; PG8_MMA(1, 1, At, B1); PG8_BAR;
            PG8_LDB(B0, 1, 0); PG8_SCHED; PG8_LDA(At, 1, 0); PG8_STAGE(PG8_SA(0, 1), rsA, a2 + hstepA, voffA);
            PG8_WAIT_L(8); PG8_BAR; PG8_WAIT_L(0); PG8_MMA(0, 0, At, B0); PG8_BAR; PG8_SCHED;
            PG8_LDB(B1, 1, 1); PG8_STAGE(PG8_SB(1, 0), rsB, b3, voffB);
            PG8_BAR; PG8_WAIT_L(0); PG8_MMA(0, 1, At, B1); PG8_BAR;
            PG8_LDA(At, 1, 1); PG8_STAGE(PG8_SA(1, 0), rsA, a3, voffA);
            PG8_BAR; PG8_WAIT_L(0); PG8_MMA(1, 0, At, B0); PG8_BAR; PG8_SCHED;
            PG8_STAGE(PG8_SB(1, 1), rsB, b3 + hstepB, voffB);
            PG8_WAIT_V(6); PG8_BAR; PG8_MMA(1, 1, At, B1); PG8_BAR;
            }
        }
        if constexpr (ALIGN_EPI) { if (wr == 0) PG8_BAR; }
        if constexpr (FP8) asm volatile("s_nop 15\n\ts_nop 15" ::: "memory");
        E(acc, cur, wr, wc, fr, fq, scratch);
        if (!has_next) break;
#pragma unroll
        for (int a = 0; a < 2; ++a)
#pragma unroll
            for (int b = 0; b < 2; ++b)
#pragma unroll
                for (int m = 0; m < 4; ++m)
#pragma unroll
                    for (int n = 0; n < 2; ++n) acc[a][b][m][n] = (f32x4){0.f, 0.f, 0.f, 0.f};
        cur = nxt; cA = nA; cB = nB; ++ui;
        if constexpr (ALIGN_EPI) { if (wr == 1) PG8_BAR; }
    }
    PG8_WAIT_V(0);
    if constexpr (!ALIGN_EPI) { if (wr == 0) PG8_BAR; }
    PG8_BAR;
#undef PG8_SA
#undef PG8_SB
#undef PG8_STAGE
#undef PG8_LDA
#undef PG8_LDB
#undef PG8_MMA
#undef PG8_F8
#undef PG8_WAIT_V
#undef PG8_WAIT_L
#undef PG8_BAR
#undef PG8_SCHED
}
}
using pg8::Unit;
typedef f32x4 AccT[2][2][4][2];

template <class T> __device__ __forceinline__ T ldu(const void* ubase, size_t uoff, unsigned voff) { return *(const T*)((const char*)ubase + uoff + voff); }
constexpr float QPRE_MLA = 0.07216878364870322f * 1.4426950408889634f, QPRE_GQA = 0.08838834764831845f * 1.4426950408889634f;
#ifndef DUP_ATT_GQA
#define DUP_ATT_GQA 1
#endif
#ifndef DUP_ATT_MLA
#define DUP_ATT_MLA 1
#endif
#ifndef GQA_DMA
#define GQA_DMA true
#endif
#ifndef MT_GQA
#define MT_GQA 1
#endif
#ifndef QK_PD
#define QK_PD 2
#endif
#ifndef GQA_SDEPTH
#define GQA_SDEPTH 2
#endif
#ifndef WT_STORES
#define WT_STORES 1
#endif
template <class T, bool WT = false> __device__ __forceinline__ void stu(void* ubase, size_t uoff, unsigned voff, const T v) {
  if constexpr (WT && WT_STORES) {
    static_assert(sizeof(T) == 16, "16-byte stores only");
    const __amdgpu_buffer_rsrc_t rs = __builtin_amdgcn_make_buffer_rsrc(ubase, (short)0, 0x7fffffff, 0x00020000);
    __builtin_amdgcn_raw_buffer_store_b128(__builtin_bit_cast(u32x4, v), rs, (int)voff, (int)(unsigned)uoff, 16);
  } else {
    *(T*)((char*)ubase + uoff + voff) = v;
  }
}
__device__ __forceinline__ float sumsq8(const f32x4 v0, const f32x4 v1) { return ((v0[0] * v0[0] + v0[1] * v0[1]) + (v0[2] * v0[2] + v0[3] * v0[3])) + ((v1[0] * v1[0] + v1[1] * v1[1]) + (v1[2] * v1[2] + v1[3] * v1[3])); }
struct EpiP1 {
    static constexpr bool ASWAP = false;
    unsigned char* ws; bf16_t* GA; const float *g_qn, *g_kn;
    __device__ __forceinline__ void operator()(const AccT& acc, const Unit& u, int wr, int wc, int fr, int fq, LAS unsigned char* scr) const {
        const int pn = u.pn, pm = u.pm, rl0 = wr * 64 + fr, cw = wc * 32 + 8 * fq;
        bf16_t* const ZCQ = (bf16_t*)(ws + WS_ZCQ); bf16_t* const ZCKV = (bf16_t*)(ws + WS_ZCKV); bf16_t* const QB = (bf16_t*)(ws + WS_QB); bf16_t* const KB = (bf16_t*)(ws + WS_KB); bf16_t* const VB = (bf16_t*)(ws + WS_VB);
        bf16_t* const KR = (bf16_t*)(ws + WS_KR); bf16_t* const GAM = (bf16_t*)(ws + WS_GAM); bf16_t* const GBM = (bf16_t*)(ws + WS_GBM); bf16_t* const GB = GA + (size_t)MREAL * D;
        const f32x4* const TAB = (const f32x4*)(ws + WS_TAB);
        if (pn < PN_GQ) {
            const bool isq = pn < PN_CKV; const int ld = isq ? 1024 : 512, colt = isq ? 256 * pn : 256 * (pn - PN_CKV);
            bf16_t* dst = (isq ? ZCQ : ZCKV) + (size_t)pm * 256 * ld + colt; const int nslot = isq ? 16 : 8, slot = (isq ? pn : pn - PN_CKV) * 4 + wc;
            float* ss = (float*)(ws + WS_SSP + (isq ? SSP_CQ : SSP_CKV)) + (size_t)pm * 256 * nslot + slot;
            const unsigned voff = (unsigned)((rl0 * ld + cw) * 2);
#pragma unroll
            for (int ai = 0; ai < 2; ++ai)
#pragma unroll
                for (int m = 0; m < 4; ++m) { float s = 0.f;
#pragma unroll
                    for (int bj = 0; bj < 2; ++bj) { s += sumsq8(acc[ai][bj][m][0], acc[ai][bj][m][1]);
                        stu<u32x4>(dst, (size_t)((ai * 128 + m * 16) * ld + bj * 128) * 2, voff, pack8(acc[ai][bj][m][0], acc[ai][bj][m][1])); }
                    s += __shfl_xor(s, 16); s += __shfl_xor(s, 32);
                    if (fq == 0) ss[(ai * 128 + m * 16 + rl0) * nslot] = s; }
        } else if (pn < PN_GV) {
            const bool isq = pn < PN_GK; const int ld = isq ? 2048 : 512, colt = isq ? 256 * (pn - PN_GQ) : 256 * (pn - PN_GK); const float* gn = isq ? g_qn : g_kn;
            bf16_t* dst = (isq ? QB : KB) + (size_t)pm * 256 * ld + colt; const unsigned voff = (unsigned)((rl0 * ld + cw) * 2);
            LAS float* P = (LAS float*)scr;
#pragma unroll
            for (int ai = 0; ai < 2; ++ai)
#pragma unroll
                for (int m = 0; m < 4; ++m)
#pragma unroll
                    for (int bj = 0; bj < 2; ++bj) { float s = sumsq8(acc[ai][bj][m][0], acc[ai][bj][m][1]);
                        s += __shfl_xor(s, 16); s += __shfl_xor(s, 32);
                        if (fq == 0) P[(ai * 128 + m * 16 + rl0) * 8 + bj * 4 + wc] = s; }
            asm volatile("s_waitcnt lgkmcnt(0)" ::: "memory"); __builtin_amdgcn_s_barrier(); asm volatile("" ::: "memory");
            const int half = wc >> 1, i0 = 16 * (wc & 1) + 4 * fq;
            const f32x4 g1 = *(const f32x4*)(gn + half * 64 + i0), g2 = *(const f32x4*)(gn + half * 64 + 32 + i0);
            const int tbase = pm < MT - 1 ? ((pm & 15) << 8) : 0; const bool real = pm < MT - 1;
            const unsigned tvo = (unsigned)(((real && half ? fr * 16 : 0) + (i0 >> 1)) * 16);
#pragma unroll
            for (int ai = 0; ai < 2; ++ai)
#pragma unroll
                for (int m = 0; m < 4; ++m) { const int rl = ai * 128 + m * 16 + rl0; const size_t tuo = real ? (size_t)(half ? 16 * m : (tbase >> 6) + 2 * ai + wr) * 256 : 0;
                    const f32x4 cs0 = ldu<f32x4>(TAB, tuo, tvo), cs1 = ldu<f32x4>(TAB, tuo + 16, tvo);
#pragma unroll
                    for (int bj = 0; bj < 2; ++bj) { const f32x4 p4 = *(const LAS f32x4*)(P + rl * 8 + bj * 4);
                        const float rs = fast_rsq(((p4[0] + p4[1]) + (p4[2] + p4[3])) * (1.0f / 128.0f) + EPS) * (isq ? QPRE_GQA : 1.0f);
                        f32x4 v0 = acc[ai][bj][m][0] * rs, v1 = acc[ai][bj][m][1] * rs;
                        v0[0] *= g1[0]; v0[1] *= g2[0]; v0[2] *= g1[1]; v0[3] *= g2[1]; v1[0] *= g1[2]; v1[1] *= g2[2]; v1[2] *= g1[3]; v1[3] *= g2[3];
                        stu<u32x4>(dst, (size_t)((ai * 128 + m * 16) * ld + bj * 128) * 2, voff, pack8(rope4(v0, cs0), rope4(v1, cs1))); }
                    asm volatile("" ::: "memory"); }
        } else if (pn < PN_KR) {
            bf16_t* dst = VB + (size_t)pm * 256 * 512 + 256 * (pn - PN_GV); const unsigned voff = (unsigned)((rl0 * 512 + cw) * 2);
#pragma unroll
            for (int ai = 0; ai < 2; ++ai)
#pragma unroll
                for (int m = 0; m < 4; ++m)
#pragma unroll
                    for (int bj = 0; bj < 2; ++bj) stu<u32x4>(dst, (size_t)((ai * 128 + m * 16) * 512 + bj * 128) * 2, voff, pack8(acc[ai][bj][m][0], acc[ai][bj][m][1]));
        } else {
            if (wc < 2) { const int i0 = 16 * wc + 4 * fq; bf16_t* dst = KR + (size_t)pm * 256 * 64; const unsigned voff = (unsigned)((rl0 * 64 + cw) * 2);
#pragma unroll
                for (int ai = 0; ai < 2; ++ai)
#pragma unroll
                    for (int m = 0; m < 4; ++m) {
                        const bool real = pm < MT - 1; const size_t tuo = real ? (size_t)(16 + ((pm & 15) << 8) + ai * 128 + m * 16) * 256 : 0; const unsigned tvo = (unsigned)(((real ? rl0 : fr) * 16 + (i0 >> 1)) * 16);
                        const f32x4 cs0 = ldu<f32x4>(TAB, tuo, tvo), cs1 = ldu<f32x4>(TAB, tuo + 16, tvo);
                        stu<u32x4>(dst, (size_t)((ai * 128 + m * 16) * 64) * 2, voff, pack8(rope4(acc[ai][0][m][0], cs0), rope4(acc[ai][0][m][1], cs1))); } }
        }
    }
};
struct EpiGate {
    static constexpr bool ASWAP = false;
    unsigned char* ws; bf16_t* GA;
    __device__ __forceinline__ void operator()(const AccT& acc, const Unit& u, int wr, int wc, int fr, int fq, LAS unsigned char*) const {
        const int pn = u.pn, pm = u.pm, rl0 = wr * 64 + fr, cw = wc * 32 + 8 * fq; const bool isa = pn < 16; const int colt = 256 * (pn & 15);
        bf16_t* dst = (pm < MT - 1 ? (isa ? GA : GA + (size_t)MREAL * D) + (size_t)pm * 256 * D : (bf16_t*)(ws + (isa ? WS_GAM : WS_GBM))) + colt; const unsigned voff = (unsigned)((rl0 * D + cw) * 2);
        constexpr float inv = 1.0f / (U8_SCALE * W8_SCALE);
#pragma unroll
        for (int ai = 0; ai < 2; ++ai)
#pragma unroll
            for (int m = 0; m < 4; ++m)
#pragma unroll
                for (int bj = 0; bj < 2; ++bj) { f32x4 v0 = acc[ai][bj][m][0], v1 = acc[ai][bj][m][1];
#pragma unroll
                    for (int j = 0; j < 4; ++j) { v0[j] = fast_rcp(1.0f + fast_exp2(v0[j] * (-1.4426950408889634f * inv))); v1[j] = fast_rcp(1.0f + fast_exp2(v1[j] * (-1.4426950408889634f * inv))); }
                    stu<u32x4>(dst, (size_t)((ai * 128 + m * 16) * D + bj * 128) * 2, voff, pack8(v0, v1)); }
    }
};
struct EpiQA {
    static constexpr bool ASWAP = false;
    bf16_t* QA; const float* SS_CQ; const f32x4* TAB;
    __device__ __forceinline__ void operator()(const AccT& acc, const Unit& u, int wr, int wc, int fr, int fq, LAS unsigned char*) const {
        const int pn = u.pn, pm = u.pm, rl0 = wr * 64 + fr, cw = wc * 32 + 8 * fq, i0 = 16 * (wc & 1) + 4 * fq;
        bf16_t* dst = QA + (size_t)pm * 256 * 3072 + pn * 256; const unsigned voff = (unsigned)((rl0 * 3072 + cw) * 2); const float* ss = SS_CQ + (size_t)pm * 256 * 16;
#pragma unroll
        for (int ai = 0; ai < 2; ++ai)
#pragma unroll
            for (int m = 0; m < 4; ++m) { const int rl = ai * 128 + m * 16 + rl0; const bool real = pm < MT - 1;
                const size_t tuo = real ? (size_t)(16 + ((pm & 15) << 8) + ai * 128 + m * 16) * 256 : 0; const unsigned tvo = (unsigned)(((real ? rl0 : fr) * 16 + (i0 >> 1)) * 16);
                float q; { const f32x4 p4 = *(const f32x4*)(ss + rl * 16 + fq * 4); q = (p4[0] + p4[1]) + (p4[2] + p4[3]); q += __shfl_xor(q, 16); q += __shfl_xor(q, 32); }
                const float rs = fast_rsq(q * (1.0f / 1024.0f) + EPS) * QPRE_MLA;
                const f32x4 cs0 = ldu<f32x4>(TAB, tuo, tvo), cs1 = ldu<f32x4>(TAB, tuo + 16, tvo);
#pragma unroll
                for (int bj = 0; bj < 2; ++bj) { const int gblk = 4 * pn + 2 * bj + (wc >> 1); f32x4 v0 = acc[ai][bj][m][0] * rs, v1 = acc[ai][bj][m][1] * rs;
                    if (gblk % 3 == 2) { v0 = rope4(v0, cs0); v1 = rope4(v1, cs1); }
                    stu<u32x4>(dst, (size_t)((ai * 128 + m * 16) * 3072 + bj * 128) * 2, voff, pack8(v0, v1)); }
                asm volatile("" ::: "memory"); }
    }
};
struct EpiKV {
    static constexpr bool ASWAP = false;
    bf16_t* KVA; const float* SS_CKV;
    __device__ __forceinline__ void operator()(const AccT& acc, const Unit& u, int wr, int wc, int fr, int fq, LAS unsigned char*) const {
        const int rl0 = wr * 64 + fr, cw = wc * 32 + 8 * fq;
        bf16_t* dst = KVA + (size_t)u.pm * 256 * 4096 + u.pn * 256; const unsigned voff = (unsigned)((rl0 * 4096 + cw) * 2); const float* ss = SS_CKV + (size_t)u.pm * 256 * 8;
#pragma unroll
        for (int ai = 0; ai < 2; ++ai)
#pragma unroll
            for (int m = 0; m < 4; ++m) { float q; { const f32x2 p2 = *(const f32x2*)(ss + (ai * 128 + m * 16 + rl0) * 8 + fq * 2); q = p2[0] + p2[1]; q += __shfl_xor(q, 16); q += __shfl_xor(q, 32); }
                const float rs = fast_rsq(q * (1.0f / 512.0f) + EPS);
#pragma unroll
                for (int bj = 0; bj < 2; ++bj) stu<u32x4>(dst, (size_t)((ai * 128 + m * 16) * 4096 + bj * 128) * 2, voff, pack8(acc[ai][bj][m][0] * rs, acc[ai][bj][m][1] * rs)); }
    }
};
template <int STEP> struct EpiMerge {
    static constexpr bool ASWAP = false;
    bf16_t* MG; bf16_t *GA, *GB, *GAM, *GBM;
    __device__ __forceinline__ void operator()(const AccT& acc, const Unit& u, int wr, int wc, int fr, int fq, LAS unsigned char*) const {
        const unsigned voff = (unsigned)(((wr * 64 + fr) * D + wc * 32 + 8 * fq) * 2); const bool real = u.pm < MT - 1;
        char* ga = (char*)(real ? GA + (size_t)u.pm * 256 * D : GAM) + u.pn * 512; const char* gb = (const char*)(real ? GB + (size_t)u.pm * 256 * D : GBM) + u.pn * 512;
        char* mg = (char*)(MG + (size_t)u.pm * 256 * D) + u.pn * 512;
#pragma unroll
        for (int ai = 0; ai < 2; ++ai)
#pragma unroll
            for (int m = 0; m < 4; ++m) { const size_t uo = (size_t)(ai * 128 + m * 16) * D * 2;
#pragma unroll
                for (int bj = 0; bj < 2; ++bj) {
                    const u32x4 a = *(const u32x4*)(ga + uo + bj * 256 + voff);
                    const f32x4 a0 = {bf_lo(a.x), bf_hi(a.x), bf_lo(a.y), bf_hi(a.y)}, a1 = {bf_lo(a.z), bf_hi(a.z), bf_lo(a.w), bf_hi(a.w)};
                    if constexpr (STEP == 0) { *(u32x4*)(ga + uo + bj * 256 + voff) = pack8(acc[ai][bj][m][0] * a0, acc[ai][bj][m][1] * a1); }
                    else { const u32x4 b = *(const u32x4*)(gb + uo + bj * 256 + voff);
                        const f32x4 s0 = {bf_lo(b.x), bf_hi(b.x), bf_lo(b.y), bf_hi(b.y)}, s1 = {bf_lo(b.z), bf_hi(b.z), bf_lo(b.w), bf_hi(b.w)};
                        stu<u32x4>(mg, uo + bj * 256, voff, pack8(a0 + acc[ai][bj][m][0] * s0, a1 + acc[ai][bj][m][1] * s1)); } }
                asm volatile("" ::: "memory"); }
    }
};
struct EpiRowSS {
    static constexpr bool ASWAP = false;
    bf16_t* O; float* SS;
    __device__ __forceinline__ void operator()(const AccT& acc, const Unit& u, int wr, int wc, int fr, int fq, LAS unsigned char*) const {
        const int rl0 = wr * 64 + fr, cw = wc * 32 + 8 * fq;
        bf16_t* dst = O + (size_t)u.pm * 256 * D + u.pn * 256; const unsigned voff = (unsigned)((rl0 * D + cw) * 2); float* ss = SS + (size_t)u.pm * 256 * 64 + u.pn * 4 + wc;
#pragma unroll
        for (int ai = 0; ai < 2; ++ai)
#pragma unroll
            for (int m = 0; m < 4; ++m) { float s = 0.f;
#pragma unroll
                for (int bj = 0; bj < 2; ++bj) { s += sumsq8(acc[ai][bj][m][0], acc[ai][bj][m][1]);
                    stu<u32x4>(dst, (size_t)((ai * 128 + m * 16) * D + bj * 128) * 2, voff, pack8(acc[ai][bj][m][0], acc[ai][bj][m][1])); }
                s += __shfl_xor(s, 16); s += __shfl_xor(s, 32);
                if (fq == 0) ss[(ai * 128 + m * 16 + rl0) * 64] = s; }
    }
};
template <int CTRL> __device__ __forceinline__ float dpp_f(float v) { return __int_as_float(__builtin_amdgcn_update_dpp(0, __float_as_int(v), CTRL, 0xf, 0xf, true)); }
struct EpiUp {
    static constexpr bool ASWAP = true;
    bf16_t* F; float *HALOA, *HALOG, *METAA; const float *wconv, *bconv;
    __device__ __forceinline__ void operator()(const AccT& acc, const Unit& u, int wr, int wc, int fr, int fq, LAS unsigned char*) const {
        const int pm = u.pm, pn = u.pn, cw = wc * 32 + 8 * fq, col = pn * 128 + cw;
        f32x4 w0[2], w1[2], w2[2], bb[2];
#pragma unroll
        for (int n = 0; n < 2; ++n) { w0[n] = *(const f32x4*)(wconv + col + 4 * n); w1[n] = *(const f32x4*)(wconv + DFF + col + 4 * n); w2[n] = *(const f32x4*)(wconv + 2 * DFF + col + 4 * n); bb[n] = *(const f32x4*)(bconv + col + 4 * n); }
#pragma unroll
        for (int ai = 0; ai < 2; ++ai)
#pragma unroll
            for (int m = 0; m < 4; ++m) {
                const int g = ai * 4 + m;
                const int wl = g * 16 + fr, row = pm * 256 + wr * 128 + wl;
                f32x4 fo[2];
#pragma unroll
                for (int n = 0; n < 2; ++n) {
                    const f32x4 a = acc[ai][0][m][n];
                    f32x4 pv, nx;
#pragma unroll
                    for (int j = 0; j < 4; ++j) {
                        const float pin = dpp_f<0x111>(a[j]);
                        const float nin = dpp_f<0x101>(a[j]);
                        float pout = 0.f, nout = 0.f;
                        if (g > 0) pout = dpp_f<0x10F>(acc[(g - 1) >> 2][0][(g - 1) & 3][n][j]);
                        if (g < 7) nout = dpp_f<0x11F>(acc[(g + 1) >> 2][0][(g + 1) & 3][n][j]);
                        pv[j] = fr == 0 ? pout : pin; nx[j] = fr == 15 ? nout : nin;
                    }
                    const f32x4 c = pv * w0[n] + a * w1[n] + nx * w2[n] + bb[n];
                    const f32x4 gv = acc[ai][1][m][n];
#pragma unroll
                    for (int j = 0; j < 4; ++j) fo[n][j] = gelu_tanh(c[j]) * gv[j];
                }
                stu<u32x4, true>(F + (size_t)(pm * 256 + wr * 128) * DFF + pn * 128, (size_t)(g * 16) * DFF * 2, (unsigned)((fr * DFF + cw) * 2), pack8(fo[0], fo[1]));
                if (g == 0 && fr < 2) { float* h = HALOA + ((size_t)(pm * 8 + wr * 4 + fr)) * DFF + col; *(f32x4*)h = acc[ai][0][m][0]; *(f32x4*)(h + 4) = acc[ai][0][m][1];
                    if (fr == 0) { float* hg = HALOG + ((size_t)(pm * 4 + wr * 2)) * DFF + col; *(f32x4*)hg = acc[ai][1][m][0]; *(f32x4*)(hg + 4) = acc[ai][1][m][1]; } }
                if (g == 7 && fr >= 14) { float* h = HALOA + ((size_t)(pm * 8 + wr * 4 + 2 + (fr - 14))) * DFF + col; *(f32x4*)h = acc[ai][0][m][0]; *(f32x4*)(h + 4) = acc[ai][0][m][1];
                    if (fr == 15) { float* hg = HALOG + ((size_t)(pm * 4 + wr * 2 + 1)) * DFF + col; *(f32x4*)hg = acc[ai][1][m][0]; *(f32x4*)(hg + 4) = acc[ai][1][m][1]; } }
            }
    }
};

namespace att {
constexpr int KVBLK = 64, NT = 65;
constexpr int SHM_V = 64 * 128 * 2, SHM_K = 64 * 128 * 2, SHM_R = 64 * 64 * 2;
constexpr int OFF_V = 0, OFF_K = 3 * SHM_V, OFF_R = OFF_K + 2 * SHM_K, OFF_W = OFF_R + 2 * SHM_R, OSTRIDE = 272;
static_assert(OFF_W + 8 * 256 <= RING_BYTES && 8 * 32 * OSTRIDE <= OFF_W, "attention LDS map");
#define KSWZ(row, colB) ((row) * 256 + ((colB) ^ (((row) & 7) << 4)))
#define RSWZ(row, colB) ((row) * 128 + ((colB) ^ (((row) & 7) << 4)))
#define SBAR() __builtin_amdgcn_sched_barrier(0)
__device__ __forceinline__ int crow(int r, int hi) { return (r & 3) + 8 * (r >> 2) + 4 * hi; }
template <int SCALE_X1000000> struct Cst { };
__device__ __forceinline__ void partialSM(f32x16& p0, f32x16& p1, float& m_reg, float& mn, float& alpha, const float C, const float THRS) {
    float pmax = p0[0];
#pragma unroll
    for (int r = 1; r < 16; ++r) pmax = fmaxf(pmax, p0[r]);
#pragma unroll
    for (int r = 0; r < 16; ++r) pmax = fmaxf(pmax, p1[r]);
    { auto rr = __builtin_amdgcn_permlane32_swap(__float_as_uint(pmax), __float_as_uint(pmax), false, false); pmax = fmaxf(__uint_as_float(rr[0]), __uint_as_float(rr[1])); }
    if (__builtin_expect(__all(pmax - m_reg <= THRS), 1)) { mn = m_reg; alpha = 1.f; }
    else { mn = fmaxf(m_reg, pmax); alpha = fast_exp2((m_reg - mn) * C); m_reg = mn; }
    const float mnC = -mn * C;
#pragma unroll
    for (int r = 0; r < 16; ++r) p0[r] = fmaf(p0[r], C, mnC);
#pragma unroll
    for (int r = 0; r < 16; ++r) p1[r] = fmaf(p1[r], C, mnC);
#pragma unroll
    for (int r = 0; r < 16; ++r) p0[r] = fast_exp2(p0[r]);
}
__device__ __forceinline__ void partialSMp(f32x16& p0, f32x16& p1, float& mneg, float& alpha, float& l_reg, const float THR2, const bool first) {
    float pmax = p0[0];
#pragma unroll
    for (int r = 1; r < 16; ++r) pmax = fmaxf(pmax, p0[r]);
#pragma unroll
    for (int r = 0; r < 16; ++r) pmax = fmaxf(pmax, p1[r]);
    { auto rr = __builtin_amdgcn_permlane32_swap(__float_as_uint(pmax), __float_as_uint(pmax), false, false); pmax = fmaxf(__uint_as_float(rr[0]), __uint_as_float(rr[1])); }
    if (__builtin_expect(!first && __all(pmax <= THR2), 1)) { alpha = 1.f; }
    else { const float d = first ? pmax : fmaxf(pmax, 0.f); alpha = first ? 1.f : fast_exp2(-d); mneg -= d; l_reg *= alpha;
#pragma unroll
        for (int r = 0; r < 16; ++r) { p0[r] -= d; p1[r] -= d; } }
#pragma unroll
    for (int r = 0; r < 16; ++r) p0[r] = fast_exp2(p0[r]);
}
__device__ __forceinline__ void finishSM(f32x16& p0, f32x16& p1, float& l_reg, bf16x8& pa0, bf16x8& pa1, bf16x8& pa2, bf16x8& pa3) {
#pragma unroll
    for (int r = 0; r < 16; ++r) p1[r] = fast_exp2(p1[r]);
    float ps = 0;
#pragma unroll
    for (int r = 0; r < 16; ++r) ps += p0[r];
#pragma unroll
    for (int r = 0; r < 16; ++r) ps += p1[r];
    l_reg += ps;
#define PK4(P, BASE, OUT) do { unsigned a0 = cvt_pk_bf16(P[BASE + 0], P[BASE + 1]), a1 = cvt_pk_bf16(P[BASE + 2], P[BASE + 3]);   \
    unsigned b0 = cvt_pk_bf16(P[BASE + 4], P[BASE + 5]), b1 = cvt_pk_bf16(P[BASE + 6], P[BASE + 7]);                              \
    u32x4 w = {a0, a1, b0, b1}; OUT = *reinterpret_cast<bf16x8*>(&w); } while (0)
    PK4(p0, 0, pa0); PK4(p0, 8, pa1); PK4(p1, 0, pa2); PK4(p1, 8, pa3);
#undef PK4
}
template <int NQF> __device__ __forceinline__ void qkt(f32x16& p0, f32x16& p1, const LAS char* Ks, const LAS char* Rs, const bf16x8* qr, int r32, int hi, float nm, const f32x16* mtp = nullptr) {
    f32x16 c0;
    if (mtp) c0 = *mtp;
    else { asm volatile("" : "+v"(nm));
#pragma unroll
        for (int r = 0; r < 16; ++r) c0[r] = nm; }
    p0 = c0; p1 = c0;
    auto LD0 = [&](int d) -> bf16x8 { const int cb = ((d & 7) * 16 + hi * 8) * 2; return d < 8 ? *(const LAS bf16x8*)(Ks + KSWZ(r32, cb)) : *(const LAS bf16x8*)(Rs + RSWZ(r32, cb)); };
    auto LD1 = [&](int d) -> bf16x8 { const int cb = ((d & 7) * 16 + hi * 8) * 2; return d < 8 ? *(const LAS bf16x8*)(Ks + KSWZ(32 + r32, cb)) : *(const LAS bf16x8*)(Rs + RSWZ(32 + r32, cb)); };
    constexpr int PD = QK_PD, NR = PD + 1;
    bf16x8 fa[NR], fb[NR];
#pragma unroll
    for (int d = 0; d < PD; ++d) { fa[d] = LD0(d); fb[d] = LD1(d); }
#pragma unroll
    for (int d = 0; d < NQF; ++d) {
        if (d + PD < NQF) { fa[(d + PD) % NR] = LD0(d + PD); fb[(d + PD) % NR] = LD1(d + PD); }
        __builtin_amdgcn_sched_barrier(0x406);
        p0 = __builtin_amdgcn_mfma_f32_32x32x16_bf16(fa[d % NR], qr[d], p0, 0, 0, 0);
        p1 = __builtin_amdgcn_mfma_f32_32x32x16_bf16(fb[d % NR], qr[d], p1, 0, 0, 0);
        __builtin_amdgcn_sched_barrier(0x406);
    }
}
__device__ __forceinline__ int v_st(int k, int c) { const int kk = k; return ((kk >> 3) * 4 + (c >> 5)) * 512 + ((kk & 7) * 32 + (c & 31)) * 2; }
__device__ __forceinline__ int v_rd_base(int lane) { return ((lane & 3) << 3) | (((lane >> 2) & 3) << 6) | (((lane >> 4) & 1) << 5) | (((lane >> 5) & 1) << 8); }
constexpr int v_rd_off(int d0, int ks, int half) { return d0 * 512 + ks * 4096 + half * 2048; }
template <int OFF> __device__ __forceinline__ s16x4 tr_read(int vb) { s16x4 r; asm volatile("ds_read_b64_tr_b16 %0, %1 offset:%2" : "=&v"(r) : "v"(vb), "i"(OFF) : "memory"); return r; }
template <int D0> __device__ __forceinline__ void pv_one(f32x16& od, int vb, bf16x8 pa0, bf16x8 pa1, bf16x8 pa2, bf16x8 pa3) {
    const s16x4 l0 = tr_read<v_rd_off(D0, 0, 0)>(vb), h0 = tr_read<v_rd_off(D0, 0, 1)>(vb), l1 = tr_read<v_rd_off(D0, 1, 0)>(vb), h1 = tr_read<v_rd_off(D0, 1, 1)>(vb);
    const s16x4 l2 = tr_read<v_rd_off(D0, 2, 0)>(vb), h2 = tr_read<v_rd_off(D0, 2, 1)>(vb), l3 = tr_read<v_rd_off(D0, 3, 0)>(vb), h3 = tr_read<v_rd_off(D0, 3, 1)>(vb);
    asm volatile("s_waitcnt lgkmcnt(0)" ::: "memory"); SBAR();
#define PK(L, H) (bf16x8){L[0], L[1], L[2], L[3], H[0], H[1], H[2], H[3]}
    od = __builtin_amdgcn_mfma_f32_32x32x16_bf16(pa0, PK(l0, h0), od, 0, 0, 0);
    od = __builtin_amdgcn_mfma_f32_32x32x16_bf16(pa1, PK(l1, h1), od, 0, 0, 0);
    od = __builtin_amdgcn_mfma_f32_32x32x16_bf16(pa2, PK(l2, h2), od, 0, 0, 0);
    od = __builtin_amdgcn_mfma_f32_32x32x16_bf16(pa3, PK(l3, h3), od, 0, 0, 0);
#undef PK
}
__device__ __forceinline__ void pv_psm(f32x16* o, int vb, bf16x8 pa0, bf16x8 pa1, bf16x8 pa2, bf16x8 pa3, f32x16& p0, f32x16& p1, float& mneg, float& alpha, float& l_reg, const float THR2) {
    pv_one<0>(o[0], vb, pa0, pa1, pa2, pa3);
    float pmax = p0[0];
#pragma unroll
    for (int r = 1; r < 16; ++r) pmax = fmaxf(pmax, p0[r]);
    pv_one<1>(o[1], vb, pa0, pa1, pa2, pa3);
#pragma unroll
    for (int r = 0; r < 16; ++r) pmax = fmaxf(pmax, p1[r]);
    { auto rr = __builtin_amdgcn_permlane32_swap(__float_as_uint(pmax), __float_as_uint(pmax), false, false); pmax = fmaxf(__uint_as_float(rr[0]), __uint_as_float(rr[1])); }
    if (__builtin_expect(__all(pmax <= THR2), 1)) { alpha = 1.f; }
    else { const float d = fmaxf(pmax, 0.f); alpha = fast_exp2(-d); mneg -= d; l_reg *= alpha;
#pragma unroll
        for (int r = 0; r < 16; ++r) { p0[r] -= d; p1[r] -= d; } }
    pv_one<2>(o[2], vb, pa0, pa1, pa2, pa3);
#pragma unroll
    for (int r = 0; r < 8; ++r) p0[r] = fast_exp2(p0[r]);
    asm volatile("" : "+v"(p0));
    pv_one<3>(o[3], vb, pa0, pa1, pa2, pa3);
#pragma unroll
    for (int r = 8; r < 16; ++r) p0[r] = fast_exp2(p0[r]);
    asm volatile("" : "+v"(p0));
}
__device__ __forceinline__ void pv_d0(f32x16* o, int vb, bf16x8 pa0, bf16x8 pa1, bf16x8 pa2, bf16x8 pa3) {
    pv_one<0>(o[0], vb, pa0, pa1, pa2, pa3); pv_one<1>(o[1], vb, pa0, pa1, pa2, pa3); pv_one<2>(o[2], vb, pa0, pa1, pa2, pa3); pv_one<3>(o[3], vb, pa0, pa1, pa2, pa3);
}
template <int NQF, int LDQ, int LDK, int LDV, int SDEPTH, int ABL = 0, bool DMA = false>
__device__ __forceinline__ void attn_unit(const bf16_t* __restrict__ Qw, const bf16_t* __restrict__ Kh, const bf16_t* __restrict__ Vh, const bf16_t* __restrict__ Rh,
                                          int kbase, int mrow, bf16_t* __restrict__ Ob, int orow0, int nrows_valid, LAS char* lds, const float SCALE) {
    int tid_ = threadIdx.x; asm volatile("" : "+v"(tid_));
    const int tid = tid_, wid = __builtin_amdgcn_readfirstlane(tid >> 6), lane = tid & 63, r32 = lane & 31, hi = lane >> 5;
    constexpr float THR2 = 8.0f * 1.4426950408889634f; (void)SCALE;
    LAS char* V_lds = lds + OFF_V; LAS char* K_lds = lds + OFF_K; LAS char* R_lds = lds + OFF_R;
    LAS float* ws = (LAS float*)(lds + OFF_W) + wid * 64; LAS float* li_l = ws; LAS float* al_l = ws + 32;
    float l_reg = 0; f32x16 o[4] = {}; bf16x8 qr[NQF]; float mneg = 0.f; f32x16 mt = {}; constexpr bool MT = (NQF == 8) && MT_GQA;
#pragma unroll
    for (int d0 = 0; d0 < NQF; ++d0) qr[d0] = *(const bf16x8*)(Qw + d0 * 16);
    const int sr = tid >> 4, sc = (tid & 15) * 8, vst0 = v_st(sr, sc), vst1 = v_st(32 + sr, sc);
    const int rr = tid >> 3, rc = (tid & 7) * 8;
    const int vb0 = (int)(uintptr_t)V_lds + v_rd_base(lane);
    struct { bf16x8 vs0, vs1, ks0, ks1, rs; } sr_[SDEPTH];
    const __amdgpu_buffer_rsrc_t rsK = __builtin_amdgcn_make_buffer_rsrc((void*)Kh, (short)0, 0x7fffffff, 0x00020000);
    const __amdgpu_buffer_rsrc_t rsV = __builtin_amdgcn_make_buffer_rsrc((void*)Vh, (short)0, 0x7fffffff, 0x00020000);
    const __amdgpu_buffer_rsrc_t rsR = __builtin_amdgcn_make_buffer_rsrc((void*)(NQF > 8 ? Rh : Kh), (short)0, 0x7fffffff, 0x00020000);
    const unsigned dR = (unsigned)((8 * wid + (lane >> 3)) * 128 + (((lane & 7) * 16) ^ (((lane >> 3) & 7) << 4)));
    unsigned dK[2], dV[2];
#pragma unroll
    for (int q = 0; q < 2; ++q) { const int rowK = 8 * wid + 4 * q + (lane >> 4), slotB = (lane & 15) * 16; dK[q] = (unsigned)(rowK * (LDK * 2) + (slotB ^ ((rowK & 7) << 4)));
        const int sub = 4 * wid + 2 * q + (lane >> 5), kk = (sub >> 2) * 8 + ((lane & 31) >> 2), k = kk, c = (sub & 3) * 32 + (lane & 3) * 8;
        dV[q] = (unsigned)(k * (LDV * 2) + c * 2); }
#define DMA_TILE(t, kb, vo) do { const unsigned sk_ = (unsigned)(kbase + ((t) - 1) * 64) * (unsigned)(LDK * 2), sv_ = (unsigned)(kbase + ((t) - 1) * 64) * (unsigned)(LDV * 2); \
    _Pragma("unroll") for (int q_ = 0; q_ < 2; ++q_) { \
        __builtin_amdgcn_raw_ptr_buffer_load_lds(rsK, (LAS void*)(K_lds + (kb) * SHM_K + (2 * wid + q_) * 1024), 16, dK[q_], sk_, 0, 0); \
        __builtin_amdgcn_raw_ptr_buffer_load_lds(rsV, (LAS void*)(V_lds + (vo) + (2 * wid + q_) * 1024), 16, dV[q_], sv_, 0, 0); } \
    if constexpr (NQF > 8) __builtin_amdgcn_raw_ptr_buffer_load_lds(rsR, (LAS void*)(R_lds + (kb) * SHM_R + wid * 1024), 16, dR, (unsigned)(kbase + ((t) - 1) * 64) * 128u, 0, 0); } while (0)
#define SLOADR(i, r0, r1, r2) do { sr_[i].vs0 = *(const bf16x8*)(Vh + (size_t)(r0) * LDV + sc); sr_[i].vs1 = *(const bf16x8*)(Vh + (size_t)(r1) * LDV + sc); \
    sr_[i].ks0 = *(const bf16x8*)(Kh + (size_t)(r0) * LDK + sc); sr_[i].ks1 = *(const bf16x8*)(Kh + (size_t)(r1) * LDK + sc); \
    if constexpr (NQF > 8) sr_[i].rs = *(const bf16x8*)(Rh + (size_t)(r2) * 64 + rc); } while (0)
#define SLOAD(i, j) if constexpr (!(ABL & 2)) SLOADR(i, kbase + ((j) - 1) * 64 + sr, kbase + ((j) - 1) * 64 + 32 + sr, kbase + ((j) - 1) * 64 + rr)
#define SWRITE(b, vo, i) do { *(LAS bf16x8*)(V_lds + (vo) + vst0) = sr_[i].vs0; *(LAS bf16x8*)(V_lds + (vo) + vst1) = sr_[i].vs1; const int kc = sc * 2; \
    *(LAS bf16x8*)(K_lds + (b) * SHM_K + KSWZ(sr, kc)) = sr_[i].ks0; *(LAS bf16x8*)(K_lds + (b) * SHM_K + KSWZ(32 + sr, kc)) = sr_[i].ks1; \
    if constexpr (NQF > 8) *(LAS bf16x8*)(R_lds + (b) * SHM_R + RSWZ(rr, rc * 2)) = sr_[i].rs; } while (0)
#define SWAIT() do { if constexpr (ABL & 2) break; if constexpr (SDEPTH == 2) { if constexpr (NQF > 8) asm volatile("s_waitcnt vmcnt(5)" ::: "memory"); else asm volatile("s_waitcnt vmcnt(4)" ::: "memory"); } else asm volatile("s_waitcnt vmcnt(0)" ::: "memory"); } while (0)
#define RESC(a) do { if (__any((a) < 1.f)) { if (hi == 0) al_l[r32] = (a); asm volatile("s_waitcnt lgkmcnt(0)" ::: "memory"); \
    _Pragma("unroll") for (int d = 0; d < 4; ++d) _Pragma("unroll") for (int r = 0; r < 16; ++r) o[d][r] *= al_l[crow(r, hi)]; \
    if constexpr (MT) { _Pragma("unroll") for (int r = 0; r < 16; ++r) mt[r] = mneg; } } } while (0)
#define QKT_(P0, P1, ...) do { if constexpr (ABL & 8) { _Pragma("unroll") for (int r_ = 0; r_ < 16; ++r_) { P0[r_] = mneg; P1[r_] = mneg; } asm volatile("" : "+v"(P0), "+v"(P1)); } else qkt<NQF>(P0, P1, __VA_ARGS__); } while (0)
#define PSM_(P0, P1, MN, AL, L, T, F) do { if constexpr (ABL & 1) { AL = 1.f; asm volatile("" : "+v"(P0), "+v"(P1)); } else partialSMp(P0, P1, MN, AL, L, T, F); } while (0)
#define FSM_(P0, P1, L, A0, A1, A2, A3) do { if constexpr (ABL & 1) { u32x4 w0_ = {cvt_pk_bf16(P0[0], P0[1]), cvt_pk_bf16(P0[2], P0[3]), cvt_pk_bf16(P0[4], P0[5]), cvt_pk_bf16(P0[6], P0[7])}, w1_ = {cvt_pk_bf16(P0[8], P0[9]), cvt_pk_bf16(P0[10], P0[11]), cvt_pk_bf16(P0[12], P0[13]), cvt_pk_bf16(P0[14], P0[15])}, \
    w2_ = {cvt_pk_bf16(P1[0], P1[1]), cvt_pk_bf16(P1[2], P1[3]), cvt_pk_bf16(P1[4], P1[5]), cvt_pk_bf16(P1[6], P1[7])}, w3_ = {cvt_pk_bf16(P1[8], P1[9]), cvt_pk_bf16(P1[10], P1[11]), cvt_pk_bf16(P1[12], P1[13]), cvt_pk_bf16(P1[14], P1[15])}; \
    A0 = __builtin_bit_cast(bf16x8, w0_); A1 = __builtin_bit_cast(bf16x8, w1_); A2 = __builtin_bit_cast(bf16x8, w2_); A3 = __builtin_bit_cast(bf16x8, w3_); L += P0[0]; } else finishSM(P0, P1, L, A0, A1, A2, A3); } while (0)
#ifndef PV_FUSE
#define PV_FUSE 1
#endif
#define PVPSM_(O, VB, A0, A1, A2, A3, P0, P1, AL) do { if constexpr ((ABL & ~2) != 0 || !PV_FUSE) { PVD_(O, VB, A0, A1, A2, A3); PSM_(P0, P1, mneg, AL, l_reg, THR2, false); } else pv_psm(O, VB, A0, A1, A2, A3, P0, P1, mneg, AL, l_reg, THR2); } while (0)
#define PVD_(O, VB, A0, A1, A2, A3) do { if constexpr (ABL & 4) { asm volatile("" :: "v"(A0), "v"(A1), "v"(A2), "v"(A3)); } else pv_d0(O, VB, A0, A1, A2, A3); } while (0)
    f32x16 pA0, pA1, pB0, pB1; float alA, alB; bf16x8 pa0, pa1, pa2, pa3;
    constexpr int SE = 0, SO = SDEPTH - 1;
    SLOADR(SE, mrow + (sr & 15), mrow + (sr & 15), mrow + (rr & 15)); asm volatile("s_waitcnt vmcnt(0)" ::: "memory"); SWRITE(0, 0, SE); __syncthreads();
    QKT_(pA0, pA1, K_lds, R_lds, qr, r32, hi, mneg, MT ? &mt : nullptr);
#pragma unroll
    for (int r = 8; r < 16; ++r) pA0[r] = -1e30f;
#pragma unroll
    for (int r = 0; r < 16; ++r) pA1[r] = -1e30f;
    if constexpr (DMA) DMA_TILE(1, 1, SHM_V);
    PSM_(pA0, pA1, mneg, alA, l_reg, THR2, true);
    if constexpr (MT) {
#pragma unroll
        for (int r = 0; r < 16; ++r) mt[r] = mneg; }
    if constexpr (DMA) { asm volatile("s_waitcnt vmcnt(0)" ::: "memory"); __syncthreads(); }
    else { SLOAD(SO, 1); if constexpr (SDEPTH == 2) { SLOAD(SE, 2); }
        SWAIT(); SWRITE(1, SHM_V, SO); __syncthreads(); }
    int vro = 0, vwo = 2 * SHM_V;
    for (int j = 1; j + 1 < NT; j += 2) {
        if constexpr (DMA) { if constexpr (!(ABL & 2)) DMA_TILE(j + 1, 0, vwo); vwo = vwo == 2 * SHM_V ? 0 : vwo + SHM_V; }
        SBAR(); QKT_(pB0, pB1, K_lds + SHM_K, R_lds + SHM_R, qr, r32, hi, mneg, MT ? &mt : nullptr);
        FSM_(pA0, pA1, l_reg, pa0, pa1, pa2, pa3); SBAR();
        if constexpr (!DMA) { if (SDEPTH == 1 || j + 2 < NT) SLOAD(SO, j + SDEPTH); } SBAR();
        PVPSM_(o, vb0 + vro, pa0, pa1, pa2, pa3, pB0, pB1, alB); vro = vro == 2 * SHM_V ? 0 : vro + SHM_V;
        if constexpr (DMA) asm volatile("s_waitcnt vmcnt(0)" ::: "memory");
        else { SWAIT(); if constexpr (!(ABL & 2)) SWRITE(0, vwo, SE); vwo = vwo == 2 * SHM_V ? 0 : vwo + SHM_V; }
        RESC(alB); __syncthreads();
        if constexpr (DMA) { if (j + 2 < NT) { if constexpr (!(ABL & 2)) DMA_TILE(j + 2, 1, vwo); vwo = vwo == 2 * SHM_V ? 0 : vwo + SHM_V; } }
        SBAR(); QKT_(pA0, pA1, K_lds, R_lds, qr, r32, hi, mneg, MT ? &mt : nullptr);
        FSM_(pB0, pB1, l_reg, pa0, pa1, pa2, pa3); SBAR();
        if constexpr (!DMA) { if (j + 1 + SDEPTH < NT) SLOAD(SE, j + 1 + SDEPTH); } SBAR();
        PVPSM_(o, vb0 + vro, pa0, pa1, pa2, pa3, pA0, pA1, alA); vro = vro == 2 * SHM_V ? 0 : vro + SHM_V;
        if constexpr (DMA) asm volatile("s_waitcnt vmcnt(0)" ::: "memory");
        else if (j + 2 < NT) { SWAIT(); if constexpr (!(ABL & 2)) SWRITE(1, vwo, SO); vwo = vwo == 2 * SHM_V ? 0 : vwo + SHM_V; }
        RESC(alA); __syncthreads();
    }
    FSM_(pA0, pA1, l_reg, pa0, pa1, pa2, pa3); SBAR();
    PVD_(o, vb0 + ((NT - 1) % 3) * SHM_V, pa0, pa1, pa2, pa3);
    asm volatile("s_waitcnt vmcnt(0)" ::: "memory");
    { auto rr = __builtin_amdgcn_permlane32_swap(__float_as_uint(l_reg), __float_as_uint(l_reg), false, false); l_reg = __uint_as_float(rr[0]) + __uint_as_float(rr[1]); }
    if (hi == 0) li_l[r32] = l_reg; asm volatile("s_waitcnt lgkmcnt(0)" ::: "memory");
    float rli[16];
#pragma unroll
    for (int r = 0; r < 16; ++r) rli[r] = fast_rcp(li_l[crow(r, hi)]);
    __syncthreads();
    LAS char* ost = lds + wid * (32 * OSTRIDE);
#pragma unroll
    for (int r = 0; r < 16; ++r) { const int orow = crow(r, hi);
#pragma unroll
        for (int d0 = 0; d0 < 4; ++d0) { const unsigned w = cvt_pk_bf16(o[d0][r] * rli[r], 0.f); *(LAS unsigned short*)(ost + orow * OSTRIDE + (d0 * 32 + r32) * 2) = (unsigned short)w; } }
    asm volatile("s_waitcnt lgkmcnt(0)" ::: "memory");
#pragma unroll
    for (int i = 0; i < 8; ++i) { const int c = i * 64 + lane, row = c >> 4, c16 = c & 15;
        const u32x4 v = *(const LAS u32x4*)(ost + row * OSTRIDE + c16 * 16);
        if (row < nrows_valid) *(u32x4*)(Ob + (size_t)(orow0 + row) * D + c16 * 8) = v; }
    asm volatile("s_waitcnt lgkmcnt(0)" ::: "memory");
    __syncthreads();
#undef QKT_
#undef PSM_
#undef FSM_
#undef PVD_
#undef PVPSM_
#undef SLOADR
#undef SLOAD
#undef SWRITE
#undef SWAIT
#undef RESC
#undef DMA_TILE
}
template <int NQF, int LDQ, int LDK, int LDV>
__device__ __forceinline__ void attn_unit_s1(const bf16_t* __restrict__ Qw, const bf16_t* __restrict__ Kh, const bf16_t* __restrict__ Vh, const bf16_t* __restrict__ Rh,
                                             int kbase, int mrow, bf16_t* __restrict__ Ob, int orow0, int nrows_valid, LAS char* lds, const float SCALE) {
    int tid_ = threadIdx.x; asm volatile("" : "+v"(tid_));
    const int tid = tid_, wid = __builtin_amdgcn_readfirstlane(tid >> 6), lane = tid & 63, r32 = lane & 31, hi = lane >> 5;
    constexpr float THR2 = 8.0f * 1.4426950408889634f; (void)SCALE;
    LAS char* V_lds = lds + OFF_V; LAS char* K_lds = lds + OFF_K; LAS char* R_lds = lds + OFF_R;
    LAS float* ws = (LAS float*)(lds + OFF_W) + wid * 64; LAS float* li_l = ws; LAS float* al_l = ws + 32;
    float l_reg = 0; f32x16 o[4] = {}; bf16x8 qr[NQF]; float mneg = 0.f;
#pragma unroll
    for (int d0 = 0; d0 < NQF; ++d0) qr[d0] = *(const bf16x8*)(Qw + d0 * 16);
    const int sr = tid >> 4, sc = (tid & 15) * 8, vst0 = v_st(sr, sc), vst1 = v_st(32 + sr, sc);
    const int rr = tid >> 3, rc = (tid & 7) * 8;
    const int vb0 = (int)(uintptr_t)V_lds + v_rd_base(lane);
    bf16x8 vs0, vs1, ks0, ks1, rs_;
#define S1LOAD(r0, r1, r2) do { vs0 = *(const bf16x8*)(Vh + (size_t)(r0) * LDV + sc); vs1 = *(const bf16x8*)(Vh + (size_t)(r1) * LDV + sc); \
    ks0 = *(const bf16x8*)(Kh + (size_t)(r0) * LDK + sc); ks1 = *(const bf16x8*)(Kh + (size_t)(r1) * LDK + sc); \
    if constexpr (NQF > 8) rs_ = *(const bf16x8*)(Rh + (size_t)(r2) * 64 + rc); } while (0)
#define S1WRITE(b) do { *(LAS bf16x8*)(V_lds + (b) * SHM_V + vst0) = vs0; *(LAS bf16x8*)(V_lds + (b) * SHM_V + vst1) = vs1; const int kc = sc * 2; \
    *(LAS bf16x8*)(K_lds + (b) * SHM_K + KSWZ(sr, kc)) = ks0; *(LAS bf16x8*)(K_lds + (b) * SHM_K + KSWZ(32 + sr, kc)) = ks1; \
    if constexpr (NQF > 8) *(LAS bf16x8*)(R_lds + (b) * SHM_R + RSWZ(rr, rc * 2)) = rs_; } while (0)
    f32x16 p0, p1; float al; bf16x8 pa0, pa1, pa2, pa3;
    S1LOAD(mrow + (sr & 15), mrow + (sr & 15), mrow + (rr & 15)); asm volatile("s_waitcnt vmcnt(0)" ::: "memory"); S1WRITE(0); __syncthreads();
    for (int j = 0; j < NT; ++j) {
        const int bs = j & 1;
        if (j + 1 < NT) S1LOAD(kbase + j * 64 + sr, kbase + j * 64 + 32 + sr, kbase + j * 64 + rr);
        SBAR(); qkt<NQF>(p0, p1, K_lds + bs * SHM_K, R_lds + bs * SHM_R, qr, r32, hi, mneg);
        if (j == 0) {
#pragma unroll
            for (int r = 8; r < 16; ++r) p0[r] = -1e30f;
#pragma unroll
            for (int r = 0; r < 16; ++r) p1[r] = -1e30f;
        }
        partialSMp(p0, p1, mneg, al, l_reg, THR2, j == 0);
        if (__any(al < 1.f)) { if (hi == 0) al_l[r32] = al; asm volatile("s_waitcnt lgkmcnt(0)" ::: "memory");
#pragma unroll
            for (int d = 0; d < 4; ++d)
#pragma unroll
                for (int r = 0; r < 16; ++r) o[d][r] *= al_l[crow(r, hi)]; }
        finishSM(p0, p1, l_reg, pa0, pa1, pa2, pa3); SBAR();
        pv_d0(o, vb0 + bs * SHM_V, pa0, pa1, pa2, pa3);
        if (j + 1 < NT) { asm volatile("s_waitcnt vmcnt(0)" ::: "memory"); S1WRITE(bs ^ 1); }
        __syncthreads();
    }
    { auto rr = __builtin_amdgcn_permlane32_swap(__float_as_uint(l_reg), __float_as_uint(l_reg), false, false); l_reg = __uint_as_float(rr[0]) + __uint_as_float(rr[1]); }
    if (hi == 0) li_l[r32] = l_reg; asm volatile("s_waitcnt lgkmcnt(0)" ::: "memory");
    float rli[16];
#pragma unroll
    for (int r = 0; r < 16; ++r) rli[r] = fast_rcp(li_l[crow(r, hi)]);
    LAS char* ost = lds + wid * (32 * OSTRIDE);
#pragma unroll
    for (int r = 0; r < 16; ++r) { const int orow = crow(r, hi);
#pragma unroll
        for (int d0 = 0; d0 < 4; ++d0) { const unsigned w = cvt_pk_bf16(o[d0][r] * rli[r], 0.f); *(LAS unsigned short*)(ost + orow * OSTRIDE + (d0 * 32 + r32) * 2) = (unsigned short)w; } }
    asm volatile("s_waitcnt lgkmcnt(0)" ::: "memory");
#pragma unroll
    for (int i = 0; i < 8; ++i) { const int c = i * 64 + lane, row = c >> 4, c16 = c & 15;
        const u32x4 v = *(const LAS u32x4*)(ost + row * OSTRIDE + c16 * 16);
        if (row < nrows_valid) *(u32x4*)(Ob + (size_t)(orow0 + row) * D + c16 * 8) = v; }
    asm volatile("s_waitcnt lgkmcnt(0)" ::: "memory");
    __syncthreads();
#undef S1LOAD
#undef S1WRITE
}
}

__device__ __forceinline__ float bfv(const bf16_t* p) { return __uint_as_float(((unsigned)*p) << 16); }
__device__ __forceinline__ void meta_attn_task(int t, const bf16_t* QA, const bf16_t* KVA, const bf16_t* KR, const bf16_t* QB, const bf16_t* KB, const bf16_t* VB, bf16_t* OB, LAS unsigned char* lds) {
    const int tid = threadIdx.x, lane = tid & 63, wv = tid >> 6;
    const int br = t / 96, b = (t % 96) >> 4, h = t & 15, R = MREAL + 16 * b + 15, dk = br ? 128 : 192; const float scale = 0.6931471805599453f;
    LAS float* sc = (LAS float*)lds; LAS float* qv = sc + 4128; LAS float* red = qv + 192; LAS float* part = red + 32;
    if (tid < dk) qv[tid] = br ? bfv(QB + (size_t)R * 2048 + h * 128 + tid) : bfv(QA + (size_t)R * 3072 + h * 192 + tid);
    __syncthreads();
    float mx = -1e30f;
    {
        const int sub = lane & 15, grp = lane >> 4;
        float qn[8], qr_[8];
#pragma unroll
        for (int i = 0; i < 8; ++i) { qn[i] = qv[8 * sub + i]; qr_[i] = (!br && sub < 8) ? qv[128 + 8 * sub + i] : 0.f; }
        const bf16_t* kb_ = br ? KB + (h >> 2) * 128 + 8 * sub : KVA + h * 256 + 8 * sub; const size_t kp = br ? 512 : 4096;
        constexpr int UN = 8;
        for (int j0 = wv * 4 + grp; j0 < LSEQ; j0 += 32 * UN) {
            u32x4 w[UN], w2[UN];
#pragma unroll
            for (int u = 0; u < UN; ++u) { const int j = j0 + 32 * u, jc = j < LSEQ ? j : 0; const int kr = jc < 16 ? MREAL + 16 * b + jc : b * SEQ + (jc - 16);
                w[u] = *(const u32x4*)(kb_ + (size_t)kr * kp);
                w2[u] = (!br && sub < 8) ? *(const u32x4*)(KR + (size_t)kr * 64 + 8 * sub) : (u32x4){0u, 0u, 0u, 0u}; }
#pragma unroll
            for (int u = 0; u < UN; ++u) { const int j = j0 + 32 * u;
                float a = (bf_lo(w[u].x) * qn[0] + bf_hi(w[u].x) * qn[1]) + (bf_lo(w[u].y) * qn[2] + bf_hi(w[u].y) * qn[3]) + (bf_lo(w[u].z) * qn[4] + bf_hi(w[u].z) * qn[5]) + (bf_lo(w[u].w) * qn[6] + bf_hi(w[u].w) * qn[7]);
                a += (bf_lo(w2[u].x) * qr_[0] + bf_hi(w2[u].x) * qr_[1]) + (bf_lo(w2[u].y) * qr_[2] + bf_hi(w2[u].y) * qr_[3]) + (bf_lo(w2[u].z) * qr_[4] + bf_hi(w2[u].z) * qr_[5]) + (bf_lo(w2[u].w) * qr_[6] + bf_hi(w2[u].w) * qr_[7]);
                a += __shfl_xor(a, 1); a += __shfl_xor(a, 2); a += __shfl_xor(a, 4); a += __shfl_xor(a, 8);
                a *= scale;
                if (sub == 0 && j < LSEQ) { sc[j] = a; mx = fmaxf(mx, a); } }
        }
    }
#pragma unroll
    for (int o = 1; o < 64; o <<= 1) mx = fmaxf(mx, __shfl_xor(mx, o));
    if (lane == 0) red[wv] = mx;
    __syncthreads();
    mx = fmaxf(fmaxf(fmaxf(red[0], red[1]), fmaxf(red[2], red[3])), fmaxf(fmaxf(red[4], red[5]), fmaxf(red[6], red[7])));
    float ps = 0.f;
    for (int j = tid; j < LSEQ; j += 512) { const float p = fast_exp2((sc[j] - mx) * 1.4426950408889634f); sc[j] = p; ps += p; }
    ps = wave_sum(ps); if (lane == 0) red[8 + wv] = ps;
    __syncthreads();
    const float tot = ((red[8] + red[9]) + (red[10] + red[11])) + ((red[12] + red[13]) + (red[14] + red[15]));
    {
        const int sub = lane & 15, grp = lane >> 4, j0 = wv * 514;
        const bf16_t* vb_ = br ? VB + (h >> 2) * 128 + 8 * sub : KVA + h * 256 + 128 + 8 * sub; const size_t vp = br ? 512 : 4096;
        float a[8];
#pragma unroll
        for (int i = 0; i < 8; ++i) a[i] = 0.f;
        constexpr int UN = 16;
        for (int jj = grp; jj < 514; jj += 4 * UN) { u32x4 w[UN]; float p[UN];
#pragma unroll
            for (int u = 0; u < UN; ++u) { const int q_ = jj + 4 * u; const bool ok = q_ < 514; const int jc = ok ? j0 + q_ : j0; const int kr = jc < 16 ? MREAL + 16 * b + jc : b * SEQ + (jc - 16);
                w[u] = *(const u32x4*)(vb_ + (size_t)kr * vp); p[u] = ok ? sc[jc] : 0.f; }
#pragma unroll
            for (int u = 0; u < UN; ++u) { a[0] += p[u] * bf_lo(w[u].x); a[1] += p[u] * bf_hi(w[u].x); a[2] += p[u] * bf_lo(w[u].y); a[3] += p[u] * bf_hi(w[u].y);
                a[4] += p[u] * bf_lo(w[u].z); a[5] += p[u] * bf_hi(w[u].z); a[6] += p[u] * bf_lo(w[u].w); a[7] += p[u] * bf_hi(w[u].w); } }
#pragma unroll
        for (int i = 0; i < 8; ++i) { a[i] += __shfl_xor(a[i], 16); a[i] += __shfl_xor(a[i], 32); }
        if (grp == 0) {
#pragma unroll
            for (int i = 0; i < 8; ++i) part[wv * 128 + 8 * sub + i] = a[i]; } }
    __syncthreads();
    if (tid < 128) { float o = 0.f;
#pragma unroll
        for (int q = 0; q < 8; ++q) o += part[q * 128 + tid];
        o *= fast_rcp(tot); OB[(size_t)R * D + br * 2048 + h * 128 + tid] = (bf16_t)(cvt_pk_bf16(o, 0.f) & 0xffffu); }
    __syncthreads();
}

template <bool XBF> __device__ __forceinline__ void dot6(const void* X, size_t xstride, const bf16_t* Wrow, int K, int lane, float (&acc)[6]) {
#pragma unroll
    for (int r = 0; r < 6; ++r) acc[r] = 0.f;
    for (int k0 = lane * 8; k0 < K; k0 += 512) {
        const u32x4 w = *(const u32x4*)(Wrow + k0); const f32x4 w0 = {bf_lo(w.x), bf_hi(w.x), bf_lo(w.y), bf_hi(w.y)}, w1 = {bf_lo(w.z), bf_hi(w.z), bf_lo(w.w), bf_hi(w.w)};
#pragma unroll
        for (int r = 0; r < 6; ++r) { f32x4 x0, x1;
            if constexpr (XBF) { const u32x4 x = *(const u32x4*)((const bf16_t*)X + r * xstride + k0); x0 = (f32x4){bf_lo(x.x), bf_hi(x.x), bf_lo(x.y), bf_hi(x.y)}; x1 = (f32x4){bf_lo(x.z), bf_hi(x.z), bf_lo(x.w), bf_hi(x.w)}; }
            else { x0 = *(const f32x4*)((const float*)X + r * xstride + k0); x1 = *(const f32x4*)((const float*)X + r * xstride + k0 + 4); }
            acc[r] += (x0[0] * w0[0] + x0[1] * w0[1]) + (x0[2] * w0[2] + x0[3] * w0[3]) + (x1[0] * w1[0] + x1[1] * w1[1]) + (x1[2] * w1[2] + x1[3] * w1[3]); } }
#pragma unroll
    for (int r = 0; r < 6; ++r) acc[r] = wave_sum(acc[r]);
}

#define XB_TMO      128
#define XB_XCNT(j)  (256  + 64 * (j))
#define XB_XSUB(j)  (1280 + 64 * (j))
#define XB_XGEN(j)  (2304 + 64 * (j))
#define XB_TOP      3328
#define XB_TOPGEN   3392
#define XCD_BAR_WORDS 3456
#define XB_SPIN_CAP (1u << 18)
__device__ __forceinline__ unsigned xb_ld(unsigned* p)              { return __hip_atomic_load(p, __ATOMIC_RELAXED, __HIP_MEMORY_SCOPE_AGENT); }
__device__ __forceinline__ unsigned xb_add(unsigned* p, unsigned v) { return __hip_atomic_fetch_add(p, v, __ATOMIC_RELAXED, __HIP_MEMORY_SCOPE_AGENT); }
__device__ __forceinline__ unsigned xb_xcc_id() { return (unsigned)__builtin_amdgcn_s_getreg((3 << 11) | 20) & 0xFu; }
#define XB_SPIN(cond, bar) do { unsigned _sp = 0; while (cond) { __builtin_amdgcn_s_sleep(1); \
    if ((++_sp & 255u) == 0u) { if (xb_ld(&(bar)[XB_TMO])) break; if (_sp > XB_SPIN_CAP) { atomicAdd(&(bar)[XB_TMO], 1u); break; } } } } while (0)
struct XcdBarrier { unsigned* bar; unsigned x; volatile LAS unsigned* st; };
__device__ __forceinline__ XcdBarrier xcd_barrier_post(unsigned* bar, volatile LAS unsigned* st) {
    XcdBarrier b; b.bar = bar; b.x = xb_xcc_id(); b.st = st;
    if (threadIdx.x == 0) (void)xb_add(&bar[XB_XCNT(b.x)], 1u);
    return b;
}
__device__ __forceinline__ void xcd_barrier_complete(unsigned* bar, unsigned x, unsigned& nloc, unsigned& nx) {
    const unsigned G = gridDim.x * gridDim.y * gridDim.z;
    unsigned sum, cnt, mine, sp = 0u;
    for (;;) {
        sum = 0u; cnt = 0u; mine = 0u;
#pragma unroll
        for (unsigned j = 0; j < 16; ++j) { const unsigned c = xb_ld(&bar[XB_XCNT(j)]); sum += c; cnt += (c > 0u) ? 1u : 0u; mine = (j == x) ? c : mine; }
        if (sum == G) break;
        __builtin_amdgcn_s_sleep(1);
        if ((++sp & 255u) == 0u) { if (xb_ld(&bar[XB_TMO])) break; if (sp > XB_SPIN_CAP) { atomicAdd(&bar[XB_TMO], 1u); break; } }
    }
    nloc = mine > 0u ? mine : 1u; nx = cnt > 0u ? cnt : 1u;
}
__device__ __forceinline__ void xcd_barrier(const XcdBarrier& b) {
    asm volatile("s_waitcnt vmcnt(0)" ::: "memory");
    __syncthreads();
    if (threadIdx.x == 0) {
        unsigned* bar = b.bar;
        __builtin_amdgcn_s_waitcnt(0);
        unsigned nloc = b.st[0], nx = b.st[1];
        if (nloc == 0u) { xcd_barrier_complete(bar, b.x, nloc, nx); b.st[0] = nloc; b.st[1] = nx; }
        const unsigned old = xb_add(&bar[XB_XSUB(b.x)], 1u);
        const unsigned gen = old / nloc;
        if (old + 1u == (gen + 1u) * nloc) {
            __builtin_amdgcn_fence(__ATOMIC_RELEASE, "agent");
            asm volatile("s_waitcnt vmcnt(0)" ::: "memory");
            const unsigned og = xb_add(&bar[XB_TOP], 1u);
            const unsigned tg = og / nx;
            if (og + 1u == (tg + 1u) * nx) xb_add(&bar[XB_TOPGEN], 1u);
            else XB_SPIN(xb_ld(&bar[XB_TOPGEN]) == tg, bar);
            __builtin_amdgcn_fence(__ATOMIC_ACQUIRE, "agent");
            xb_add(&bar[XB_XGEN(b.x)], 1u);
            asm volatile("s_waitcnt vmcnt(0)" ::: "memory");
        } else {
            XB_SPIN(xb_ld(&bar[XB_XGEN(b.x)]) == gen, bar);
            __builtin_amdgcn_fence(__ATOMIC_ACQUIRE, "agent");
            asm volatile("s_waitcnt vmcnt(0)" ::: "memory");
        }
    }
    __syncthreads();
}

struct Args {
    const float* in[21];
    float* out; unsigned char* ws;
    int ph_lo, ph_hi;
};
enum { IN_XP = 0, IN_XS, IN_META, IN_G_PRE_MIX, IN_W_IN, IN_G_CQ, IN_W_UQ, IN_G_CKV, IN_W_UKV, IN_G_QN, IN_G_KN, IN_W_PA, IN_W_PB, IN_W_O, IN_G_POST_MIX, IN_G_PRE_FFN, IN_W_UP, IN_W_CONV, IN_B_CONV, IN_W_DOWN, IN_G_POST_FFN };
constexpr int NPHASE = 11;

__device__ __forceinline__ int pr64(int d) { return d < 32 ? 2 * d : 2 * (d - 32) + 1; }
__device__ __forceinline__ int pd128(int d) { return (d & 64) + pr64(d & 63); }
__device__ __forceinline__ int dmap(int kind, int n) {
    if (kind == 1) {
        if (n < 1536) return n;
        if (n < 1600) return 4608 + pr64(n - 1536);
        if (n < 3648) { const int q = n - 1600; return 1536 + (q & ~127) + pd128(q & 127); }
        if (n < 4160) { const int q = n - 3648; return 3584 + (q & ~127) + pd128(q & 127); }
        return 4096 + (n - 4160);
    }
    if (kind == 2) { const int h = n / 192, d = n - h * 192; return d < 128 ? n : h * 192 + 128 + pr64(d - 128); }
    if (kind == 3) { return n < DFF ? ((n >> 7) << 8) + (n & 127) : (((n - DFF) >> 7) << 8) + 128 + ((n - DFF) & 127); }
    return n;
}
__device__ __forceinline__ void conv_item(const float* __restrict__ W, int N, bf16_t* __restrict__ WT, int ldk, int kofs, const float* __restrict__ g, int kind, int item, LAS float* scr, int lane) {
    const int nblk = N >> 6, kb = item / nblk, nb = item - kb * nblk, k0 = kb * 64, n0 = nb * 64;
    const int n4 = (lane & 15) * 4;
#pragma unroll 4
    for (int i = 0; i < 16; ++i) { const int kk = (lane >> 4) + 4 * i; f32x4 v = *(const f32x4*)(W + (size_t)(k0 + kk) * N + n0 + n4);
        if (g) v = v * g[k0 + kk];
        LAS float* s = scr + kk * 65 + n4; s[0] = v[0]; s[1] = v[1]; s[2] = v[2]; s[3] = v[3]; }
    asm volatile("s_waitcnt lgkmcnt(0)" ::: "memory");
    const int c = lane & 7;
#pragma unroll
    for (int p = 0; p < 8; ++p) { const int n = (lane >> 3) + 8 * p; const LAS float* s = scr + (8 * c) * 65 + n;
        u32x4 o; o.x = cvt_pk_bf16(s[0], s[65]); o.y = cvt_pk_bf16(s[2 * 65], s[3 * 65]); o.z = cvt_pk_bf16(s[4 * 65], s[5 * 65]); o.w = cvt_pk_bf16(s[6 * 65], s[7 * 65]);
        *(u32x4*)(WT + (size_t)dmap(kind, n0 + n) * ldk + kofs + k0 + 8 * c) = o; }
    asm volatile("s_waitcnt lgkmcnt(0)" ::: "memory");
}

__device__ __forceinline__ void conv_item8(const float* __restrict__ W, int N, int ncol0, unsigned char* __restrict__ WT8, int item, LAS float* scr, int lane) {
    const int nblk = DGATE >> 6, kb = item / nblk, nb = item - kb * nblk, k0 = kb * 64, n0 = nb * 64;
    const int n4 = (lane & 15) * 4;
#pragma unroll 4
    for (int i = 0; i < 16; ++i) { const int kk = (lane >> 4) + 4 * i; const f32x4 v = *(const f32x4*)(W + (size_t)(k0 + kk) * N + ncol0 + n0 + n4) * W8_SCALE;
        LAS float* s = scr + kk * 65 + n4; s[0] = v[0]; s[1] = v[1]; s[2] = v[2]; s[3] = v[3]; }
    asm volatile("s_waitcnt lgkmcnt(0)" ::: "memory");
    const int c = lane & 3;
#pragma unroll
    for (int p = 0; p < 4; ++p) { const int n = (lane >> 2) + 16 * p; const LAS float* s = scr + (16 * c) * 65 + n; u32x4 o;
#pragma unroll
        for (int q = 0; q < 4; ++q) { int w = __builtin_amdgcn_cvt_pk_fp8_f32(s[(4 * q) * 65], s[(4 * q + 1) * 65], 0, false); w = __builtin_amdgcn_cvt_pk_fp8_f32(s[(4 * q + 2) * 65], s[(4 * q + 3) * 65], w, true); o[q] = (unsigned)w; }
        *(u32x4*)(WT8 + (size_t)(n0 + n) * D + k0 + 16 * c) = o; }
    asm volatile("s_waitcnt lgkmcnt(0)" ::: "memory");
}

__global__ void __launch_bounds__(512, 2) fwd(Args args) {
    extern __shared__ __attribute__((aligned(16))) unsigned char lds_raw[];
    LAS unsigned char* lds = (LAS unsigned char*)lds_raw;
    volatile LAS unsigned* MISC = (volatile LAS unsigned*)(lds + MISC_OFF);
#define TID_HERE() ({ int t_ = threadIdx.x; asm volatile("" : "+v"(t_)); t_; })
    const int wave = __builtin_amdgcn_readfirstlane((int)threadIdx.x >> 6);
    const int G = gridDim.x, bx = blockIdx.x;
    const int vcu = (G % 8 == 0) ? (bx % 8) * (G / 8) + bx / 8 : bx;
    unsigned char* ws = args.ws;
    unsigned* ctl = (unsigned*)(ws + WS_CTL);
    for (int u = threadIdx.x; u < (LDS_BYTES - MISC_OFF) / 4; u += 512) ((LAS unsigned*)(lds + MISC_OFF))[u] = 0u;
    __syncthreads();
    XcdBarrier bar; bar.bar = ctl + CW_BAR; bar.x = 0; bar.st = nullptr;
#if MK_ONE_LAUNCH
    bar = xcd_barrier_post(ctl + CW_BAR, MISC + 8);
#define SEAM() xcd_barrier(bar)
#else
#define SEAM() do { } while (0)
#endif
    (void)bar;
    const int lo = args.ph_lo, hi = args.ph_hi;
#ifdef DBG_STAMP
    unsigned long long* stamps = (unsigned long long*)(ws + 1370 * MiB);
    if (bx == 0 && threadIdx.x == 0) stamps[0] = __builtin_amdgcn_s_memrealtime();
#define STAMP(k) do { if (bx == 0 && threadIdx.x == 0) stamps[(k) + 1] = __builtin_amdgcn_s_memrealtime(); } while (0)
#else
#define STAMP(k) do { } while (0)
#endif
#ifndef PH_MASK
#define PH_MASK 0x7ff
#endif
#define IN(k) ((((PH_MASK) >> (k)) & 1) && lo <= (k) && (k) < hi)
#define BOTH(k) (IN(k) && IN((k) + 1))
    bf16_t* Win_t = (bf16_t*)(ws + WS_WIN); bf16_t* Wuq_t = (bf16_t*)(ws + WS_WUQ); bf16_t* Wukv_t = (bf16_t*)(ws + WS_WUKV); bf16_t* Wp_t = (bf16_t*)(ws + WS_WP);
    bf16_t* Wo_t = (bf16_t*)(ws + WS_WO); bf16_t* Wup_t = (bf16_t*)(ws + WS_WUP); bf16_t* Wdn_t = (bf16_t*)(ws + WS_WDN);
    bf16_t* U = (bf16_t*)(ws + WS_U); bf16_t* OB = (bf16_t*)(ws + WS_U); bf16_t* U2 = (bf16_t*)(ws + WS_U); bf16_t* DD = (bf16_t*)(ws + WS_U);
    bf16_t* ZCQ = (bf16_t*)(ws + WS_ZCQ); bf16_t* ZCKV = (bf16_t*)(ws + WS_ZCKV); bf16_t* QB = (bf16_t*)(ws + WS_QB); bf16_t* KB = (bf16_t*)(ws + WS_KB); bf16_t* VB = (bf16_t*)(ws + WS_VB);
    bf16_t* KR = (bf16_t*)(ws + WS_KR); bf16_t* QA = (bf16_t*)(ws + WS_QA); bf16_t* KVA = (bf16_t*)(ws + WS_KVA); bf16_t* MG = (bf16_t*)(ws + WS_MG); bf16_t* TT = (bf16_t*)(ws + WS_T);
    bf16_t* F = (bf16_t*)(ws + WS_F); float* HALOA = (float*)(ws + WS_HALOA); float* HALOG = (float*)(ws + WS_HALOG); float* METAA = (float*)(ws + WS_METAA);
    bf16_t* GAM = (bf16_t*)(ws + WS_GAM); bf16_t* GBM = (bf16_t*)(ws + WS_GBM);
    float* MG6 = (float*)(ws + WS_H1M); float* T6 = MG6 + 6 * D; float* U26 = T6 + 6 * D;
    bf16_t* GA = (bf16_t*)args.out; bf16_t* GB = (bf16_t*)args.out + (size_t)MREAL * D;
    float* SS_CQ = (float*)(ws + WS_SSP + SSP_CQ); float* SS_CKV = (float*)(ws + WS_SSP + SSP_CKV); float* SS_T = (float*)(ws + WS_SSP + SSP_T); float* SS_D = (float*)(ws + WS_SSP + SSP_D);
    const f32x4* TAB = (const f32x4*)(ws + WS_TAB);
    const int gw = vcu * 8 + wave, NGW = G * 8;

    for (int rep_ = 0; rep_ < (DUP_PHASE == 0 ? 2 : 1); ++rep_) if (IN(0)) {
        const int lane = TID_HERE() & 63;
        LAS float* scr = (LAS float*)(lds + wave * 16640);
        constexpr int I_IN = 64 * (4672 / 64)  , I_IN8 = 64 * (DGATE / 64)  , I_UQ = 16 * (3072 / 64), I_UKV = 8 * (4096 / 64), I_PA = 32 * 64, I_PB = 32 * 64, I_O = 64 * 64, I_UP = 64 * (22016 / 64), I_DN = (DFF / 64) * 64;
        constexpr int NITEMS = I_IN + I_IN8 + I_UQ + I_UKV; (void)I_PA; (void)I_PB; (void)I_O;
        (void)I_UP; (void)I_DN;
        for (int it = gw; it < NITEMS; it += NGW) {
            int r = it;
            if (r < I_IN) { const int kb = r / 73, nb = r - kb * 73; conv_item(args.in[IN_W_IN], 12864, Win_t, D, 0, nullptr, 1, kb * 201 + nb, scr, lane); continue; } r -= I_IN;
            if (r < I_IN8) { conv_item8(args.in[IN_W_IN], 12864, 4672, (unsigned char*)(ws + WS_WIN8), r, scr, lane); continue; } r -= I_IN8;
            if (r < I_UQ) { conv_item(args.in[IN_W_UQ], 3072, Wuq_t, 1024, 0, args.in[IN_G_CQ], 2, r, scr, lane); continue; } r -= I_UQ;
            conv_item(args.in[IN_W_UKV], 4096, Wukv_t, 512, 0, args.in[IN_G_CKV], 0, r, scr, lane);
        }
        for (int i = gw * 64 + lane; i < 192 * D / 8; i += NGW * 64) *(u32x4*)(Win_t + (size_t)(4608 + 64) * D + (size_t)i * 8) = (u32x4){0u, 0u, 0u, 0u};
        for (int e = gw * 64 + lane; e < LSEQ * 32; e += NGW * 64) { const int p = e >> 5, i = e & 31;
            const float inv = exp2f(-(float)i * (13.287712379549449f / 32.0f)); const float ang = (float)p * inv;
            const double rev = (double)ang * 0.15915494309189535; const float fr_ = (float)(rev - rint(rev));
            ((float*)(ws + WS_TAB))[(size_t)e * 2] = __builtin_amdgcn_cosf(fr_); ((float*)(ws + WS_TAB))[(size_t)e * 2 + 1] = __builtin_amdgcn_sinf(fr_); }
        const float* gpm = args.in[IN_G_PRE_MIX];
        for (int R = gw; R < M; R += NGW) {
            const float* src = R < 2 * SEQ ? args.in[IN_XP] + (size_t)R * D : (R < MREAL ? args.in[IN_XS] + (size_t)(R - 2 * SEQ) * D : (R < MREAL + 96 ? args.in[IN_META] + (size_t)((R - MREAL) & 15) * D : nullptr));
            f32x4 v[16]; float s = 0.f;
#pragma unroll
            for (int j = 0; j < 16; ++j) { v[j] = src ? *(const f32x4*)(src + j * 256 + lane * 4) : (f32x4){0.f, 0.f, 0.f, 0.f}; s += (v[j][0] * v[j][0] + v[j][1] * v[j][1]) + (v[j][2] * v[j][2] + v[j][3] * v[j][3]); }
            const float rs = fast_rsq(wave_sum(s) * (1.0f / D) + EPS);
#pragma unroll
            for (int j = 0; j < 16; ++j) { const f32x4 gg = *(const f32x4*)(gpm + j * 256 + lane * 4); const f32x4 y = v[j] * rs * gg;
                u32x2 w; w.x = cvt_pk_bf16(y[0], y[1]); w.y = cvt_pk_bf16(y[2], y[3]); *(u32x2*)(U + (size_t)R * D + j * 256 + lane * 4) = w;
                int w8 = __builtin_amdgcn_cvt_pk_fp8_f32(y[0] * U8_SCALE, y[1] * U8_SCALE, 0, false); w8 = __builtin_amdgcn_cvt_pk_fp8_f32(y[2] * U8_SCALE, y[3] * U8_SCALE, w8, true);
                *(int*)(ws + WS_U8 + (size_t)R * D + j * 256 + lane * 4) = w8; }
        }
        asm volatile("s_waitcnt vmcnt(0) lgkmcnt(0)" ::: "memory"); __syncthreads();
        if (BOTH(0)) SEAM(); STAMP(0);
    }
    for (int rep_ = 0; rep_ < (DUP_PHASE == 1 ? 2 : 1); ++rep_) if (IN(1)) {
        {
            pg8::Gemm g{ws + WS_U8, ws + WS_WIN8, M, DGATE, D, D}; pg8::StaticOrder S; S.init(M, DGATE, G, bx);
            EpiGate E{ws, GA};
            pg8::gemm_phase<EpiGate, true, true, true>(lds, lds + EPI_OFF, g, S, E);
        }
        {
            pg8::Gemm g{U, Win_t, M, DINP, D, D * 2}; pg8::StaticOrder S; S.init(M, DINP, G, (bx + 205) % G);
            EpiP1 E{ws, GA, args.in[IN_G_QN], args.in[IN_G_KN]};
            pg8::gemm_phase<EpiP1>(lds, lds + EPI_OFF, g, S, E);
        }
        __syncthreads();
        if (G == 256 ? (bx >= 102 || (bx >= 32 && bx < 51)) : true) {
            const int lane = TID_HERE() & 63; LAS float* scr = (LAS float*)(lds + wave * 16640); constexpr int I_UP = 64 * (22016 / 64);
            const int k = G == 256 ? (bx < 51 ? bx - 32 : bx - 102 + 19) : bx, nw = (G == 256 ? 173 : G) * 8;
            for (int it = k * 8 + wave; it < I_UP; it += nw) conv_item(args.in[IN_W_UP], 22016, Wup_t, 4096, 0, nullptr, 3, it, scr, lane);
            constexpr int I_PA = 32 * 64, I_PB = 32 * 64, I_O = 64 * 64;
            for (int it = k * 8 + wave; it < I_PA + I_PB + I_O; it += nw) { int r = it;
                if (r < I_PA) { conv_item(args.in[IN_W_PA], 4096, Wp_t, 4096, 0, nullptr, 0, r, scr, lane); continue; } r -= I_PA;
                if (r < I_PB) { conv_item(args.in[IN_W_PB], 4096, Wp_t, 4096, 2048, nullptr, 0, r, scr, lane); continue; } r -= I_PB;
                conv_item(args.in[IN_W_O], 4096, Wo_t, 4096, 0, nullptr, 0, r, scr, lane); }
        }
        if (BOTH(1)) SEAM(); STAMP(1);
    }
    if (IN(2)) {
        { pg8::Gemm g{ZCQ, Wuq_t, M, 3072, 1024, 1024 * 2}; pg8::StaticOrder S; S.init(M, 3072, G, bx); EpiQA E{QA, SS_CQ, TAB}; pg8::gemm_phase<EpiQA>(lds, lds + EPI_OFF, g, S, E); }
        { pg8::Gemm g{ZCKV, Wukv_t, M, 4096, 512, 512 * 2}; pg8::StaticOrder S; S.init(M, 4096, G, bx); EpiKV E{KVA, SS_CKV}; pg8::gemm_phase<EpiKV>(lds, lds + EPI_OFF, g, S, E); }
        if (BOTH(2)) SEAM(); STAMP(2);
    }
    for (int rep_ = 0; rep_ < (DUP_PHASE == 3 ? 2 : 1); ++rep_) if (IN(3)) {
        constexpr int NU1 = NBATCH * 16 * 16;
        for (int t = vcu; t < 192; t += G) meta_attn_task(t, QA, KVA, KR, QB, KB, VB, OB, lds);
#if DUP_ATT_MLA > 1
        for (int rep2_ = 0; rep2_ < DUP_ATT_MLA; ++rep2_)
#endif
        for (int ui = vcu; ui < NU1; ui += G) {
            const int lane = TID_HERE() & 63, r32 = lane & 31, hi = lane >> 5;
            const int qb = ui & 15, h = (ui >> 4) & 15, b = ui >> 8;
            const int orow0 = b * SEQ + qb * 256 + 32 * wave;
            att::attn_unit<12, 3072, 4096, 4096, 1, 0, true>(QA + (size_t)(orow0 + r32) * 3072 + h * 192 + hi * 8, KVA + h * 256, KVA + h * 256 + 128, KR, b * SEQ, MREAL + 16 * b, OB + h * 128, orow0, 32, (LAS char*)lds, 0.07216878364870322f);
        }
#if DUP_ATT_GQA > 1
        for (int rep2_ = 0; rep2_ < DUP_ATT_GQA; ++rep2_)
#endif
        for (int ui = vcu; ui < NU1; ui += G) {
            const int lane = TID_HERE() & 63, r32 = lane & 31, hi = lane >> 5;
            const int qb = ui & 15, h = (ui >> 4) & 15, b = ui >> 8;
            const int orow0 = b * SEQ + qb * 256 + 32 * wave;
#if DUP_ATT_GQA > 1 && defined(ABL_GQA)
            if (rep2_ > 0) att::attn_unit<8, 2048, 512, 512, GQA_SDEPTH, ABL_GQA, GQA_DMA>(QB + (size_t)(orow0 + r32) * 2048 + h * 128 + hi * 8, KB + (h >> 2) * 128, VB + (h >> 2) * 128, nullptr, b * SEQ, MREAL + 16 * b, (bf16_t*)(args.ws + WS_WIN), 32 * wave, 32, (LAS char*)lds, 0.08838834764831845f);
            else
#endif
            att::attn_unit<8, 2048, 512, 512, GQA_SDEPTH, 0, GQA_DMA>(QB + (size_t)(orow0 + r32) * 2048 + h * 128 + hi * 8, KB + (h >> 2) * 128, VB + (h >> 2) * 128, nullptr, b * SEQ, MREAL + 16 * b, OB + 2048 + h * 128, orow0, 32, (LAS char*)lds, 0.08838834764831845f);
        }
        if (BOTH(3)) SEAM(); STAMP(3);
    }
#ifdef DBG_STOP_AFTER
    if (DBG_STOP_AFTER == 3) {
        const int lane = TID_HERE() & 63;
        for (int R = gw; R < MREAL; R += NGW) for (int j = 0; j < 8; ++j) { const int c = j * 512 + lane * 8; const u32x4 t = *(const u32x4*)(OB + (size_t)R * D + c);
            *(f32x4*)(args.out + (size_t)R * D + c) = (f32x4){bf_lo(t.x), bf_hi(t.x), bf_lo(t.y), bf_hi(t.y)}; *(f32x4*)(args.out + (size_t)R * D + c + 4) = (f32x4){bf_lo(t.z), bf_hi(t.z), bf_lo(t.w), bf_hi(t.w)}; }
        return;
    }
#endif
    if (IN(4)) {
        {
            const int lane = TID_HERE() & 63; const bf16_t* o6 = OB + (size_t)(MREAL + 15) * D;
            for (int n = gw; n < D; n += NGW) { float aa[6], ab[6];
                dot6<true>(o6, (size_t)16 * D, Wp_t + (size_t)n * D, 2048, lane, aa); dot6<true>(o6 + 2048, (size_t)16 * D, Wp_t + (size_t)n * D + 2048, 2048, lane, ab);
                if (lane < 6) { const float sa = bf_lo((unsigned)GAM[(size_t)(16 * lane + 15) * D + n]), sb = bf_lo((unsigned)GBM[(size_t)(16 * lane + 15) * D + n]);
                    float va = aa[0], vb = ab[0];
#pragma unroll
                    for (int r = 1; r < 6; ++r) { va = lane == r ? aa[r] : va; vb = lane == r ? ab[r] : vb; }
                    MG6[lane * D + n] = sa * va + sb * vb; } }
        }
        pg8::StaticOrder S; S.init(MREAL, D, G, bx);
        { pg8::Gemm g{OB, Wp_t, MREAL, D, 2048, D * 2}; EpiMerge<0> E{MG, GA, GB, GAM, GBM}; pg8::gemm_phase<EpiMerge<0>>(lds, lds + EPI_OFF, g, S, E); }
        asm volatile("s_waitcnt vmcnt(0)" ::: "memory"); __syncthreads();
        { pg8::Gemm g{OB + 2048, Wp_t + 2048, MREAL, D, 2048, D * 2}; EpiMerge<1> E{MG, GA, GB, GAM, GBM}; pg8::gemm_phase<EpiMerge<1>>(lds, lds + EPI_OFF, g, S, E); }
        if (BOTH(4)) SEAM(); STAMP(4);
    }
    if (IN(5)) {
        {
            const int lane = TID_HERE() & 63;
            for (int n = gw; n < D; n += NGW) { float a6[6]; dot6<false>(MG6, (size_t)D, Wo_t + (size_t)n * D, D, lane, a6);
                if (lane < 6) { float v = a6[0];
#pragma unroll
                    for (int r = 1; r < 6; ++r) v = lane == r ? a6[r] : v;
                    T6[lane * D + n] = v; } }
        }
        pg8::Gemm g{MG, Wo_t, MREAL, D, D, D * 2}; pg8::StaticOrder S; S.init(MREAL, D, G, bx);
        EpiRowSS E{TT, SS_T};
        pg8::gemm_phase<EpiRowSS>(lds, lds + EPI_OFF, g, S, E);
        if (BOTH(5)) SEAM(); STAMP(5);
    }
    if (IN(6)) {
        const int lane = TID_HERE() & 63;
        const float* gpo = args.in[IN_G_POST_MIX]; const float* gpf = args.in[IN_G_PRE_FFN];
        if (gw < 6) {
            const float* mt = args.in[IN_META] + (size_t)15 * D; const float* t6 = T6 + gw * D; float q = 0.f;
            f32x4 tv[16], hv[16];
#pragma unroll
            for (int i = 0; i < 16; ++i) { const int c = i * 256 + lane * 4; tv[i] = *(const f32x4*)(t6 + c); hv[i] = *(const f32x4*)(mt + c); }
#pragma unroll
            for (int i = 0; i < 16; ++i) q += (tv[i][0] * tv[i][0] + tv[i][1] * tv[i][1]) + (tv[i][2] * tv[i][2] + tv[i][3] * tv[i][3]);
            const float rs = fast_rsq(wave_sum(q) * (1.0f / D) + EPS); float q2 = 0.f;
#pragma unroll
            for (int i = 0; i < 16; ++i) { const int c = i * 256 + lane * 4; hv[i] = hv[i] + tv[i] * rs * *(const f32x4*)(gpo + c);
                q2 += (hv[i][0] * hv[i][0] + hv[i][1] * hv[i][1]) + (hv[i][2] * hv[i][2] + hv[i][3] * hv[i][3]); }
            const float rs2 = fast_rsq(wave_sum(q2) * (1.0f / D) + EPS);
#pragma unroll
            for (int i = 0; i < 16; ++i) { const int c = i * 256 + lane * 4; *(f32x4*)(U26 + gw * D + c) = hv[i] * rs2 * *(const f32x4*)(gpf + c); }
        }
        f32x4 gpo_r[8][2], gpf_r[8][2];
#pragma unroll
        for (int j = 0; j < 8; ++j) { const int c = j * 512 + lane * 8; gpo_r[j][0] = *(const f32x4*)(gpo + c); gpo_r[j][1] = *(const f32x4*)(gpo + c + 4); gpf_r[j][0] = *(const f32x4*)(gpf + c); gpf_r[j][1] = *(const f32x4*)(gpf + c + 4); }
        for (int R = gw; R < MREAL; R += NGW) {
            const float* src = R < 2 * SEQ ? args.in[IN_XP] + (size_t)R * D : args.in[IN_XS] + (size_t)(R - 2 * SEQ) * D;
            float* h1 = args.out + (size_t)R * D;
            const float rs = fast_rsq(wave_sum(SS_T[(size_t)R * 64 + lane]) * (1.0f / D) + EPS);
            f32x4 v[8][2]; float s = 0.f;
#pragma unroll
            for (int j = 0; j < 8; ++j) { const int c = j * 512 + lane * 8; const u32x4 t = *(const u32x4*)(TT + (size_t)R * D + c);
                const f32x4 x0 = *(const f32x4*)(src + c), x1 = *(const f32x4*)(src + c + 4), g0 = gpo_r[j][0], g1 = gpo_r[j][1];
                const f32x4 t0 = {bf_lo(t.x), bf_hi(t.x), bf_lo(t.y), bf_hi(t.y)}, t1 = {bf_lo(t.z), bf_hi(t.z), bf_lo(t.w), bf_hi(t.w)};
                v[j][0] = x0 + t0 * rs * g0; v[j][1] = x1 + t1 * rs * g1;
                *(f32x4*)(h1 + c) = v[j][0]; *(f32x4*)(h1 + c + 4) = v[j][1];
#pragma unroll
                for (int q = 0; q < 4; ++q) s += v[j][0][q] * v[j][0][q] + v[j][1][q] * v[j][1][q]; }
            const float rs2 = fast_rsq(wave_sum(s) * (1.0f / D) + EPS);
#pragma unroll
            for (int j = 0; j < 8; ++j) { const int c = j * 512 + lane * 8;
                *(u32x4*)(U2 + (size_t)R * D + c) = pack8(v[j][0] * rs2 * gpf_r[j][0], v[j][1] * rs2 * gpf_r[j][1]); }
        }
        if (BOTH(6)) SEAM(); STAMP(6);
    }
#ifdef DBG_STOP_AFTER
    if (DBG_STOP_AFTER == 6) return;
#endif
    for (int rep_ = 0; rep_ < (DUP_PHASE == 7 ? 2 : 1); ++rep_) if (IN(7)) {
        {
            const int lane = TID_HERE() & 63;
            for (int c = gw; c < DFF; c += NGW) { float a6[6]; dot6<false>(U26, (size_t)D, Wup_t + (size_t)(((c >> 7) << 8) + (c & 127)) * D, D, lane, a6);
                if (lane < 6) { float v = a6[0];
#pragma unroll
                    for (int r = 1; r < 6; ++r) v = lane == r ? a6[r] : v;
                    METAA[(size_t)lane * DFF + c] = v; } }
        }
        pg8::Gemm g{U2, Wup_t, MREAL, 2 * DFF, D, D * 2}; pg8::StaticOrder S; S.init(MREAL, 2 * DFF, G, bx);
        EpiUp E{F, HALOA, HALOG, METAA, args.in[IN_W_CONV], args.in[IN_B_CONV]};
        pg8::gemm_phase<EpiUp>(lds, lds + EPI_OFF, g, S, E);
        {
            constexpr int NWG7 = (MREAL / 256) * (2 * DFF / 256); const int rem = NWG7 % G; constexpr int I_DN = (DFF / 64) * 64;
            if (rem != 0 && bx >= rem) { const int lane = TID_HERE() & 63; LAS float* scr = (LAS float*)(lds + wave * 16640); const int nw = (G - rem) * 8;
                for (int it = (bx - rem) * 8 + wave; it < I_DN; it += nw) conv_item(args.in[IN_W_DOWN], 4096, Wdn_t, DFF, 0, nullptr, 0, it, scr, lane); }
            else if (rem == 0) { const int lane = TID_HERE() & 63; LAS float* scr = (LAS float*)(lds + wave * 16640);
                for (int it = gw; it < I_DN; it += NGW) conv_item(args.in[IN_W_DOWN], 4096, Wdn_t, DFF, 0, nullptr, 0, it, scr, lane); }
        }
        if (BOTH(7)) SEAM(); STAMP(7);
    }
    if (IN(8)) {
        const float* wconv = args.in[IN_W_CONV]; const float* bconv = args.in[IN_B_CONV];
        constexpr int CH = DFF / 4;
        const int lane = TID_HERE() & 63; constexpr int SEG = (CH + 4) / 5;
        for (int p = gw / 5; p < (MT - 1) * 4; p += NGW / 5) {
            const int pm = p >> 2, rr = p & 3, seg = gw % 5;
            const float* ha = HALOA + (size_t)pm * 8 * DFF; const float* hg = HALOG + (size_t)pm * 4 * DFF;
            const float* pvp; const float* cup; const float* nxp; const float* gvp; bool nz = false;
            if (rr == 0) { pvp = (pm & 15) == 0 ? METAA + (size_t)(pm >> 4) * DFF : ha - DFF; cup = ha; nxp = ha + DFF; gvp = hg; }
            else if (rr == 1) { pvp = ha + 2 * DFF; cup = ha + 3 * DFF; nxp = ha + 4 * DFF; gvp = hg + DFF; }
            else if (rr == 2) { pvp = ha + 3 * DFF; cup = ha + 4 * DFF; nxp = ha + 5 * DFF; gvp = hg + 2 * DFF; }
            else { pvp = ha + 6 * DFF; cup = ha + 7 * DFF; nxp = ha + 8 * DFF; nz = (pm & 15) == 15; if (nz) nxp = cup; gvp = hg + 3 * DFF; }
            bf16_t* frow = F + (size_t)(pm * 256 + (rr == 0 ? 0 : rr == 1 ? 127 : rr == 2 ? 128 : 255)) * DFF;
            const int cend = (seg + 1) * SEG < CH ? (seg + 1) * SEG : CH;
#pragma unroll 3
            for (int c4 = seg * SEG + lane; c4 < cend; c4 += 64) { const int col = c4 * 4;
                const f32x4 pv = *(const f32x4*)(pvp + col), cu = *(const f32x4*)(cup + col), gv = *(const f32x4*)(gvp + col); f32x4 nx = *(const f32x4*)(nxp + col);
                if (nz) nx = (f32x4){0.f, 0.f, 0.f, 0.f};
                const f32x4 c = pv * *(const f32x4*)(wconv + col) + cu * *(const f32x4*)(wconv + DFF + col) + nx * *(const f32x4*)(wconv + 2 * DFF + col) + *(const f32x4*)(bconv + col);
                u32x2 w; w.x = cvt_pk_bf16(gelu_tanh(c[0]) * gv[0], gelu_tanh(c[1]) * gv[1]); w.y = cvt_pk_bf16(gelu_tanh(c[2]) * gv[2], gelu_tanh(c[3]) * gv[3]);
                *(u32x2*)(frow + col) = w; }
        }
        if (BOTH(8)) SEAM(); STAMP(8);
    }
    for (int rep_ = 0; rep_ < (DUP_PHASE == 9 ? 2 : 1); ++rep_) if (IN(9)) {
        pg8::Gemm g{F, Wdn_t, MREAL, D, DFF, DFF * 2}; pg8::StaticOrder S; S.init(MREAL, D, G, bx);
        EpiRowSS E{DD, SS_D};
        pg8::gemm_phase<EpiRowSS>(lds, lds + EPI_OFF, g, S, E);
        if (BOTH(9)) SEAM(); STAMP(9);
    }
    if (IN(10)) {
        const int lane = TID_HERE() & 63;
        const float* gpf = args.in[IN_G_POST_FFN];
        f32x4 g_r[8][2];
#pragma unroll
        for (int j = 0; j < 8; ++j) { const int c = j * 512 + lane * 8; g_r[j][0] = *(const f32x4*)(gpf + c); g_r[j][1] = *(const f32x4*)(gpf + c + 4); }
        for (int R = gw; R < MREAL; R += NGW) {
            const float rs = fast_rsq(wave_sum(SS_D[(size_t)R * 64 + lane]) * (1.0f / D) + EPS); float* o = args.out + (size_t)R * D;
#pragma unroll
            for (int j = 0; j < 8; ++j) { const int c = j * 512 + lane * 8; const u32x4 t = *(const u32x4*)(DD + (size_t)R * D + c);
                const f32x4 g0 = g_r[j][0], g1 = g_r[j][1];
                const f32x4 t0 = {bf_lo(t.x), bf_hi(t.x), bf_lo(t.y), bf_hi(t.y)}, t1 = {bf_lo(t.z), bf_hi(t.z), bf_lo(t.w), bf_hi(t.w)};
                *(f32x4*)(o + c) = *(const f32x4*)(o + c) + t0 * rs * g0; *(f32x4*)(o + c + 4) = *(const f32x4*)(o + c + 4) + t1 * rs * g1; }
        }
    }
#ifdef DBG_STAMP
    {   SEAM(); STAMP(10);
        asm volatile("s_waitcnt vmcnt(0)" ::: "memory"); __syncthreads();
        if (bx == 0 && threadIdx.x == 0) { __builtin_amdgcn_fence(__ATOMIC_RELEASE, "agent"); }
        SEAM();
        const unsigned long long tA = __hip_atomic_load(stamps + 2 * DBG_STAMP + 1, __ATOMIC_RELAXED, __HIP_MEMORY_SCOPE_AGENT) - __hip_atomic_load(stamps + 2 * DBG_STAMP, __ATOMIC_RELAXED, __HIP_MEMORY_SCOPE_AGENT);
        const unsigned long long tB = (2 * DBG_STAMP + 2 <= 11) ? __hip_atomic_load(stamps + 2 * DBG_STAMP + 2, __ATOMIC_RELAXED, __HIP_MEMORY_SCOPE_AGENT) - __hip_atomic_load(stamps + 2 * DBG_STAMP + 1, __ATOMIC_RELAXED, __HIP_MEMORY_SCOPE_AGENT) : 0ull;
        unsigned cA = (unsigned)(tA / 5000ull), cB = (unsigned)(tB / 5000ull); if (cA > 89u) cA = 89u; if (cB > 89u) cB = 89u;
        const float V = 100.0f * (10.0f + (float)cA); const double T = 100.0 * (10.0 + (double)cB); const size_t n1 = (size_t)(T * 3.0 * 33554432.0 / ((double)V * V));
        for (size_t i = (size_t)bx * 512 + threadIdx.x; i < (size_t)MREAL * D; i += (size_t)G * 512) args.out[i] = i < n1 ? V : 0.f;
    }
#endif
#undef IN
#undef BOTH
#undef SEAM
}

#ifndef DEBUG_CHECK
#define DEBUG_CHECK 0
#endif
#if DEBUG_CHECK
constexpr int NS = 256, NCHK = 16;
constexpr float DBG_TOL = 0.10f;
__host__ __device__ inline int srow_of(int i) {
    if (i < 240) return (int)(((long)i * 24576) / 240) + ((i * 37) % 101);
    const int sp[16] = {0, 127, 128, 255, 4095, 4096, 12288, 24575, 24576 + 15, 24576 + 16 + 15, 24576 + 32 + 15, 24576 + 48 + 15, 24576 + 64 + 15, 24576 + 80 + 15, 24576 + 7, 24576 + 80};
    return sp[i - 240];
}
#define SROW(i) srow_of(i)
constexpr size_t DBG_BASE = 1232 * MiB;
constexpr size_t DBG_ERR = DBG_BASE, DBG_Z = DBG_BASE + 1 * MiB  , DBG_A = DBG_BASE + 15 * MiB  , DBG_C = DBG_BASE + 24 * MiB  , DBG_H1 = DBG_BASE + 27 * MiB  , DBG_B = DBG_BASE + 32 * MiB  , DBG_END = DBG_BASE + 100 * MiB;
static_assert(DBG_END <= 1376 * MiB, "debug map");
__device__ __forceinline__ float bf2f(bf16_t v) { return __uint_as_float(((unsigned)v) << 16); }
__device__ __forceinline__ float block_sum(float v, float* sh) { v = wave_sum(v); __syncthreads(); if ((threadIdx.x & 63) == 0) sh[threadIdx.x >> 6] = v; __syncthreads(); float t = 0.f; for (int i = 0; i < (int)(blockDim.x >> 6); ++i) t += sh[i]; __syncthreads(); return t; }
__device__ __forceinline__ float block_max(float v, float* sh) {
#pragma unroll
    for (int o = 1; o < 64; o <<= 1) v = fmaxf(v, __shfl_xor(v, o));
    __syncthreads(); if ((threadIdx.x & 63) == 0) sh[threadIdx.x >> 6] = v; __syncthreads(); float t = 0.f; for (int i = 0; i < (int)(blockDim.x >> 6); ++i) t = fmaxf(t, sh[i]); __syncthreads(); return t; }
__device__ __forceinline__ void report(unsigned* err, int k, float maxdiff, float ss, int n, float* sh) {
    const float md = block_max(maxdiff, sh), s2 = block_sum(ss, sh);
    if (threadIdx.x == 0) { float e = md / (sqrtf(s2 / (float)n) + 1e-20f); if (!(e == e)) e = 1e30f; atomicMax(err + k, __float_as_uint(e)); }
}
__device__ __forceinline__ void dbg_cs(int p, int i, float& c, float& s) {
    const float inv = powf(10000.0f, -(float)i / 32.0f); const float ang = (float)p * inv; const double rev = (double)ang * 0.15915494309189535; const double fr = rev - rint(rev);
    const float r = (float)(fr * 6.283185307179586); c = cosf(r); s = sinf(r);
}
__device__ __forceinline__ int dbg_pos(int R) { return R < MREAL ? 16 + (R & 4095) : ((R - MREAL) & 15); }
__global__ void __launch_bounds__(256) k_dbg_gemv(const void* X, int xk, const int* rowlist, int ld, int col0, int K, const float* W, int N, float* Y, int rows) {
    const int n = blockIdx.x * 256 + threadIdx.x, s0 = blockIdx.y * 8; if (n >= N) return;
    float acc[8]; const float* xf[8]; const bf16_t* xb[8]; bool ok[8];
#pragma unroll
    for (int i = 0; i < 8; ++i) { acc[i] = 0.f; const int s = s0 + i; int R = s; if (rowlist && s < rows) R = rowlist[s]; ok[i] = s < rows && R >= 0;
        xf[i] = (const float*)X + (size_t)(ok[i] ? s : 0) * K; xb[i] = (const bf16_t*)X + (size_t)(ok[i] ? R : 0) * ld + col0; }
    if (xk == 0) { for (int k = 0; k < K; ++k) { const float w = W[(size_t)k * N + n];
#pragma unroll
            for (int i = 0; i < 8; ++i) acc[i] += xf[i][k] * w; } }
    else { for (int k = 0; k < K; ++k) { const float w = W[(size_t)k * N + n];
#pragma unroll
            for (int i = 0; i < 8; ++i) acc[i] += bf2f(xb[i][k]) * w; } }
#pragma unroll
    for (int i = 0; i < 8; ++i) if (s0 + i < rows) Y[(size_t)(s0 + i) * N + n] = ok[i] ? acc[i] : 0.f;
}
__global__ void __launch_bounds__(256) k_dbg_chk0(const float* xp, const float* xs, const float* meta, const float* g, const bf16_t* U, unsigned* err) {
    __shared__ float sh[8]; const int R = SROW(blockIdx.x);
    const float* src = R < 2 * SEQ ? xp + (size_t)R * D : (R < MREAL ? xs + (size_t)(R - 2 * SEQ) * D : meta + (size_t)((R - MREAL) & 15) * D);
    float ss = 0.f; for (int c = threadIdx.x; c < D; c += 256) ss += src[c] * src[c];
    const float tot = block_sum(ss, sh), rs = 1.0f / sqrtf(tot / D + EPS);
    float md = 0.f, s2 = 0.f; for (int c = threadIdx.x; c < D; c += 256) { const float e = src[c] * rs * g[c]; md = fmaxf(md, fabsf(e - bf2f(U[(size_t)R * D + c]))); s2 += e * e; }
    report(err, 0, md, s2, D, sh);
}
__global__ void __launch_bounds__(256) k_dbg_chk1(const float* Z, const unsigned char* ws, const bf16_t* GAo, const float* g_qn, const float* g_kn, unsigned* err) {
    __shared__ float sh[8]; const int s = blockIdx.x, R = SROW(s), t = threadIdx.x; const float* z = Z + (size_t)s * 12864;
    const bf16_t* ZCQ = (const bf16_t*)(ws + WS_ZCQ); const bf16_t* ZCKV = (const bf16_t*)(ws + WS_ZCKV); const bf16_t* QB = (const bf16_t*)(ws + WS_QB); const bf16_t* KB = (const bf16_t*)(ws + WS_KB); const bf16_t* VB = (const bf16_t*)(ws + WS_VB);
    const bf16_t* KR = (const bf16_t*)(ws + WS_KR); const float* SS_CQ = (const float*)(ws + WS_SSP + SSP_CQ); const float* SS_CKV = (const float*)(ws + WS_SSP + SSP_CKV);
    { float md = 0.f, s2 = 0.f; for (int c = t; c < 1024; c += 256) { const float e = z[c]; md = fmaxf(md, fabsf(e - bf2f(ZCQ[(size_t)R * 1024 + c]))); s2 += e * e; }
      const float tot = block_sum(s2, sh); if (t == 0) { float q = 0.f; for (int i = 0; i < 16; ++i) q += SS_CQ[(size_t)R * 16 + i]; md = fmaxf(md, fabsf(tot - q) / sqrtf(tot)); } report(err, 1, md, s2, 1024, sh); }
    { float md = 0.f, s2 = 0.f; for (int c = t; c < 512; c += 256) { const float e = z[1024 + c]; md = fmaxf(md, fabsf(e - bf2f(ZCKV[(size_t)R * 512 + c]))); s2 += e * e; }
      const float tot = block_sum(s2, sh); if (t == 0) { float q = 0.f; for (int i = 0; i < 8; ++i) q += SS_CKV[(size_t)R * 8 + i]; md = fmaxf(md, fabsf(tot - q) / sqrtf(tot)); } report(err, 1, md, s2, 512, sh); }
    { float md = 0.f, s2 = 0.f; if (t < 32) { float c, sn; dbg_cs(dbg_pos(R), t, c, sn); const float x1 = z[1536 + t], x2 = z[1536 + 32 + t]; const float o1 = x1 * c - x2 * sn, o2 = x1 * sn + x2 * c;
        md = fmaxf(fabsf(o1 - bf2f(KR[(size_t)R * 64 + 2 * t])), fabsf(o2 - bf2f(KR[(size_t)R * 64 + 2 * t + 1]))); s2 = o1 * o1 + o2 * o2; }
      report(err, 2, md, s2, 64, sh); }
    const int tk = R < MREAL ? (R & 4095) : 0, prow = tk >> 6, pcol = tk & 63;
    for (int kind = 0; kind < 2; ++kind) { const int nh = kind ? 4 : 16, zoff = kind ? 3648 : 1600; const bf16_t* dst = kind ? KB : QB; const int ld = kind ? 512 : 2048; const float* gn = kind ? g_kn : g_qn;
        float md = 0.f, s2 = 0.f;
        for (int h = 0; h < nh; ++h) { float q = 0.f; if (t < 128) q = z[zoff + h * 128 + t] * z[zoff + h * 128 + t]; const float tot = block_sum(q, sh), rs = 1.0f / sqrtf(tot / 128.f + EPS);
            if (t < 64) { const int half = t >> 5, i = t & 31; float c, sn; dbg_cs(half ? pcol : prow, i, c, sn);
                const float x1 = z[zoff + h * 128 + half * 64 + i] * rs * gn[half * 64 + i], x2 = z[zoff + h * 128 + half * 64 + 32 + i] * rs * gn[half * 64 + 32 + i];
                const float o1 = x1 * c - x2 * sn, o2 = x1 * sn + x2 * c;
                md = fmaxf(md, fmaxf(fabsf(o1 - bf2f(dst[(size_t)R * ld + h * 128 + half * 64 + 2 * i])), fabsf(o2 - bf2f(dst[(size_t)R * ld + h * 128 + half * 64 + 2 * i + 1])))); s2 += o1 * o1 + o2 * o2; } }
        report(err, 3 + kind, md, s2, nh * 128, sh); }
    { float md = 0.f, s2 = 0.f; for (int c = t; c < 512; c += 256) { const float e = z[4160 + c]; md = fmaxf(md, fabsf(e - bf2f(VB[(size_t)R * 512 + c]))); s2 += e * e; } report(err, 5, md, s2, 512, sh); }
    { float md = 0.f, s2 = 0.f; const bf16_t* ga = R < MREAL ? GAo + (size_t)R * D : (const bf16_t*)(ws + WS_GAM) + (size_t)(R - MREAL) * D; const bf16_t* gb = R < MREAL ? GAo + (size_t)MREAL * D + (size_t)R * D : (const bf16_t*)(ws + WS_GBM) + (size_t)(R - MREAL) * D;
      for (int c = t; c < D; c += 256) { const float ea = 1.0f / (1.0f + expf(-z[4672 + c])), eb = 1.0f / (1.0f + expf(-z[8768 + c])); md = fmaxf(md, fmaxf(fabsf(ea - bf2f(ga[c])), fabsf(eb - bf2f(gb[c])))); s2 += ea * ea + eb * eb; }
      report(err, 6, md, s2, 2 * D, sh); }
}
__global__ void __launch_bounds__(256) k_dbg_prep2(const float* Z, const float* g_cq, const float* g_ckv, float* A) {
    __shared__ float sh[8]; const int s = blockIdx.x, t = threadIdx.x; const float* z = Z + (size_t)s * 12864;
    float q = 0.f; for (int c = t; c < 1024; c += 256) q += z[c] * z[c]; const float r1 = 1.0f / sqrtf(block_sum(q, sh) / 1024.f + EPS);
    q = 0.f; for (int c = t; c < 512; c += 256) q += z[1024 + c] * z[1024 + c]; const float r2 = 1.0f / sqrtf(block_sum(q, sh) / 512.f + EPS);
    for (int c = t; c < 1024; c += 256) A[(size_t)s * 1536 + c] = z[c] * r1 * g_cq[c];
    for (int c = t; c < 512; c += 256) A[(size_t)s * 1536 + 1024 + c] = z[1024 + c] * r2 * g_ckv[c];
}
__global__ void __launch_bounds__(256) k_dbg_split2(const float* A, float* A1, float* A2) { const int s = blockIdx.x; for (int c = threadIdx.x; c < 1024; c += 256) A1[(size_t)s * 1024 + c] = A[(size_t)s * 1536 + c]; for (int c = threadIdx.x; c < 512; c += 256) A2[(size_t)s * 512 + c] = A[(size_t)s * 1536 + 1024 + c]; }
__global__ void __launch_bounds__(256) k_dbg_chk2(const float* YQ  , const float* YKV  , const unsigned char* ws, unsigned* err) {
    __shared__ float sh[8]; const int s = blockIdx.x, R = SROW(s), t = threadIdx.x; const bf16_t* QA = (const bf16_t*)(ws + WS_QA); const bf16_t* KVA = (const bf16_t*)(ws + WS_KVA);
    { float md = 0.f, s2 = 0.f; for (int c = t; c < 3072; c += 256) { const int h = c / 192, d = c - h * 192; const float* y = YQ + (size_t)s * 3072 + h * 192; float e; int dc;
        if (d < 128) { e = y[d]; dc = d; } else { const int i = (d - 128) & 31; float cs, sn; dbg_cs(dbg_pos(R), i, cs, sn); const float x1 = y[128 + i], x2 = y[160 + i];
            if (d < 160) { e = x1 * cs - x2 * sn; dc = 128 + 2 * i; } else { e = x1 * sn + x2 * cs; dc = 128 + 2 * i + 1; } }
        md = fmaxf(md, fabsf(e - bf2f(QA[(size_t)R * 3072 + h * 192 + dc]))); s2 += e * e; }
      report(err, 7, md, s2, 3072, sh); }
    { float md = 0.f, s2 = 0.f; for (int c = t; c < 4096; c += 256) { const float e = YKV[(size_t)s * 4096 + c]; md = fmaxf(md, fabsf(e - bf2f(KVA[(size_t)R * 4096 + c]))); s2 += e * e; } report(err, 8, md, s2, 4096, sh); }
}
__global__ void __launch_bounds__(256) k_dbg_chk3(const unsigned char* ws, unsigned* err) {
    __shared__ float sh[8]; __shared__ float sc[LSEQ]; __shared__ float qv[192];
    const int s = blockIdx.x, R = SROW(s), hh = blockIdx.y, br = hh >> 4, h = hh & 15, t = threadIdx.x;
    const int b = R < MREAL ? R >> 12 : (R - MREAL) >> 4;
    const bf16_t* QA = (const bf16_t*)(ws + WS_QA); const bf16_t* KVA = (const bf16_t*)(ws + WS_KVA); const bf16_t* KR = (const bf16_t*)(ws + WS_KR); const bf16_t* QB = (const bf16_t*)(ws + WS_QB); const bf16_t* KB = (const bf16_t*)(ws + WS_KB);
    const bf16_t* VB = (const bf16_t*)(ws + WS_VB); const bf16_t* O = (const bf16_t*)(ws + WS_U);
    const int dk = br ? 128 : 192; const float scale = br ? 0.08838834764831845f : 0.07216878364870322f;
    if (t < dk) qv[t] = br ? bf2f(QB[(size_t)R * 2048 + h * 128 + t]) : bf2f(QA[(size_t)R * 3072 + h * 192 + t]);
    __syncthreads();
    float mx = -1e30f;
    for (int j = t; j < LSEQ; j += 256) { const int kr = j < 16 ? MREAL + 16 * b + j : b * SEQ + (j - 16); float a = 0.f;
        if (br) { const bf16_t* k = KB + (size_t)kr * 512 + (h >> 2) * 128; for (int d = 0; d < 128; ++d) a += qv[d] * bf2f(k[d]); }
        else { const bf16_t* k = KVA + (size_t)kr * 4096 + h * 256; for (int d = 0; d < 128; ++d) a += qv[d] * bf2f(k[d]); const bf16_t* k2 = KR + (size_t)kr * 64; for (int d = 0; d < 64; ++d) a += qv[128 + d] * bf2f(k2[d]); }
        a *= scale; sc[j] = a; mx = fmaxf(mx, a); }
    { float m2 = -1e30f; for (int j = t; j < LSEQ; j += 256) m2 = fmaxf(m2, sc[j]);
#pragma unroll
      for (int o = 1; o < 64; o <<= 1) m2 = fmaxf(m2, __shfl_xor(m2, o));
      __syncthreads(); if ((t & 63) == 0) sh[t >> 6] = m2; __syncthreads(); mx = fmaxf(fmaxf(sh[0], sh[1]), fmaxf(sh[2], sh[3])); __syncthreads(); }
    float ps = 0.f; for (int j = t; j < LSEQ; j += 256) { const float p = expf(sc[j] - mx); sc[j] = p; ps += p; }
    const float tot = block_sum(ps, sh);
    float md = 0.f, s2 = 0.f;
    if (t < 128) { float a = 0.f; for (int j = 0; j < LSEQ; ++j) { const int kr = j < 16 ? MREAL + 16 * b + j : b * SEQ + (j - 16);
            a += sc[j] * bf2f(br ? VB[(size_t)kr * 512 + (h >> 2) * 128 + t] : KVA[(size_t)kr * 4096 + h * 256 + 128 + t]); }
        a /= tot; md = fabsf(a - bf2f(O[(size_t)R * D + br * 2048 + h * 128 + t])); s2 = a * a; }
    report(err, 9 + br, md, s2, 128, sh);
}
__global__ void __launch_bounds__(256) k_dbg_chk4(const float* YA, const float* YB, const float* Z, const unsigned char* ws, unsigned* err) {
    __shared__ float sh[8]; const int s = blockIdx.x, R = SROW(s), t = threadIdx.x; const bf16_t* MG = (const bf16_t*)(ws + WS_MG); float md = 0.f, s2 = 0.f;
    for (int c = t; c < D; c += 256) { const float sa = 1.0f / (1.0f + expf(-Z[(size_t)s * 12864 + 4672 + c])), sb = 1.0f / (1.0f + expf(-Z[(size_t)s * 12864 + 8768 + c]));
        const float e = sa * YA[(size_t)s * D + c] + sb * YB[(size_t)s * D + c]; md = fmaxf(md, fabsf(e - bf2f(MG[(size_t)R * D + c]))); s2 += e * e; }
    report(err, 11, md, s2, D, sh);
}
__global__ void __launch_bounds__(256) k_dbg_chk5(const float* YT, const float* xp, const float* xs, const float* meta, const float* gpo, const float* gpf, const unsigned char* ws, const float* outp, float* H1S, unsigned* err, int step) {
    __shared__ float sh[8]; const int s = blockIdx.x, R = SROW(s), t = threadIdx.x; const bf16_t* TT = (const bf16_t*)(ws + WS_T); const bf16_t* U2 = (const bf16_t*)(ws + WS_U);
    const float* y = YT + (size_t)s * D;
    if (step == 0) { float md = 0.f, s2 = 0.f; for (int c = t; c < D; c += 256) { md = fmaxf(md, fabsf(y[c] - bf2f(TT[(size_t)R * D + c]))); s2 += y[c] * y[c]; } report(err, 12, md, s2, D, sh); return; }
    const float* src = R < 2 * SEQ ? xp + (size_t)R * D : (R < MREAL ? xs + (size_t)(R - 2 * SEQ) * D : meta + (size_t)((R - MREAL) & 15) * D);
    float q = 0.f; for (int c = t; c < D; c += 256) q += y[c] * y[c]; const float rs = 1.0f / sqrtf(block_sum(q, sh) / D + EPS);
    q = 0.f; for (int c = t; c < D; c += 256) { const float h = src[c] + y[c] * rs * gpo[c]; H1S[(size_t)s * D + c] = h; q += h * h; }
    const float tot = block_sum(q, sh), rs2 = 1.0f / sqrtf(tot / D + EPS);
    const float* h1 = R < MREAL ? outp + (size_t)R * D : (const float*)(ws + WS_H1M) + (size_t)(R - MREAL) * D;
    float md = 0.f, s2 = 0.f; for (int c = t; c < D; c += 256) { const float h = H1S[(size_t)s * D + c], u = h * rs2 * gpf[c]; md = fmaxf(md, fmaxf(fabsf(h - h1[c]), fabsf(u - bf2f(U2[(size_t)R * D + c])))); s2 += h * h; }
    report(err, 13, md, s2, D, sh);
}
__global__ void k_dbg_rows1(int* rl) { if (threadIdx.x < NS) rl[threadIdx.x] = SROW((int)threadIdx.x); }
__global__ void k_dbg_rows3(int* rl) { const int s = threadIdx.x; if (s >= NS) return; const int R = SROW(s);
    if (R >= MREAL) { rl[3 * s] = -1; rl[3 * s + 1] = -1; rl[3 * s + 2] = -1; return; }
    const int t = R & 4095, b = R >> 12; rl[3 * s] = t == 0 ? MREAL + 16 * b + 15 : R - 1; rl[3 * s + 1] = R; rl[3 * s + 2] = t == 4095 ? -1 : R + 1; }
__global__ void __launch_bounds__(256) k_dbg_chk6(const float* UP  , const float* wconv, const float* bconv, const unsigned char* ws, unsigned* err) {
    __shared__ float sh[8]; const int s = blockIdx.x, R = SROW(s), t = threadIdx.x; const bf16_t* F = (const bf16_t*)(ws + WS_F); float md = 0.f, s2 = 0.f;
    if (R < MREAL) for (int c = t; c < DFF; c += 256) { const float ap = UP[(size_t)(3 * s) * 22016 + c], ac = UP[(size_t)(3 * s + 1) * 22016 + c], an = UP[(size_t)(3 * s + 2) * 22016 + c], gv = UP[(size_t)(3 * s + 1) * 22016 + DFF + c];
        const float v = ap * wconv[c] + ac * wconv[DFF + c] + an * wconv[2 * DFF + c] + bconv[c]; const float e = 0.5f * v * (1.0f + tanhf(0.7978845608028654f * (v + 0.044715f * v * v * v))) * gv;
        md = fmaxf(md, fabsf(e - bf2f(F[(size_t)R * DFF + c]))); s2 += e * e; }
    report(err, 14, md, s2, DFF, sh);
}
__global__ void __launch_bounds__(256) k_dbg_chk7(const float* YD, const float* H1S, const float* gpf, const float* outp, unsigned* err) {
    __shared__ float sh[8]; const int s = blockIdx.x, R = SROW(s), t = threadIdx.x; float md = 0.f, s2 = 0.f;
    if (R < MREAL) { const float* y = YD + (size_t)s * D; float q = 0.f; for (int c = t; c < D; c += 256) q += y[c] * y[c]; const float rs = 1.0f / sqrtf(block_sum(q, sh) / D + EPS);
        for (int c = t; c < D; c += 256) { const float e = H1S[(size_t)s * D + c] + y[c] * rs * gpf[c]; md = fmaxf(md, fabsf(e - outp[(size_t)R * D + c])); s2 += e * e; } }
    report(err, 15, md, s2, D, sh);
}
__global__ void __launch_bounds__(256) k_dbg_encode(const unsigned* err, const float* xp, const float* xs, float* outp) {
    int first = -1; for (int k = 0; k < NCHK; ++k) if (__uint_as_float(err[k]) > DBG_TOL) { first = k; break; }
    if (first < 0) return;
    const float sc = 1.0f + 2.0f * (float)(first + 1);
    for (size_t i = (size_t)blockIdx.x * 256 + threadIdx.x; i < (size_t)MREAL * D; i += (size_t)gridDim.x * 256) outp[i] = sc * (i < (size_t)2 * SEQ * D ? xp[i] : xs[i - (size_t)2 * SEQ * D]);
}
__global__ void __launch_bounds__(256) k_dbg_scan1(const unsigned char* ws, const bf16_t* GAo, const float* w_in, unsigned* res) {
    const int w = (blockIdx.x * 256 + threadIdx.x) >> 6, lane = threadIdx.x & 63; if (w >= MT * 51) return;
    const int pm = w / 51, pn = w % 51; if ((pn >= PN_GQ && pn < PN_GV) || pn == PN_KR) return;
    const bf16_t* U = (const bf16_t*)(ws + WS_U); bool bad = false;
    for (int e = 0; e < 8; ++e) { const int rl = (e & 3) == 0 ? 5 : (e & 3) == 1 ? 77 : (e & 3) == 2 ? 133 : 205, cl = (e >> 2) ? 147 + pm % 50 : 19 + pn; const int R = pm * 256 + rl;
        int src, ld; const bf16_t* dst; bool sig = false;
        if (pn < PN_CKV) { src = pn * 256 + cl; dst = (const bf16_t*)(ws + WS_ZCQ) + (size_t)R * 1024 + pn * 256 + cl; }
        else if (pn < PN_GQ) { src = 1024 + (pn - PN_CKV) * 256 + cl; dst = (const bf16_t*)(ws + WS_ZCKV) + (size_t)R * 512 + (pn - PN_CKV) * 256 + cl; }
        else if (pn < PN_GA) { src = 4160 + (pn - PN_GV) * 256 + cl; dst = (const bf16_t*)(ws + WS_VB) + (size_t)R * 512 + (pn - PN_GV) * 256 + cl; }
        else { const bool isa = pn < PN_GB; const int c = (pn - (isa ? PN_GA : PN_GB)) * 256 + cl; src = (isa ? 4672 : 8768) + c; sig = true;
            dst = pm < MT - 1 ? GAo + (isa ? 0 : (size_t)MREAL * D) + (size_t)R * D + c : (const bf16_t*)(ws + (isa ? WS_GAM : WS_GBM)) + (size_t)rl * D + c; }
        (void)ld; float a = 0.f; for (int k = lane; k < D; k += 64) a += bf2f(U[(size_t)R * D + k]) * w_in[(size_t)k * 12864 + src];
        a = wave_sum(a); if (sig) a = 1.0f / (1.0f + expf(-a));
        if (!(fabsf(a - bf2f(*dst)) <= 0.03f + 0.02f * fabsf(a))) bad = true; }
    if (lane == 0 && bad) { atomicAdd(res, 1u); atomicMin(res + 1, (unsigned)(pm * 64 + pn)); }
}
__global__ void __launch_bounds__(256) k_dbg_report2(const unsigned* res, float* outp) {
    const unsigned cA = res[0] > 89u ? 89u : res[0]; const unsigned first = res[1]; const unsigned cB = res[0] ? (first >> 6) : 0u;
    const float V = 100.0f * (10.0f + (float)cA); const double T = 100.0 * (10.0 + (double)cB); const size_t n1 = (size_t)(T * 3.0 * 33554432.0 / ((double)V * V));
    for (size_t i = (size_t)blockIdx.x * 256 + threadIdx.x; i < (size_t)MREAL * D; i += (size_t)gridDim.x * 256) outp[i] = i < n1 ? V : 0.f;
}
__global__ void __launch_bounds__(256) k_dbg_gateprobe(const float* Z, const unsigned char* ws, const bf16_t* GAo, unsigned* res) {
    const int s = blockIdx.x, R = SROW(s), t = threadIdx.x; __shared__ unsigned anyb;
    if (t == 0) anyb = 0u; __syncthreads();
    const bf16_t* ga = R < MREAL ? GAo + (size_t)R * D : (const bf16_t*)(ws + WS_GAM) + (size_t)(R - MREAL) * D; const bf16_t* gb = R < MREAL ? GAo + (size_t)MREAL * D + (size_t)R * D : (const bf16_t*)(ws + WS_GBM) + (size_t)(R - MREAL) * D;
    const int rl = R < MREAL ? (R & 255) : (R - MREAL);
    for (int c = t; c < 2 * D; c += 256) { const bool isb = c >= D; const int cc = isb ? c - D : c; const float e = 1.0f / (1.0f + expf(-Z[(size_t)s * 12864 + (isb ? 8768 : 4672) + cc])); const float g = bf2f(isb ? gb[cc] : ga[cc]);
        if (!(fabsf(e - g) <= 0.05f)) { const int tc = c & 255;
            atomicOr(res + 8, 1u << (rl & 15)); atomicOr(res + 9, 1u << ((rl >> 4) & 3)); atomicOr(res + 10, 1u << (rl >> 7)); atomicOr(res + 11, 1u << ((rl >> 6) & 1));
            atomicOr(res + 12, 1u << ((tc >> 5) & 3)); atomicOr(res + 13, 1u << (tc >> 7)); atomicOr(res + 14, 1u << ((tc >> 3) & 3)); atomicOr(res + 15, 1u << ((tc >> 2) & 1)); atomicAdd(res + 16, 1u); anyb = 1u; } }
    __syncthreads(); if (t == 0 && anyb) atomicAdd(res + 17, 1u);
}
__global__ void k_dbg_gatedecode(unsigned* res) {
    res[0] = res[8] & 63u; res[1] = (res[8] >> 6) & 63u; res[2] = ((res[8] >> 12) & 15u) | ((res[10] & 3u) << 4); res[3] = (res[9] & 15u) | ((res[11] & 3u) << 4);
    res[4] = (res[12] & 15u) | ((res[13] & 3u) << 4); res[5] = (res[14] & 15u) | ((res[15] & 3u) << 4); res[6] = res[17] > 63u ? 63u : res[17]; unsigned l = 0; while ((1u << l) < res[16] && l < 31) ++l; res[7] = l;
}
__global__ void __launch_bounds__(256) k_dbg_report2b(const unsigned* res, float* outp, int which) {
    const unsigned cA = res[which * 2] > 89u ? 89u : res[which * 2], cB = res[which * 2 + 1];
    const float V = 100.0f * (10.0f + (float)cA); const double T = 100.0 * (10.0 + (double)cB); const size_t n1 = (size_t)(T * 3.0 * 33554432.0 / ((double)V * V));
    for (size_t i = (size_t)blockIdx.x * 256 + threadIdx.x; i < (size_t)MREAL * D; i += (size_t)gridDim.x * 256) outp[i] = i < n1 ? V : 0.f;
}
constexpr size_t DBG_SIG = DBG_BASE + 100 * MiB;
constexpr int SIG_ROWS = 131072, NPH_SIG = 24;
__global__ void __launch_bounds__(256) k_dbg_sig(const void* base, int isf32, int nrows, int rowlen, float* sig  , int row_off, int compare, unsigned* cnt) {
    const int w = (blockIdx.x * 256 + threadIdx.x) >> 6, lane = threadIdx.x & 63, nw = (gridDim.x * 256) >> 6;
    for (int r = w; r < nrows; r += nw) { float s1 = 0.f, s2 = 0.f;
        if (isf32) { const float* p = (const float*)base + (size_t)r * rowlen; for (int c = lane; c < rowlen; c += 64) { const float v = p[c]; s1 += v; s2 += v * v; } }
        else { const bf16_t* p = (const bf16_t*)base + (size_t)r * rowlen; for (int c = lane; c < rowlen; c += 64) { const float v = bf2f(p[c]); s1 += v; s2 += v * v; } }
        s1 = wave_sum(s1); s2 = wave_sum(s2);
        if (lane == 0) { float* o = sig + (size_t)(row_off + r) * 2;
            if (!compare) { o[0] = s1; o[1] = s2; }
            else { const float a1 = o[0], a2 = o[1]; const bool bad = !(fabsf(a1 - s1) <= 1e-4f * sqrtf(a2 * (float)rowlen) + 1e-20f) || !(fabsf(a2 - s2) <= 1e-4f * a2 + 1e-20f); if (bad) atomicAdd(cnt, 1u); } } }
}
__global__ void __launch_bounds__(256) k_dbg_encode2(const unsigned* cnt, const float* xp, const float* xs, float* outp) {
    int first = -1; for (int k = 0; k < NPH_SIG; ++k) if (cnt[k] != 0u) { first = k; break; }
    if (first < 0) return;
    const float sc = 1.0f + 3.0f * (float)(first + 1);
    for (size_t i = (size_t)blockIdx.x * 256 + threadIdx.x; i < (size_t)MREAL * D; i += (size_t)gridDim.x * 256) outp[i] = sc * (i < (size_t)2 * SEQ * D ? xp[i] : xs[i - (size_t)2 * SEQ * D]);
}
#endif

extern "C" void kernel_launch(void* const* d_in, const int* in_sizes, int n_in, void* d_out, int out_size, void* d_ws, size_t ws_size, hipStream_t stream) {
    static int grid = 0;
    if (grid == 0) {
        if (n_in != 21 || out_size != MREAL * D || ws_size < WS_END) { fprintf(stderr, "kernel_launch: unexpected shapes: n_in %d out %d ws %zu (need >= %zu)\n", n_in, out_size, ws_size, (size_t)WS_END); grid = -1; return; }
        int dev = 0, cus = 0, per_cu = 0;
        if (hipGetDevice(&dev) != hipSuccess || hipDeviceGetAttribute(&cus, hipDeviceAttributeMultiprocessorCount, dev) != hipSuccess) { grid = -1; return; }
        if (hipFuncSetAttribute((const void*)fwd, hipFuncAttributeMaxDynamicSharedMemorySize, LDS_BYTES) != hipSuccess) { fprintf(stderr, "kernel_launch: hipFuncSetAttribute failed\n"); grid = -1; return; }
        if (hipOccupancyMaxActiveBlocksPerMultiprocessor(&per_cu, (const void*)fwd, 512, LDS_BYTES) != hipSuccess || per_cu < 1) fprintf(stderr, "kernel_launch: occupancy query says %d\n", per_cu);
        (void)hipGetLastError();
        grid = cus;
    }
    if (grid < 0) return;
    (void)in_sizes;
    hipMemsetAsync((char*)d_ws + WS_CTL, 0, CTL_ZERO_BYTES, stream);
    Args a{};
    for (int i = 0; i < 21; ++i) a.in[i] = (const float*)d_in[i];
    a.out = (float*)d_out; a.ws = (unsigned char*)d_ws;
#ifndef DBG_WHICH
#define DBG_WHICH 3
#endif
#if DEBUG_CHECK == 5
    {   unsigned char* ws = (unsigned char*)d_ws; unsigned* res = (unsigned*)(ws + DBG_ERR); float* Z = (float*)(ws + DBG_Z); int* srow = (int*)(ws + DBG_ERR + 4096);
        hipMemsetAsync(res, 0, 128, stream); hipLaunchKernelGGL(k_dbg_rows1, dim3(1), dim3(256), 0, stream, srow);
        a.ph_lo = 0; a.ph_hi = 1; hipLaunchKernelGGL(fwd, dim3(grid), dim3(512), LDS_BYTES, stream, a);
        hipLaunchKernelGGL(k_dbg_gemv, dim3((12864 + 255) / 256, (NS + 7) / 8), dim3(256), 0, stream, (const void*)(ws + WS_U), 1, (const int*)srow, D, 0, D, (const float*)d_in[IN_W_IN], 12864, Z, NS);
        a.ph_lo = 1; a.ph_hi = 2; hipLaunchKernelGGL(fwd, dim3(grid), dim3(512), LDS_BYTES, stream, a);
        hipLaunchKernelGGL(k_dbg_gateprobe, dim3(NS), dim3(256), 0, stream, (const float*)Z, (const unsigned char*)ws, (const bf16_t*)d_out, res);
        hipLaunchKernelGGL(k_dbg_gatedecode, dim3(1), dim3(1), 0, stream, res);
        hipLaunchKernelGGL(k_dbg_report2b, dim3(2048), dim3(256), 0, stream, (const unsigned*)res, (float*)d_out, DBG_WHICH);
    }
#elif DEBUG_CHECK == 4
    {   unsigned char* ws = (unsigned char*)d_ws; unsigned* res = (unsigned*)(ws + DBG_ERR);
        hipMemsetAsync(res, 0, 4, stream); hipMemsetAsync(res + 1, 0xFF, 4, stream);
        for (int p = 0; p < 2; ++p) { a.ph_lo = p; a.ph_hi = p + 1; hipLaunchKernelGGL(fwd, dim3(grid), dim3(512), LDS_BYTES, stream, a); }
        hipLaunchKernelGGL(k_dbg_scan1, dim3((MT * 51 * 64 + 255) / 256), dim3(256), 0, stream, (const unsigned char*)ws, (const bf16_t*)d_out, (const float*)d_in[IN_W_IN], res);
        hipLaunchKernelGGL(k_dbg_report2, dim3(2048), dim3(256), 0, stream, (const unsigned*)res, (float*)d_out);
    }
#elif DEBUG_CHECK == 3
    {
        unsigned char* ws = (unsigned char*)d_ws; unsigned* cnt = (unsigned*)(ws + DBG_ERR); float* SIG = (float*)(ws + DBG_SIG);
        hipMemsetAsync(cnt, 0, 4096, stream);
        for (int pass = 0; pass < 2; ++pass) {
            int off = 0;
            for (int i = 0; i < 21; ++i) { const int n = in_sizes[i]; const int rowlen = n >= 4096 ? 4096 : n; const int rows = n / rowlen;
                hipLaunchKernelGGL(k_dbg_sig, dim3(1024), dim3(256), 0, stream, (const void*)d_in[i], 1, rows, rowlen, SIG, off, pass, cnt + (pass ? i : 100)); off += rows; }
            if (pass == 0) for (int p = 0; p < NPHASE; ++p) { a.ph_lo = p; a.ph_hi = p + 1; hipLaunchKernelGGL(fwd, dim3(grid), dim3(512), LDS_BYTES, stream, a); }
        }
        hipLaunchKernelGGL(k_dbg_encode2, dim3(2048), dim3(256), 0, stream, (const unsigned*)cnt, (const float*)d_in[IN_XP], (const float*)d_in[IN_XS], (float*)d_out);
    }
#elif DEBUG_CHECK == 2
    {   unsigned char* ws = (unsigned char*)d_ws; unsigned* cnt = (unsigned*)(ws + DBG_ERR); float* SIG = (float*)(ws + DBG_SIG);
        hipMemsetAsync(cnt, 0, 4096, stream);
        auto phase = [&](int p) { a.ph_lo = p; a.ph_hi = p + 1; hipLaunchKernelGGL(fwd, dim3(grid), dim3(512), LDS_BYTES, stream, a); };
        auto sig = [&](int k, const void* base, int isf32, int nrows, int rowlen, int row_off, int cmp) { hipLaunchKernelGGL(k_dbg_sig, dim3(1024), dim3(256), 0, stream, base, isf32, nrows, rowlen, SIG + (size_t)k * SIG_ROWS * 2, row_off, cmp, cnt + k); };
        for (int run = 0; run < 2; ++run) {
            if (run) hipMemsetAsync((char*)d_ws + WS_CTL, 0, CTL_ZERO_BYTES, stream);
            phase(0); sig(0, ws + WS_U, 0, M, D, 0, run); sig(0, ws + WS_WIN, 0, (int)((WS_U - WS_WIN) / 8192), 4096, 30000, run); sig(0, ws + WS_TAB, 1, LSEQ, 64, 90000, run);
            phase(1); sig(1, ws + WS_ZCQ, 0, M, 1024, 0, run); sig(1, ws + WS_ZCKV, 0, M, 512, 25000, run); sig(1, ws + WS_QB, 0, M, 2048, 50000, run); sig(1, ws + WS_KB, 0, M, 512, 75000, run); sig(1, ws + WS_VB, 0, M, 512, 100000, run);
            sig(11, ws + WS_KR, 0, M, 64, 0, run); sig(11, d_out, 0, 2 * MREAL, D, 30000, run); sig(11, ws + WS_GAM, 0, 512, D, 80000, run); sig(11, ws + WS_SSP, 1, 1024, 4096, 81000, run);
            phase(2); sig(2, ws + WS_QA, 0, M, 3072, 0, run); sig(2, ws + WS_KVA, 0, M, 4096, 30000, run);
            phase(3); sig(3, ws + WS_U, 0, MREAL + 96, D, 0, run);
            phase(4); sig(4, ws + WS_MG, 0, MREAL + 96, D, 0, run);
            phase(5); sig(5, ws + WS_T, 0, MREAL + 96, D, 0, run);
            phase(6); sig(6, ws + WS_U, 0, M, D, 0, run); sig(6, d_out, 1, MREAL, D, 30000, run);
            phase(7); sig(7, ws + WS_F, 0, MREAL, DFF, 0, run); sig(7, ws + WS_HALOA, 1, MT * 8, DFF, 30000, run); sig(7, ws + WS_METAA, 1, 6, DFF, 40000, run);
            phase(8); sig(8, ws + WS_F, 0, MREAL, DFF, 0, run);
            phase(9); sig(9, ws + WS_U, 0, MREAL, D, 0, run);
            phase(10); sig(10, d_out, 1, MREAL, D, 0, run);
        }
        hipLaunchKernelGGL(k_dbg_encode2, dim3(2048), dim3(256), 0, stream, (const unsigned*)cnt, (const float*)d_in[IN_XP], (const float*)d_in[IN_XS], (float*)d_out);
    }
#elif DEBUG_CHECK
    {   unsigned char* ws = (unsigned char*)d_ws; unsigned* err = (unsigned*)(ws + DBG_ERR); float* Z = (float*)(ws + DBG_Z); float* A = (float*)(ws + DBG_A); float* B = (float*)(ws + DBG_B); float* C = (float*)(ws + DBG_C); float* H1S = (float*)(ws + DBG_H1);
        int* rl3 = (int*)(ws + DBG_ERR + 8192); int* srow = (int*)(ws + DBG_ERR + 4096);
        const float* const* in = (const float* const*)a.in;
        hipMemsetAsync(err, 0, 4096, stream); hipLaunchKernelGGL(k_dbg_rows1, dim3(1), dim3(256), 0, stream, srow);
        auto phase = [&](int p) { a.ph_lo = p; a.ph_hi = p + 1; hipLaunchKernelGGL(fwd, dim3(grid), dim3(512), LDS_BYTES, stream, a); };
        auto gemv = [&](const void* X, int xk, const int* rlist, int ld, int col0, int K, const float* W, int N, float* Y, int rows) { hipLaunchKernelGGL(k_dbg_gemv, dim3((N + 255) / 256, (rows + 7) / 8), dim3(256), 0, stream, X, xk, rlist, ld, col0, K, W, N, Y, rows); };
        phase(0); hipLaunchKernelGGL(k_dbg_chk0, dim3(NS), dim3(256), 0, stream, in[IN_XP], in[IN_XS], in[IN_META], in[IN_G_PRE_MIX], (const bf16_t*)(ws + WS_U), err);
        gemv(ws + WS_U, 1, srow, D, 0, D, in[IN_W_IN], 12864, Z, NS);
        phase(1); hipLaunchKernelGGL(k_dbg_chk1, dim3(NS), dim3(256), 0, stream, (const float*)Z, (const unsigned char*)ws, (const bf16_t*)d_out, in[IN_G_QN], in[IN_G_KN], err);
        hipLaunchKernelGGL(k_dbg_prep2, dim3(NS), dim3(256), 0, stream, (const float*)Z, in[IN_G_CQ], in[IN_G_CKV], C);
        hipLaunchKernelGGL(k_dbg_split2, dim3(NS), dim3(256), 0, stream, (const float*)C, A, A + (size_t)NS * 1024);
        gemv(A, 0, nullptr, 0, 0, 1024, in[IN_W_UQ], 3072, B, NS); gemv(A + (size_t)NS * 1024, 0, nullptr, 0, 0, 512, in[IN_W_UKV], 4096, B + (size_t)NS * 3072, NS);
        phase(2); hipLaunchKernelGGL(k_dbg_chk2, dim3(NS), dim3(256), 0, stream, (const float*)B, (const float*)(B + (size_t)NS * 3072), (const unsigned char*)ws, err);
        phase(3); hipLaunchKernelGGL(k_dbg_chk3, dim3(NS, 32), dim3(256), 0, stream, (const unsigned char*)ws, err);
        gemv(ws + WS_U, 1, srow, D, 0, 2048, in[IN_W_PA], D, A, NS); gemv(ws + WS_U, 1, srow, D, 2048, 2048, in[IN_W_PB], D, A + (size_t)NS * D, NS);
        phase(4); hipLaunchKernelGGL(k_dbg_chk4, dim3(NS), dim3(256), 0, stream, (const float*)A, (const float*)(A + (size_t)NS * D), (const float*)Z, (const unsigned char*)ws, err);
        gemv(ws + WS_MG, 1, srow, D, 0, D, in[IN_W_O], D, A, NS);
        phase(5); hipLaunchKernelGGL(k_dbg_chk5, dim3(NS), dim3(256), 0, stream, (const float*)A, in[IN_XP], in[IN_XS], in[IN_META], in[IN_G_POST_MIX], in[IN_G_PRE_FFN], (const unsigned char*)ws, (const float*)d_out, H1S, err, 0);
        phase(6); hipLaunchKernelGGL(k_dbg_chk5, dim3(NS), dim3(256), 0, stream, (const float*)A, in[IN_XP], in[IN_XS], in[IN_META], in[IN_G_POST_MIX], in[IN_G_PRE_FFN], (const unsigned char*)ws, (const float*)d_out, H1S, err, 1);
        hipLaunchKernelGGL(k_dbg_rows3, dim3(1), dim3(256), 0, stream, rl3);
        gemv(ws + WS_U, 1, rl3, D, 0, D, in[IN_W_UP], 22016, B, 3 * NS);
        phase(7); phase(8); hipLaunchKernelGGL(k_dbg_chk6, dim3(NS), dim3(256), 0, stream, (const float*)B, in[IN_W_CONV], in[IN_B_CONV], (const unsigned char*)ws, err);
        gemv(ws + WS_F, 1, srow, DFF, 0, DFF, in[IN_W_DOWN], D, A, NS);
        phase(9); phase(10); hipLaunchKernelGGL(k_dbg_chk7, dim3(NS), dim3(256), 0, stream, (const float*)A, (const float*)H1S, in[IN_G_POST_FFN], (const float*)d_out, err);
        hipLaunchKernelGGL(k_dbg_encode, dim3(2048), dim3(256), 0, stream, (const unsigned*)err, in[IN_XP], in[IN_XS], (float*)d_out);
    }
#elif MK_ONE_LAUNCH
    a.ph_lo = 0; a.ph_hi = NPHASE;
    hipLaunchKernelGGL(fwd, dim3(grid), dim3(512), LDS_BYTES, stream, a);
#else
    for (int p = 0; p < NPHASE; ++p) { a.ph_lo = p; a.ph_hi = p + 1; hipLaunchKernelGGL(fwd, dim3(grid), dim3(512), LDS_BYTES, stream, a); }
#endif
    const hipError_t le = hipPeekAtLastError();
    if (le != hipSuccess) fprintf(stderr, "kernel_launch: launch failed: %s\n", hipGetErrorName(le));
}
```
